# Optimizing an MI355X kernel written in HIP

```python
import math
import jax, jax.numpy as jnp
from jax import lax
import numpy as np

D_MODEL = 1024
BATCH = 4
SEQ = 8192
DEPTH = 1

N_META = 16
BLOCK = 128
PAD_FRONT = BLOCK - N_META
NORM_EPS = 1e-6
NEG = -1e30

SSD_HEADDIM = 64
SSD_HEADS = 16
SSD_INNER = SSD_HEADS * SSD_HEADDIM
SSD_GROUPS = 2
SSD_STATE = 128
SSD_CONV = 4
SSD_CONV_DIM = SSD_INNER + 2 * SSD_GROUPS * SSD_STATE

ATT_HEADS = 8
ATT_HEAD_DIM = 64
ATT_QK = ATT_HEADS * 2 * ATT_HEAD_DIM
ATT_V = ATT_HEADS * 2 * ATT_HEAD_DIM

D_FF = ((8 * D_MODEL // 3 + 255) // 256) * 256

SPLIT_SIZES = [SSD_INNER,
               SSD_CONV_DIM,
               SSD_HEADS,
               ATT_QK, ATT_QK, ATT_V,
               2 * D_MODEL]
IN_COLS = sum(SPLIT_SIZES)
SPLIT_POINTS = list(np.cumsum(SPLIT_SIZES)[:-1])

kernel_name = "hybrid_ssd_diffattn_gated_block"


def rmsnorm(x, g):
    xf = x.astype(jnp.float32)
    y = xf * lax.rsqrt(jnp.mean(xf * xf, axis=-1, keepdims=True) + NORM_EPS)
    return (y * g.astype(jnp.float32)).astype(x.dtype)


def causal_depthwise_conv(u, w, b):
    c = u.shape[-1]
    kern = jnp.transpose(w)[:, None, :].astype(u.dtype)
    y = lax.conv_general_dilated(u, kern, window_strides=(1,), padding=[(SSD_CONV - 1, 0)],
                                 dimension_numbers=('NWC', 'WIO', 'NWC'), feature_group_count=c)
    return y + b.astype(u.dtype)


def ssd_chunked(xs, bmat, cmat, dt_raw, dt_bias, a_log, d_skip, valid):
    bsz, L = xs.shape[0], xs.shape[1]
    nc = L // BLOCK
    hpg = SSD_HEADS // SSD_GROUPS
    dt = jax.nn.softplus(dt_raw.astype(jnp.float32) + dt_bias.astype(jnp.float32))
    dt = jnp.where(valid[None, :, None], dt, 0.0)
    a = -jnp.exp(a_log.astype(jnp.float32))
    da = (dt * a).reshape(bsz, nc, BLOCK, SSD_GROUPS, hpg)
    dt = dt.reshape(bsz, nc, BLOCK, SSD_GROUPS, hpg)
    x = xs.astype(jnp.float32).reshape(bsz, nc, BLOCK, SSD_GROUPS, hpg, SSD_HEADDIM)
    xdt = x * dt[..., None]
    bc = bmat.astype(jnp.float32).reshape(bsz, nc, BLOCK, SSD_GROUPS, SSD_STATE)
    cc = cmat.astype(jnp.float32).reshape(bsz, nc, BLOCK, SSD_GROUPS, SSD_STATE)
    acs = jnp.cumsum(da, axis=2)

    tri = jnp.arange(BLOCK)[:, None] >= jnp.arange(BLOCK)[None, :]
    seg = acs[:, :, :, None] - acs[:, :, None, :]
    decay = jnp.exp(jnp.where(tri[:, :, None, None], seg, -jnp.inf))
    cb = jnp.einsum('bclgn,bcsgn->bclsg', cc, bc)
    y_diag = jnp.einsum('bclsg,bclsge,bcsgep->bclgep', cb, decay, xdt)

    decay_states = jnp.exp(acs[:, :, -1:] - acs)
    states = jnp.einsum('bclgn,bclge,bclgep->bcgepn', bc, decay_states, xdt)
    chunk_decay = jnp.exp(acs[:, :, -1])

    def step(h, inp):
        s_c, d_c = inp
        return h * d_c[..., None, None] + s_c, h

    h0 = jnp.zeros((bsz, SSD_GROUPS, hpg, SSD_HEADDIM, SSD_STATE), jnp.float32)
    _, prev = lax.scan(step, h0, (jnp.moveaxis(states, 1, 0), jnp.moveaxis(chunk_decay, 1, 0)))
    prev = jnp.moveaxis(prev, 0, 1)
    y_off = jnp.einsum('bclgn,bcgepn,bclge->bclgep', cc, prev, jnp.exp(acs))

    y = y_diag + y_off + x * d_skip.astype(jnp.float32).reshape(SSD_GROUPS, hpg)[:, :, None]
    return y.reshape(bsz, L, SSD_INNER)


def diff_attention(q, k, v, lam, lam_init, subln_g):
    bsz, L = q.shape[0], q.shape[1]
    nb = L // BLOCK
    slopes = 2.0 ** (-8.0 * (jnp.arange(ATT_HEADS, dtype=jnp.float32) + 1.0) / ATT_HEADS)
    scale = ATT_HEAD_DIM ** -0.5
    kpos = jnp.arange(L)
    kvalid = kpos >= PAD_FRONT
    vf = v.astype(jnp.float32)
    qb = jnp.moveaxis(q.reshape(bsz, nb, BLOCK, ATT_HEADS, 2, ATT_HEAD_DIM), 1, 0)

    def block(args):
        qblk, i = args
        qpos = i * BLOCK + jnp.arange(BLOCK)
        s = jnp.einsum('bqhcd,bkhcd->bhcqk', qblk, k,
                       preferred_element_type=jnp.float32) * scale
        dist = (qpos[:, None] - kpos[None, :]).astype(jnp.float32)
        allowed = (kpos[None, :] <= qpos[:, None]) & kvalid[None, :]
        s = s - slopes[None, :, None, None, None] * dist
        s = jnp.where(allowed, s, NEG)
        p = jax.nn.softmax(s, axis=-1)
        a = p[:, :, 0] - lam * p[:, :, 1]
        return jnp.einsum('bhqk,bkhe->bqhe', a, vf)

    out = lax.map(block, (qb, jnp.arange(nb)))
    out = jnp.moveaxis(out, 0, 1).reshape(bsz, L, ATT_HEADS, 2 * ATT_HEAD_DIM)
    out = rmsnorm(out, subln_g) * (1.0 - lam_init)
    return out.reshape(bsz, L, ATT_V)


def setup_inputs(seed: int = 0) -> dict:
    key = jax.random.key(seed)
    ks = jax.random.split(key, 24)
    f32 = jnp.float32
    nrm = lambda k, shp, s: jax.random.normal(k, shp, f32) * s
    dt0 = jnp.exp(jax.random.uniform(ks[9], (DEPTH, SSD_HEADS), f32)
                  * (math.log(0.1) - math.log(0.001)) + math.log(0.001))
    return {
        "x": nrm(ks[0], (BATCH, SEQ, D_MODEL), 1.0),
        "meta_tokens": nrm(ks[1], (N_META, D_MODEL), 1.0),
        "norm_mix_g": 1.0 + nrm(ks[2], (DEPTH, D_MODEL), 0.02),
        "w_in": nrm(ks[3], (DEPTH, D_MODEL, IN_COLS), D_MODEL ** -0.5),
        "gate_bias": nrm(ks[4], (DEPTH, 2 * D_MODEL), 0.01),
        "conv_w": nrm(ks[5], (DEPTH, SSD_CONV_DIM, SSD_CONV), SSD_CONV ** -0.5),
        "conv_b": nrm(ks[6], (DEPTH, SSD_CONV_DIM), 0.01),
        "dt_bias": dt0 + jnp.log(-jnp.expm1(-dt0)),
        "a_log": jnp.log(jax.random.uniform(ks[7], (DEPTH, SSD_HEADS), f32, 1.0, 16.0)),
        "d_skip": 1.0 + nrm(ks[8], (DEPTH, SSD_HEADS), 0.1),
        "ssd_norm_g": 1.0 + nrm(ks[10], (DEPTH, SSD_INNER), 0.02),
        "lambda_q1": nrm(ks[11], (DEPTH, ATT_HEAD_DIM), 0.1),
        "lambda_k1": nrm(ks[12], (DEPTH, ATT_HEAD_DIM), 0.1),
        "lambda_q2": nrm(ks[13], (DEPTH, ATT_HEAD_DIM), 0.1),
        "lambda_k2": nrm(ks[14], (DEPTH, ATT_HEAD_DIM), 0.1),
        "subln_g": 1.0 + nrm(ks[15], (DEPTH, 2 * ATT_HEAD_DIM), 0.02),
        "w_ssd_branch": nrm(ks[16], (DEPTH, SSD_INNER, D_MODEL), SSD_INNER ** -0.5),
        "w_attn_branch": nrm(ks[17], (DEPTH, ATT_V, D_MODEL), ATT_V ** -0.5),
        "w_out": nrm(ks[18], (DEPTH, D_MODEL, D_MODEL), D_MODEL ** -0.5),
        "norm_ffn_g": 1.0 + nrm(ks[19], (DEPTH, D_MODEL), 0.02),
        "w_gate_ffn": nrm(ks[20], (DEPTH, D_MODEL, D_FF), D_MODEL ** -0.5),
        "w_up_ffn": nrm(ks[21], (DEPTH, D_MODEL, D_FF), D_MODEL ** -0.5),
        "w_down_ffn": nrm(ks[22], (DEPTH, D_FF, D_MODEL), D_FF ** -0.5),
        "norm_final_g": 1.0 + nrm(ks[23], (D_MODEL,), 0.02),
    }


def reference(x, meta_tokens, norm_mix_g, w_in, gate_bias, conv_w, conv_b, dt_bias, a_log,
              d_skip, ssd_norm_g, lambda_q1, lambda_k1, lambda_q2, lambda_k2, subln_g,
              w_ssd_branch, w_attn_branch, w_out, norm_ffn_g, w_gate_ffn, w_up_ffn,
              w_down_ffn, norm_final_g):
    bsz = x.shape[0]
    dt_ = x.dtype
    meta = jnp.broadcast_to(meta_tokens.astype(dt_)[None], (bsz, N_META, D_MODEL))
    h = jnp.concatenate([jnp.zeros((bsz, PAD_FRONT, D_MODEL), dt_), meta, x], axis=1)
    L = h.shape[1]
    valid = jnp.arange(L) >= PAD_FRONT
    vmask = valid.astype(dt_)[None, :, None]

    for l in range(DEPTH):
        u = rmsnorm(h, norm_mix_g[l]) * vmask
        proj = u @ w_in[l]
        z, xbc, dt_raw, q, k, v, gates = jnp.split(proj, SPLIT_POINTS, axis=-1)

        xbc = jax.nn.silu(causal_depthwise_conv(xbc, conv_w[l], conv_b[l]))
        xs, bm, cm = jnp.split(xbc, [SSD_INNER, SSD_INNER + SSD_GROUPS * SSD_STATE], axis=-1)
        bm = bm.reshape(bsz, L, SSD_GROUPS, SSD_STATE)
        cm = cm.reshape(bsz, L, SSD_GROUPS, SSD_STATE)
        y_ssd = ssd_chunked(xs, bm, cm, dt_raw, dt_bias[l], a_log[l], d_skip[l], valid)
        y_ssd = rmsnorm(y_ssd * jax.nn.silu(z.astype(jnp.float32)), ssd_norm_g[l]).astype(dt_)

        lam_init = 0.8 - 0.6 * math.exp(-0.3 * l)
        lam = (jnp.exp(jnp.sum(lambda_q1[l].astype(jnp.float32) * lambda_k1[l].astype(jnp.float32)))
               - jnp.exp(jnp.sum(lambda_q2[l].astype(jnp.float32) * lambda_k2[l].astype(jnp.float32)))
               + lam_init)
        q = q.reshape(bsz, L, ATT_HEADS, 2, ATT_HEAD_DIM)
        k = k.reshape(bsz, L, ATT_HEADS, 2, ATT_HEAD_DIM)
        v = v.reshape(bsz, L, ATT_HEADS, 2 * ATT_HEAD_DIM)
        y_att = diff_attention(q, k, v, lam, lam_init, subln_g[l]).astype(dt_)

        g_ssd, g_att = jnp.split(jax.nn.sigmoid(gates + gate_bias[l]), 2, axis=-1)
        merged = g_ssd * (y_ssd @ w_ssd_branch[l]) + g_att * (y_att @ w_attn_branch[l])
        h = h + merged @ w_out[l]

        u2 = rmsnorm(h, norm_ffn_g[l])
        h = h + (jax.nn.silu(u2 @ w_gate_ffn[l]) * (u2 @ w_up_ffn[l])) @ w_down_ffn[l]

    out = rmsnorm(h, norm_final_g)
    return out[:, PAD_FRONT + N_META:]
```

```cpp
#include <hip/hip_runtime.h>
#include <hip/hip_cooperative_groups.h>
#include <hip/hip_bf16.h>
#include <cstdio>
#include <cstdint>
#include <cmath>
#include <type_traits>
namespace pg8 {
#define PG8_LAS __attribute__((address_space(3)))
typedef unsigned short bf16_t;
typedef short bf16x8 __attribute__((ext_vector_type(8)));
typedef float f32x4 __attribute__((ext_vector_type(4)));
typedef unsigned u32x4 __attribute__((ext_vector_type(4)));
constexpr int BM = 256, BK = 64, HALF = 128, HTB = HALF * BK * 2  , STAGE_BYTES = 8 * HTB, NXCD = 8, WGM = 8;

__host__ __device__ __forceinline__ int lds_byte(int r, int c) { const int st = (r >> 4) * 2 + (c >> 5), rr = r & 15, cc = c & 31, ob = rr * 64 + cc * 2; return st * 1024 + (ob ^ (((ob >> 9) & 1) << 5)); }
__host__ __device__ __forceinline__ void stage_rc(int b, int& R, int& C) { const int st = b / 1024, sb = b % 1024, swz = sb ^ (((sb >> 9) & 1) << 5); R = (st >> 1) * 16 + swz / 64; C = (st & 1) * 32 + (swz % 64) / 2; }
__host__ __device__ __forceinline__ int perm32(int rho) { const int n = rho >> 4, i = rho & 15; return 8 * (i >> 2) + 4 * n + (i & 3); }

struct Unit { int pm, pn, seg; };
struct Gemm { const bf16_t* A; const bf16_t* Bt; int M, N, K, amap; const bf16_t* A2; const bf16_t* Bt2; int amap2; };
__device__ __forceinline__ const char* a_base(const Gemm& g, const Unit& u) { const int am = u.seg ? g.amap2 : g.amap; const int r0 = am ? u.pm * 256 + 128 * (u.pm / 32 + 1) : u.pm * 256; return (const char*)(u.seg ? g.A2 : g.A) + (size_t)r0 * (size_t)g.K * 2; }
__device__ __forceinline__ const char* b_base(const Gemm& g, const Unit& u) { return (const char*)(u.seg ? g.Bt2 : g.Bt) + (size_t)u.pn * 256 * (size_t)g.K * 2; }
template <class T, class = void> struct has_twoseg : std::false_type {};
template <class T> struct has_twoseg<T, std::void_t<decltype(T::TWOSEG)>> : std::true_type {};

struct StaticOrder {
    int nM, nN, nwg, G, c;
    __host__ __device__ void init(int M, int N, int G_, int c_) { nM = M / BM; nN = N / BM; nwg = nM * nN; G = G_; c = c_; }
    __host__ __device__ bool next(int i, Unit& u) const {
        const long L = (long)i * G + c; if (L >= nwg) return false;
        int wgid = (int)L; { const int q = nwg / NXCD, r = nwg % NXCD, xcd = wgid % NXCD, off = wgid / NXCD; wgid = (xcd < r ? xcd * (q + 1) : r * (q + 1) + (xcd - r) * q) + off; }
        const int nig = WGM * nN, gid = wgid / nig, fm = gid * WGM, gsz = (nM - fm) < WGM ? (nM - fm) : WGM;
        u.pm = fm + ((wgid % nig) % gsz); u.pn = (wgid % nig) / gsz; u.seg = 0; return true;
    }
    __device__ __forceinline__ void a_ready(const Unit&) const {}
    __device__ __forceinline__ void done(const Unit&) const {}
};
struct StaticOrder2 { StaticOrder b;
    __host__ __device__ void init(int M, int N, int G_, int c_) { b.init(M, N, G_, c_); }
    __host__ __device__ bool next(int i, Unit& u) const { if (!b.next(i >> 1, u)) return false; u.seg = i & 1; return true; }
    __device__ __forceinline__ void a_ready(const Unit&) const {}
    __device__ __forceinline__ void done(const Unit&) const {}
};
typedef float f32x2c __attribute__((ext_vector_type(2))); typedef __bf16 bf16x2c __attribute__((ext_vector_type(2)));
__device__ __forceinline__ unsigned cvt_pk_bf16(float lo, float hi) { f32x2c v = {lo, hi}; bf16x2c b = __builtin_convertvector(v, bf16x2c); return __builtin_bit_cast(unsigned, b); }
typedef float f32x2 __attribute__((ext_vector_type(2)));
typedef unsigned u32x2 __attribute__((ext_vector_type(2)));
__device__ __forceinline__ u32x4 pack8(const f32x4 v0, const f32x4 v1) { u32x4 w; w.x = cvt_pk_bf16(v0[0], v0[1]); w.y = cvt_pk_bf16(v0[2], v0[3]); w.z = cvt_pk_bf16(v1[0], v1[1]); w.w = cvt_pk_bf16(v1[2], v1[3]); return w; }
__device__ __forceinline__ void unpack8(const u32x4 w, f32x4& a, f32x4& b) {
    a[0] = __uint_as_float(w.x << 16); a[1] = __uint_as_float(w.x & 0xffff0000u); a[2] = __uint_as_float(w.y << 16); a[3] = __uint_as_float(w.y & 0xffff0000u);
    b[0] = __uint_as_float(w.z << 16); b[1] = __uint_as_float(w.z & 0xffff0000u); b[2] = __uint_as_float(w.w << 16); b[3] = __uint_as_float(w.w & 0xffff0000u); }
__device__ __forceinline__ float sigm(float x) { return __builtin_amdgcn_rcpf(1.f + __expf(-x)); }
__device__ __forceinline__ f32x4 sigm4(f32x4 v) { f32x4 r; r[0] = sigm(v[0]); r[1] = sigm(v[1]); r[2] = sigm(v[2]); r[3] = sigm(v[3]); return r; }
__device__ __forceinline__ unsigned q8x4(f32x4 v) { return (unsigned)(v[0] * 255.f + 0.5f) | ((unsigned)(v[1] * 255.f + 0.5f) << 8) | ((unsigned)(v[2] * 255.f + 0.5f) << 16) | ((unsigned)(v[3] * 255.f + 0.5f) << 24); }
__device__ __forceinline__ f32x4 u8x4(unsigned w) { f32x4 r; r[0] = (float)(w & 0xffu); r[1] = (float)((w >> 8) & 0xffu); r[2] = (float)((w >> 16) & 0xffu); r[3] = (float)(w >> 24); return r; }
__device__ __forceinline__ float dot4(f32x4 v) { return (v[0] * v[0] + v[1] * v[1]) + (v[2] * v[2] + v[3] * v[3]); }
constexpr float QSCALE = 0.125f * 1.4426950408889634f;

#define EPI_LOOP_AM _Pragma("unroll") for (int ai = 0; ai < 2; ++ai) _Pragma("unroll") for (int m = 0; m < 4; ++m)

struct EpiProj1 {
    static constexpr bool PERM = true, AFTER_DRAIN = false;
    bf16_t *Q, *K, *V, *XBC; float* DT; float* NORM;
    __device__ __forceinline__ void operator()(const f32x4 (&acc)[2][2][4][2], const Unit& u, int wr, int wc, int fr, int fq) const {
        const int pn = u.pn, row0 = u.pm * BM + wr * 64 + fr;
        if (pn == 18) {
            if (wc == 0 && fq < 2) {
                EPI_LOOP_AM { float* p = DT + (size_t)(row0 + ai * HALF + m * 16) * 16 + 8 * fq; *(f32x4*)p = acc[ai][0][m][0]; *(f32x4*)(p + 4) = acc[ai][0][m][1]; }
            }
            return;
        }
        bf16_t* base; int ldc, colt; float sc = 1.f;
        if (pn < 4) { base = Q; ldc = 1024; colt = pn * 256; sc = QSCALE; }
        else if (pn < 8) { base = K; ldc = 1024; colt = (pn - 4) * 256; }
        else if (pn < 12) { base = V; ldc = 1024; colt = (pn - 8) * 256; }
        else { base = XBC; ldc = 1536; colt = (pn - 12) * 256; }
        const int col0 = colt + wc * 32 + 8 * fq;
        float mx[2] = {0.f, 0.f};
        EPI_LOOP_AM { bf16_t* rowp = base + (size_t)(row0 + ai * HALF + m * 16) * ldc + col0;
#pragma unroll
            for (int bj = 0; bj < 2; ++bj) { const f32x4 v0 = acc[ai][bj][m][0] * sc, v1 = acc[ai][bj][m][1] * sc; *(u32x4*)(rowp + bj * HALF) = pack8(v0, v1);
                if (pn < 8) { float ss = dot4(v0) + dot4(v1); ss += __shfl_xor(ss, 16); ss += __shfl_xor(ss, 32); mx[bj] = fmaxf(mx[bj], ss); } } }
        if (pn < 8) {
#pragma unroll
            for (int bj = 0; bj < 2; ++bj) { float v = mx[bj]; v = fmaxf(v, __shfl_xor(v, 1)); v = fmaxf(v, __shfl_xor(v, 2)); v = fmaxf(v, __shfl_xor(v, 4)); v = fmaxf(v, __shfl_xor(v, 8));
                if (fr == 0 && fq == 0) atomicMax((unsigned*)NORM + (((pn >> 2) * 8 + (pn & 3) * 2 + bj) * 2 + (wc >> 1)) * 2 + (wc & 1), __float_as_uint(v * 1.02f)); }
        }
    }
};
struct EpiZG {
    static constexpr bool PERM = true, AFTER_DRAIN = false;
    const bf16_t* Y; bf16_t *YZ, *G; const float* gbias; float* SSQ3;
    __device__ __forceinline__ void operator()(const f32x4 (&acc)[2][2][4][2], const Unit& u, int wr, int wc, int fr, int fq) const {
        const int pn = u.pn, row0 = u.pm * BM + wr * 64 + fr;
        if (pn < 4) {
            const int col0 = pn * 256 + wc * 32 + 8 * fq; const int prow0 = row0 + 128 * (u.pm / 32 + 1);
            EPI_LOOP_AM { const int rr = ai * HALF + m * 16; float ss = 0.f;
#pragma unroll
                for (int bj = 0; bj < 2; ++bj) { f32x4 y0, y1; unpack8(*(const u32x4*)(Y + (size_t)(prow0 + rr) * 1024 + col0 + bj * HALF), y0, y1);
                    const f32x4 z0 = acc[ai][bj][m][0], z1 = acc[ai][bj][m][1]; const f32x4 v0 = y0 * z0 * sigm4(z0), v1 = y1 * z1 * sigm4(z1);
                    *(u32x4*)(YZ + (size_t)(row0 + rr) * 1024 + col0 + bj * HALF) = pack8(v0, v1); ss += dot4(v0) + dot4(v1); }
                ss += __shfl_xor(ss, 16); ss += __shfl_xor(ss, 32);
                if (fq == 0) atomicAdd(SSQ3 + row0 + rr, ss); }
        } else {
            const int col0 = (pn - 4) * 256 + wc * 32 + 8 * fq;
            f32x4 bv[2][2];
#pragma unroll
            for (int bj = 0; bj < 2; ++bj) { bv[bj][0] = *(const f32x4*)(gbias + col0 + bj * HALF); bv[bj][1] = *(const f32x4*)(gbias + col0 + bj * HALF + 4); }
            EPI_LOOP_AM { unsigned char* rowp = (unsigned char*)G + (size_t)(row0 + ai * HALF + m * 16) * 2048 + col0;
#pragma unroll
                for (int bj = 0; bj < 2; ++bj) { u32x2 w; w.x = q8x4(sigm4(acc[ai][bj][m][0] + bv[bj][0])); w.y = q8x4(sigm4(acc[ai][bj][m][1] + bv[bj][1])); *(u32x2*)(rowp + bj * HALF) = w; } }
        }
    }
};
struct EpiBranch {
    static constexpr bool PERM = true, AFTER_DRAIN = false, TWOSEG = true;
    const bf16_t* G; bf16_t* MG; const float* SSQ3;
    __device__ __forceinline__ void mid(f32x4 (&acc)[2][2][4][2], const Unit& u, int wr, int wc, int fr, int fq) const {
        const int row0 = u.pm * BM + wr * 64 + fr, col0 = u.pn * 256 + wc * 32 + 8 * fq;
        EPI_LOOP_AM { const size_t row = (size_t)(row0 + ai * HALF + m * 16); const float r3 = rsqrtf(SSQ3[row] * (1.f / 1024.f) + 1e-6f);
#pragma unroll
            for (int bj = 0; bj < 2; ++bj) { const int c = col0 + bj * HALF; const unsigned char* gp = (const unsigned char*)G + row * 2048 + c;
                const u32x2 ws = *(const u32x2*)gp, wa = *(const u32x2*)(gp + 1024);
                const f32x4 s0 = u8x4(ws.x), s1 = u8x4(ws.y), a0 = u8x4(wa.x), a1 = u8x4(wa.y);
#pragma unroll
                for (int e = 0; e < 4; ++e) { acc[ai][bj][m][0][e] *= r3 * s0[e] * __builtin_amdgcn_rcpf(fmaxf(a0[e], 1.f)); acc[ai][bj][m][1][e] *= r3 * s1[e] * __builtin_amdgcn_rcpf(fmaxf(a1[e], 1.f)); } } }
    }
    __device__ __forceinline__ void operator()(f32x4 (&acc)[2][2][4][2], const Unit& u, int wr, int wc, int fr, int fq) const {
        const int row0 = u.pm * BM + wr * 64 + fr, col0 = u.pn * 256 + wc * 32 + 8 * fq;
        EPI_LOOP_AM { const size_t row = (size_t)(row0 + ai * HALF + m * 16);
#pragma unroll
            for (int bj = 0; bj < 2; ++bj) { const int c = col0 + bj * HALF; const u32x2 wa = *(const u32x2*)((const unsigned char*)G + row * 2048 + 1024 + c); f32x4 a0 = u8x4(wa.x), a1 = u8x4(wa.y);
#pragma unroll
                for (int e = 0; e < 4; ++e) { a0[e] = fmaxf(a0[e], 1.f) * (1.f / 255.f); a1[e] = fmaxf(a1[e], 1.f) * (1.f / 255.f); }
                *(u32x4*)(MG + row * 1024 + c) = pack8(acc[ai][bj][m][0] * a0, acc[ai][bj][m][1] * a1); } }
    }
};
struct EpiWout {
    static constexpr bool PERM = true, AFTER_DRAIN = false;
    const float* X; const bf16_t* U; const float* RS0; const float* GMIX; bf16_t* H1B; float* SSQ;
    __device__ __forceinline__ void operator()(const f32x4 (&acc)[2][2][4][2], const Unit& u, int wr, int wc, int fr, int fq) const {
        const int row0 = u.pm * BM + wr * 64 + fr, col0 = u.pn * 256 + wc * 32 + 8 * fq;
        const int prow0 = row0 + 128 * (u.pm / 32 + 1);
        f32x4 ig[2][2]; bool allnz = true;
#pragma unroll
        for (int bj = 0; bj < 2; ++bj)
#pragma unroll
            for (int n = 0; n < 2; ++n) { const f32x4 g = *(const f32x4*)(GMIX + col0 + bj * HALF + 4 * n);
#pragma unroll
                for (int e2 = 0; e2 < 4; ++e2) { allnz = allnz && (g[e2] != 0.f); ig[bj][n][e2] = __builtin_amdgcn_rcpf(g[e2]); } }
        EPI_LOOP_AM { const int rr = ai * HALF + m * 16; const size_t row = (size_t)(row0 + rr); float ss = 0.f; const float irs = RS0[prow0 + rr];
#pragma unroll
            for (int bj = 0; bj < 2; ++bj) { const size_t o = row * 1024 + col0 + bj * HALF;
                f32x4 x0, x1; unpack8(*(const u32x4*)(U + (size_t)(prow0 + rr) * 1024 + col0 + bj * HALF), x0, x1); x0 = x0 * ig[bj][0] * irs; x1 = x1 * ig[bj][1] * irs;
                if (!allnz) { x0 = *(const f32x4*)(X + o); x1 = *(const f32x4*)(X + o + 4); }
                const f32x4 v0 = x0 + acc[ai][bj][m][0], v1 = x1 + acc[ai][bj][m][1];
                *(u32x4*)(H1B + o) = pack8(v0, v1); ss += dot4(v0) + dot4(v1); }
            ss += __shfl_xor(ss, 16); ss += __shfl_xor(ss, 32);
            if (fq == 0) atomicAdd(SSQ + row, ss); }
    }
};
struct EpiGU {
    static constexpr bool PERM = true, AFTER_DRAIN = false;
    bf16_t* HF; const float* SSQ;
    __device__ __forceinline__ void operator()(const f32x4 (&acc)[2][2][4][2], const Unit& u, int wr, int wc, int fr, int fq) const {
        const int row0 = u.pm * BM + wr * 64 + fr, col0 = u.pn * 128 + wc * 32 + 8 * fq;
        EPI_LOOP_AM { const size_t row = (size_t)(row0 + ai * HALF + m * 16); const float rstd = rsqrtf(SSQ[row] * (1.f / 1024.f) + 1e-6f);
            f32x4 h[2];
#pragma unroll
            for (int n = 0; n < 2; ++n) { const f32x4 g = acc[ai][0][m][n] * rstd, up = acc[ai][1][m][n] * rstd; h[n] = g * sigm4(g) * up; }
            *(u32x4*)(HF + row * 2816 + col0) = pack8(h[0], h[1]); }
    }
};
struct EpiDownNorm {
    static constexpr bool PERM = true, AFTER_DRAIN = false;
    float* H; const bf16_t* H1B; float* SSQ; unsigned* CNT; const float* gfin;
    __device__ __forceinline__ void operator()(f32x4 (&acc)[2][2][4][2], const Unit& u, int wr, int wc, int fr, int fq) const {
        const int row0 = u.pm * BM + wr * 64 + fr, col0 = u.pn * 256 + wc * 32 + 8 * fq;
        EPI_LOOP_AM { const size_t row = (size_t)(row0 + ai * HALF + m * 16); float ss = 0.f;
#pragma unroll
            for (int bj = 0; bj < 2; ++bj) { const size_t o = row * 1024 + col0 + bj * HALF;
                f32x4 r0, r1; unpack8(*(const u32x4*)(H1B + o), r0, r1); acc[ai][bj][m][0] = acc[ai][bj][m][0] + r0; acc[ai][bj][m][1] = acc[ai][bj][m][1] + r1;
                ss += dot4(acc[ai][bj][m][0]) + dot4(acc[ai][bj][m][1]); }
            ss += __shfl_xor(ss, 16); ss += __shfl_xor(ss, 32);
            if (fq == 0) (void)__hip_atomic_fetch_add(SSQ + row, ss, __ATOMIC_RELAXED, __HIP_MEMORY_SCOPE_AGENT); }
        asm volatile("s_waitcnt vmcnt(0)" ::: "memory");
        unsigned* cnt = CNT + 16 * u.pm;
        if (fr == 0 && fq == 0) (void)__hip_atomic_fetch_add(cnt, 1u, __ATOMIC_RELAXED, __HIP_MEMORY_SCOPE_AGENT);
        for (unsigned sp = 0; sp < (1u << 22); ++sp) {
            if ((unsigned)__builtin_amdgcn_readfirstlane((int)__hip_atomic_load(cnt, __ATOMIC_RELAXED, __HIP_MEMORY_SCOPE_AGENT)) >= 32u) break;
            __builtin_amdgcn_s_sleep(2); }
        f32x4 gv[2][2];
#pragma unroll
        for (int bj = 0; bj < 2; ++bj) { gv[bj][0] = *(const f32x4*)(gfin + col0 + bj * HALF); gv[bj][1] = *(const f32x4*)(gfin + col0 + bj * HALF + 4); }
        EPI_LOOP_AM { const size_t row = (size_t)(row0 + ai * HALF + m * 16);
            const float rs = rsqrtf(__hip_atomic_load(SSQ + row, __ATOMIC_RELAXED, __HIP_MEMORY_SCOPE_AGENT) * (1.f / 1024.f) + 1e-6f);
#pragma unroll
            for (int bj = 0; bj < 2; ++bj) { const size_t o = row * 1024 + col0 + bj * HALF;
                *(f32x4*)(H + o) = acc[ai][bj][m][0] * rs * gv[bj][0]; *(f32x4*)(H + o + 4) = acc[ai][bj][m][1] * rs * gv[bj][1]; } }
    }
};

template <class Epi, class Sched, bool ALIGN_EPI = false, bool SP2 = false>
__device__ __forceinline__ void gemm_phase(PG8_LAS unsigned char* lds, const Gemm g, const Sched& S, const Epi& E) {
    int tid_ = threadIdx.x; asm volatile("" : "+v"(tid_));
    const int tid = tid_, wid = __builtin_amdgcn_readfirstlane(tid >> 6), lane = tid & 63, wr = wid >> 2, wc = wid & 3, fr = lane & 15, fq = lane >> 4;
    const int K = g.K, nt = K / BK;
    unsigned voffA[2], voffB[2];
#pragma unroll
    for (int i = 0; i < 2; ++i) { int R, C; stage_rc(tid * 16 + i * 8192, R, C); const int Rb = Epi::PERM ? ((R & ~31) + perm32(R & 31)) : R;
        voffA[i] = (unsigned)(R * K + C) * 2u; voffB[i] = (unsigned)(Rb * K + C) * 2u; }
    const size_t kstep = (size_t)(BK * 2);
    const size_t hstep = (size_t)HALF * K * 2;
    const size_t tstep = 2 * hstep;
    const unsigned ldsw = (unsigned)wid * 1024u;
    const int aoff = lds_byte(wr * 64 + fr, fq * 8), boff = lds_byte(wc * 32 + fr, fq * 8);
#define PG8_SA(b, h) (((b) * 2 + (h)) * HTB)
#define PG8_SB(b, h) ((4 + (b) * 2 + (h)) * HTB)
#define PG8_STAGE(bufoff, gbase, voff) do { _Pragma("unroll") for (int _i = 0; _i < 2; ++_i) \
        __builtin_amdgcn_global_load_lds((const unsigned*)((const char*)(gbase) + (voff)[_i]), (PG8_LAS unsigned*)(lds + (bufoff) + ldsw + _i * 8192), 16, 0, 0); } while (0)
#define PG8_LDA(dst, b, h) do { _Pragma("unroll") for (int m = 0; m < 4; ++m) _Pragma("unroll") for (int k = 0; k < 2; ++k) dst[m][k] = *(const PG8_LAS bf16x8*)(lds + PG8_SA(b, h) + aoff + m * 2048 + k * 1024); } while (0)
#define PG8_LDB(dst, b, h) do { _Pragma("unroll") for (int n = 0; n < 2; ++n) _Pragma("unroll") for (int k = 0; k < 2; ++k) dst[n][k] = *(const PG8_LAS bf16x8*)(lds + PG8_SB(b, h) + boff + n * 2048 + k * 1024); } while (0)
#define PG8_MMA(ai, bj, At, Bt) do { __builtin_amdgcn_s_setprio(1); _Pragma("unroll") for (int m = 0; m < 4; ++m) _Pragma("unroll") for (int n = 0; n < 2; ++n) _Pragma("unroll") for (int k = 0; k < 2; ++k) \
        acc[ai][bj][m][n] = __builtin_amdgcn_mfma_f32_16x16x32_bf16(Bt[n][k], At[m][k], acc[ai][bj][m][n], 0, 0, 0); __builtin_amdgcn_s_setprio(0); } while (0)
#define PG8_WAIT_V(n) asm volatile("s_waitcnt vmcnt(" #n ")" ::: "memory")
#define PG8_WAIT_L(n) asm volatile("s_waitcnt lgkmcnt(" #n ")" ::: "memory")
#define PG8_BAR __builtin_amdgcn_s_barrier()
#define PG8_SCHED __builtin_amdgcn_sched_barrier(0)
    Unit cur, nxt; int ui = 0;
    if (!S.next(0, cur)) return;
    f32x4 acc[2][2][4][2];
#pragma unroll
    for (int a = 0; a < 2; ++a)
#pragma unroll
        for (int b = 0; b < 2; ++b)
#pragma unroll
            for (int m = 0; m < 4; ++m)
#pragma unroll
                for (int n = 0; n < 2; ++n) acc[a][b][m][n] = (f32x4){0.f, 0.f, 0.f, 0.f};
    bf16x8 At[4][2], B0[2][2], B1[2][2];
    const char* cA = a_base(g, cur); const char* cB = b_base(g, cur);
    S.a_ready(cur);
    if constexpr (SP2) {
        PG8_STAGE(PG8_SB(0, 0), cB, voffB); PG8_STAGE(PG8_SB(0, 1), cB + hstep, voffB); PG8_STAGE(PG8_SA(0, 0), cA, voffA); PG8_STAGE(PG8_SA(0, 1), cA + hstep, voffA);
        if (wr == 1) PG8_BAR;
        PG8_WAIT_V(2); PG8_BAR;
        PG8_STAGE(PG8_SB(1, 0), cB + kstep, voffB); PG8_STAGE(PG8_SA(1, 0), cA + kstep, voffA); PG8_STAGE(PG8_SB(1, 1), cB + hstep + kstep, voffB);
        PG8_WAIT_V(6); PG8_BAR;
    } else {
        PG8_STAGE(PG8_SB(0, 0), cB, voffB); PG8_STAGE(PG8_SA(0, 0), cA, voffA); PG8_STAGE(PG8_SB(0, 1), cB + hstep, voffB); PG8_STAGE(PG8_SA(0, 1), cA + hstep, voffA);
        if (wr == 1) PG8_BAR;
        PG8_WAIT_V(4); PG8_BAR;
        PG8_STAGE(PG8_SB(1, 0), cB + kstep, voffB); PG8_STAGE(PG8_SA(1, 0), cA + kstep, voffA); PG8_STAGE(PG8_SB(1, 1), cB + hstep + kstep, voffB);
        PG8_WAIT_V(6); PG8_BAR;
    }
    for (;;) {
        const bool has_next = S.next(ui + 1, nxt);
        const char* nA = has_next ? a_base(g, nxt) : cA; const char* nB = has_next ? b_base(g, nxt) : cB;
        for (int t = 0; t < nt; t += 2) {
            const bool last = (t == nt - 2);
            const char* a1 = cA + (size_t)(t + 1) * kstep;
            const char* a2 = last ? nA : cA + (size_t)(t + 2) * kstep; const char* b2 = last ? nB : cB + (size_t)(t + 2) * kstep;
            const char* a3 = a2 + kstep; const char* b3 = b2 + kstep;
            if (last && has_next) S.a_ready(nxt);
            if constexpr (SP2) {
            PG8_LDB(B0, 0, 0); PG8_LDB(B1, 0, 1); PG8_SCHED; PG8_LDA(At, 0, 0); PG8_STAGE(PG8_SA(1, 1), a1 + hstep, voffA);
            PG8_WAIT_V(8); PG8_WAIT_L(0); PG8_BAR; PG8_MMA(0, 0, At, B0); PG8_MMA(0, 1, At, B1); PG8_BAR; PG8_SCHED;
            PG8_LDA(At, 0, 1); PG8_STAGE(PG8_SB(0, 0), b2, voffB); PG8_STAGE(PG8_SB(0, 1), b2 + hstep, voffB); PG8_STAGE(PG8_SA(0, 0), a2, voffA);
            PG8_WAIT_V(8); PG8_WAIT_L(0); PG8_BAR; PG8_MMA(1, 0, At, B0); PG8_MMA(1, 1, At, B1); PG8_BAR; PG8_SCHED;
            PG8_LDB(B0, 1, 0); PG8_LDB(B1, 1, 1); PG8_SCHED; PG8_LDA(At, 1, 0); PG8_STAGE(PG8_SA(0, 1), a2 + hstep, voffA);
            PG8_WAIT_V(8); PG8_WAIT_L(0); PG8_BAR; PG8_MMA(0, 0, At, B0); PG8_MMA(0, 1, At, B1); PG8_BAR; PG8_SCHED;
            PG8_LDA(At, 1, 1); PG8_STAGE(PG8_SB(1, 0), b3, voffB); PG8_STAGE(PG8_SB(1, 1), b3 + hstep, voffB); PG8_STAGE(PG8_SA(1, 0), a3, voffA);
            PG8_WAIT_V(8); PG8_WAIT_L(0); PG8_BAR; PG8_MMA(1, 0, At, B0); PG8_MMA(1, 1, At, B1); PG8_BAR; PG8_SCHED;
            } else {
            PG8_LDB(B0, 0, 0); PG8_SCHED; PG8_LDA(At, 0, 0); PG8_STAGE(PG8_SA(1, 1), a1 + hstep, voffA);
            PG8_WAIT_L(8); PG8_BAR; PG8_WAIT_L(0); PG8_MMA(0, 0, At, B0); PG8_BAR; PG8_SCHED;
            PG8_LDB(B1, 0, 1); PG8_STAGE(PG8_SB(0, 0), b2, voffB);
            PG8_BAR; PG8_WAIT_L(0); PG8_MMA(0, 1, At, B1); PG8_BAR;
            PG8_LDA(At, 0, 1); PG8_STAGE(PG8_SA(0, 0), a2, voffA);
            PG8_BAR; PG8_WAIT_L(0); PG8_MMA(1, 0, At, B0); PG8_BAR; PG8_SCHED;
            PG8_STAGE(PG8_SB(0, 1), b2 + hstep, voffB);
            PG8_WAIT_V(6); PG8_BAR; PG8_MMA(1, 1, At, B1); PG8_BAR;
            PG8_LDB(B0, 1, 0); PG8_SCHED; PG8_LDA(At, 1, 0); PG8_STAGE(PG8_SA(0, 1), a2 + hstep, voffA);
            PG8_WAIT_L(8); PG8_BAR; PG8_WAIT_L(0); PG8_MMA(0, 0, At, B0); PG8_BAR; PG8_SCHED;
            PG8_LDB(B1, 1, 1); PG8_STAGE(PG8_SB(1, 0), b3, voffB);
            PG8_BAR; PG8_WAIT_L(0); PG8_MMA(0, 1, At, B1); PG8_BAR;
            PG8_LDA(At, 1, 1); PG8_STAGE(PG8_SA(1, 0), a3, voffA);
            PG8_BAR; PG8_WAIT_L(0); PG8_MMA(1, 0, At, B0); PG8_BAR; PG8_SCHED;
            PG8_STAGE(PG8_SB(1, 1), b3 + hstep, voffB);
            PG8_WAIT_V(6); PG8_BAR; PG8_MMA(1, 1, At, B1); PG8_BAR;
            }
        }
        if constexpr (ALIGN_EPI) { if (wr == 0) PG8_BAR; }
        bool keep_acc = false;
        if constexpr (has_twoseg<Epi>::value) { if (cur.seg == 0) { E.mid(acc, cur, wr, wc, fr, fq); keep_acc = true; } else { E(acc, cur, wr, wc, fr, fq); } }
        else if constexpr (!Epi::AFTER_DRAIN) { E(acc, cur, wr, wc, fr, fq); S.done(cur); }
        if (!has_next) break;
        if (!keep_acc)
#pragma unroll
        for (int a = 0; a < 2; ++a)
#pragma unroll
            for (int b = 0; b < 2; ++b)
#pragma unroll
                for (int m = 0; m < 4; ++m)
#pragma unroll
                    for (int n = 0; n < 2; ++n) acc[a][b][m][n] = (f32x4){0.f, 0.f, 0.f, 0.f};
        cur = nxt; cA = nA; cB = nB; ++ui;
        if constexpr (ALIGN_EPI) { if (wr == 1) PG8_BAR; }
    }
    PG8_WAIT_V(0);
    if constexpr (!ALIGN_EPI) { if (wr == 0) PG8_BAR; }
    PG8_BAR;
    if constexpr (Epi::AFTER_DRAIN) { E.fused(acc, cur, wr, wc, fr, fq, lds, wid, lane); S.done(cur); }
#undef PG8_SA
#undef PG8_SB
#undef PG8_STAGE
#undef PG8_LDA
#undef PG8_LDB
#undef PG8_MMA
#undef PG8_WAIT_V
#undef PG8_WAIT_L
#undef PG8_BAR
#undef PG8_SCHED
}
}
namespace attn_body {
using bf16=__hip_bfloat16;
using bf16x8=__attribute__((ext_vector_type(8)))short;
using s16x4=__attribute__((ext_vector_type(4)))short;
using f32x16=__attribute__((ext_vector_type(16)))float;
using u32x4=__attribute__((ext_vector_type(4)))unsigned;
constexpr int D=64,PQ=1024,PO=2048,LP=8320;
constexpr int NW=8,QBLK=32,QB=QBLK*NW,KVBLK=64,NQB=32;
__device__ __forceinline__ int crow(int r,int hi){return (r&3)+8*(r>>2)+4*hi;}
#define SBAR() __builtin_amdgcn_sched_barrier(0)
__device__ __forceinline__ void cmask(f32x16&p0,f32x16&p1,int jb,int qrel,int hi){
  const float NEG=-INFINITY; int kb=64*jb+4*hi;
  #pragma unroll
  for(int r=0;r<16;++r){int kv=kb+(r&3)+8*(r>>2); if(kv>qrel)p0[r]=NEG; if(kv+32>qrel)p1[r]=NEG;}
}

constexpr int NSLOT=3, SLOTB=8192;
constexpr int LDS_K=0, LDS_V=NSLOT*SLOTB, LDS_WS=2*NSLOT*SLOTB, LDS_OST=LDS_WS+NW*64*4, LDS_BYTES=LDS_OST+NW*4096;
constexpr float C2=0.125f*1.4426950408889634f;
__device__ __forceinline__ void glds16(const void*gsrc,unsigned lds_dst){unsigned keep;
  asm volatile("s_mov_b32 %0, m0\n\ts_mov_b32 m0, %2\n\ts_nop 0\n\tglobal_load_lds_dwordx4 %1, off\n\ts_mov_b32 m0, %0":"=&s"(keep):"v"(gsrc),"s"(lds_dst):"memory");}
__device__ __forceinline__ float max3f(float a,float b,float c){float r;asm("v_max3_f32 %0, %1, %2, %3":"=v"(r):"v"(a),"v"(b),"v"(c));return r;}
__device__ __forceinline__ float max2f(float a,float b){float r;asm("v_max_f32_e32 %0, %1, %2":"=v"(r):"v"(a),"v"(b));return r;}
__device__ __forceinline__ float fadd_s(float a,float b){float r;asm("v_add_f32_e32 %0, %1, %2":"=v"(r):"v"(a),"v"(b));return r;}
__device__ __forceinline__ float fsub_s(float a,float b){float r;asm("v_sub_f32_e32 %0, %1, %2":"=v"(r):"v"(a),"v"(b));return r;}
typedef float f32x2_t __attribute__((ext_vector_type(2))); typedef __bf16 bf16x2_t __attribute__((ext_vector_type(2)));
__device__ __forceinline__ unsigned cvtpk_s(float lo,float hi){f32x2_t v={lo,hi};bf16x2_t b=__builtin_convertvector(v,bf16x2_t);return __builtin_bit_cast(unsigned,b);}
#define WAIT_BAR(N) asm volatile("s_waitcnt vmcnt(" #N ") lgkmcnt(0)\n\ts_barrier":::"memory")

__device__ __forceinline__ void qkt(f32x16&p0,f32x16&p1,const char*Kslot,const bf16x8*qr,const f32x16&ci0,const f32x16&ci1,int r32,int hi){
  const char*kb=Kslot+hi*1024+r32*16;
  #pragma unroll
  for(int d0=0;d0<4;++d0){
    const bf16x8 b0=*reinterpret_cast<const bf16x8*>(kb+d0*2048);
    const bf16x8 b1=*reinterpret_cast<const bf16x8*>(kb+d0*2048+512);
    if(d0==0){p0=__builtin_amdgcn_mfma_f32_32x32x16_bf16(b0,qr[0],ci0,0,0,0);p1=__builtin_amdgcn_mfma_f32_32x32x16_bf16(b1,qr[0],ci1,0,0,0);}
    else{p0=__builtin_amdgcn_mfma_f32_32x32x16_bf16(b0,qr[d0],p0,0,0,0);p1=__builtin_amdgcn_mfma_f32_32x32x16_bf16(b1,qr[d0],p1,0,0,0);}}
}
typedef __attribute__((address_space(3))) const char* lds_cptr;
typedef short v4i16_t __attribute__((ext_vector_type(4)));
__device__ __forceinline__ void kload8(bf16x8*kf,lds_cptr kp){
  kf[0]=*(const __attribute__((address_space(3))) bf16x8*)(kp);      kf[1]=*(const __attribute__((address_space(3))) bf16x8*)(kp+512);
  kf[2]=*(const __attribute__((address_space(3))) bf16x8*)(kp+2048); kf[3]=*(const __attribute__((address_space(3))) bf16x8*)(kp+2560);
  kf[4]=*(const __attribute__((address_space(3))) bf16x8*)(kp+4096); kf[5]=*(const __attribute__((address_space(3))) bf16x8*)(kp+4608);
  kf[6]=*(const __attribute__((address_space(3))) bf16x8*)(kp+6144); kf[7]=*(const __attribute__((address_space(3))) bf16x8*)(kp+6656);
}
__device__ __forceinline__ void kload2(bf16x8*kf,lds_cptr kp,int j){ kf[2*j]=*(const __attribute__((address_space(3))) bf16x8*)(kp+j*2048); kf[2*j+1]=*(const __attribute__((address_space(3))) bf16x8*)(kp+j*2048+512); }
__device__ __forceinline__ s16x4 vtr(lds_cptr p){ return __builtin_bit_cast(s16x4,__builtin_amdgcn_ds_read_tr16_b64_v4i16((__attribute__((address_space(3))) v4i16_t*)p)); }
__device__ __forceinline__ float rowmax(const f32x16&p0,const f32x16&p1){
  float a=max3f(p0[0],p0[1],p1[0]),b=max3f(p0[2],p0[3],p1[1]);a=max3f(a,p1[2],p1[3]);
  #pragma unroll
  for(int r=4;r<16;r+=4){a=max3f(a,p0[r],p0[r+1]);b=max3f(b,p0[r+2],p0[r+3]);a=max3f(a,p1[r],p1[r+1]);b=max3f(b,p1[r+2],p1[r+3]);}
  const float m=max2f(a,b);
  auto rr=__builtin_amdgcn_permlane32_swap(__float_as_uint(m),__float_as_uint(m),false,false);
  return max2f(__uint_as_float(rr[0]),__uint_as_float(rr[1]));
}
__device__ __forceinline__ void pv(f32x16*o,int vb,bf16x8 pa0,bf16x8 pa1,bf16x8 pa2,bf16x8 pa3){
  #pragma unroll
  for(int d0=0;d0<2;++d0){s16x4 lo[4],hi[4];
    #pragma unroll
    for(int ks=0;ks<4;++ks){
      asm volatile("ds_read_b64_tr_b16 %0,%1 offset:%c2":"=&v"(lo[ks]):"v"(vb),"i"(d0*4096+ks*1024):"memory");
      asm volatile("ds_read_b64_tr_b16 %0,%1 offset:%c2":"=&v"(hi[ks]):"v"(vb),"i"(d0*4096+ks*1024+512):"memory");}
    asm volatile("s_waitcnt lgkmcnt(0)":::"memory");SBAR();
    #define PK(k) (bf16x8){lo[k][0],lo[k][1],lo[k][2],lo[k][3],hi[k][0],hi[k][1],hi[k][2],hi[k][3]}
    o[d0]=__builtin_amdgcn_mfma_f32_32x32x16_bf16(pa0,PK(0),o[d0],0,0,0);
    o[d0]=__builtin_amdgcn_mfma_f32_32x32x16_bf16(pa1,PK(1),o[d0],0,0,0);
    o[d0]=__builtin_amdgcn_mfma_f32_32x32x16_bf16(pa2,PK(2),o[d0],0,0,0);
    o[d0]=__builtin_amdgcn_mfma_f32_32x32x16_bf16(pa3,PK(3),o[d0],0,0,0);
    #undef PK
  }
}

#ifndef ATTN_STORE16
#define ATTN_STORE16(p,v) (*(u32x4*)(p)=(v))
#endif
template<int THRL> __device__ __forceinline__ void attn_unit(int b,int h,int c,int vh,int qb,int t0,const bf16*Q,const bf16*__restrict__ K,const bf16*__restrict__ V,bf16*O,char*shm){
  int tid_=threadIdx.x; asm volatile("":"+v"(tid_)); const int tid=tid_,lane=tid&63,r32=lane&31,hi=lane>>5; const int wid=__builtin_amdgcn_readfirstlane(tid>>6);
  const long rowbase=(long)b*LP+64; const int q0=64+qb*QB;
  const bf16*Qw=Q+(rowbase+q0+wid*QBLK)*PQ+h*128+c*64;
  const bf16*Kh=K+(rowbase+(long)t0*KVBLK)*PQ+h*128+c*64,*Vh=V+(rowbase+(long)t0*KVBLK)*PQ+h*128+vh*64;
  const float s2=__builtin_amdgcn_exp2f(-(float)(h+1))*1.4426950408889634f;
  const unsigned lds0=(unsigned)(uintptr_t)shm;
  float*wsf=(float*)(shm+LDS_WS)+wid*64;
  const bf16*ksrc=Kh+(long)lane*PQ+wid*8;
  const bf16*vsrc=Vh+(long)(16*(wid&3)+(lane>>2))*PQ+(wid>>2)*32+(lane&3)*8;
  const unsigned kdst=lds0+LDS_K+wid*1024, vdst=lds0+LDS_V+wid*1024;
  #define DMA_K(t,slot) glds16(ksrc+(long)(t)*KVBLK*PQ,(unsigned)__builtin_amdgcn_readfirstlane(kdst+(slot)))
  #define DMA_V(t,slot) glds16(vsrc+(long)(t)*KVBLK*PQ,(unsigned)__builtin_amdgcn_readfirstlane(vdst+(slot)))
  const int vb0=(int)(lds0+LDS_V)+((lane>>4)&1)*32+(lane&3)*8+(4*hi+((lane&15)>>2))*64;
  const char*Kbase=shm+LDS_K; bf16x8 kf[8];
  const lds_cptr shm3=(lds_cptr)shm; const lds_cptr kp0=shm3+LDS_K+hi*1024+r32*16; const lds_cptr vp0=shm3+LDS_V+((lane>>4)&1)*32+(lane&3)*8+(4*hi+((lane&15)>>2))*64;
  const int NT=(q0+QB)/KVBLK-t0;
  DMA_K(0,0);DMA_V(0,0);DMA_K(1,SLOTB);
  bf16x8 qr[4];
  #pragma unroll
  for(int d0=0;d0<4;++d0)qr[d0]=*reinterpret_cast<const bf16x8*>(&Qw[(long)r32*PQ+d0*16+hi*8]);
  float mhat=0.f,l_reg=0.f;f32x16 o[2];o[0]=f32x16{};o[1]=f32x16{};
  #define RFL(x) __uint_as_float((unsigned)__builtin_amdgcn_readfirstlane((int)__float_as_uint(x)))
  const float s2x1=RFL(s2),s2x2=RFL(2.f*s2),s2x3=RFL(3.f*s2),s2x8=RFL(8.f*s2),s2x16=RFL(16.f*s2),s2x24=RFL(24.f*s2),s2_32=RFL(32.f*s2),s2_64=RFL(64.f*s2);
  const float hi4=hi?4.f*s2:0.f;
  #define CINIT(C0,C1,t) do{ const float tbh_=(s2_64*(float)((t)-(NT-4))-mhat)+hi4; \
    { const float g0_=tbh_,g1_=tbh_+s2x8,g2_=tbh_+s2x16,g3_=tbh_+s2x24; \
      C0[0]=g0_;C0[1]=g0_+s2x1;C0[2]=g0_+s2x2;C0[3]=g0_+s2x3; C0[4]=g1_;C0[5]=g1_+s2x1;C0[6]=g1_+s2x2;C0[7]=g1_+s2x3; \
      C0[8]=g2_;C0[9]=g2_+s2x1;C0[10]=g2_+s2x2;C0[11]=g2_+s2x3; C0[12]=g3_;C0[13]=g3_+s2x1;C0[14]=g3_+s2x2;C0[15]=g3_+s2x3; } \
    _Pragma("unroll") for(int r=0;r<16;++r)C1[r]=C0[r]+s2_32; }while(0)
  const int qrel=wid*QBLK+r32;
  #define CMASK(P0,P1,t) do{int jb_=(t)-(NT-4); if(jb_>=0)cmask(P0,P1,jb_,qrel,hi);}while(0)
  bool resc=false;
  #define START(P0,P1) do{ const float rm=rowmax(P0,P1); resc=false; \
    { const float dl=rm; mhat=fadd_s(mhat,dl); \
      _Pragma("unroll") for(int r=0;r<16;++r){P0[r]=fsub_s(P0[r],dl);P1[r]=fsub_s(P1[r],dl);} } \
    _Pragma("unroll") for(int r=0;r<16;++r)P0[r]=__builtin_amdgcn_exp2f(P0[r]); }while(0)
  #define RESC() do{ if(resc){ asm volatile("s_waitcnt lgkmcnt(0)":::"memory"); \
      _Pragma("unroll") for(int d_=0;d_<2;++d_) _Pragma("unroll") for(int r=0;r<16;++r)o[d_][r]*=wsf[crow(r,hi)]; } }while(0)
  f32x16 pA0,pA1,pB0,pB1;
  int sl_prev=0,sl_cur=0,sl_next=SLOTB;
  #define ROT() do{sl_prev=sl_cur;sl_cur=sl_next;sl_next=(sl_next==(NSLOT-1)*SLOTB)?0:sl_next+SLOTB;}while(0)
  DMA_K(2,2*SLOTB);
  WAIT_BAR(3);
  { f32x16 ci0,ci1; CINIT(ci0,ci1,0); qkt(pA0,pA1,Kbase,qr,ci0,ci1,r32,hi); } asm volatile("s_nop 15\n\ts_nop 7":"+v"(pA0),"+v"(pA1));
  if(t0==0){ const float NEGI=-INFINITY; _Pragma("unroll") for(int r=0;r<16;++r)pA0[r]=NEGI; _Pragma("unroll") for(int r=0;r<8;++r)pA1[r]=NEGI; }
  START(pA0,pA1);
  _Pragma("unroll") for(int r=0;r<16;++r)pA1[r]=__builtin_amdgcn_exp2f(pA1[r]);
  WAIT_BAR(0);
  DMA_K(3,0);DMA_V(1,SLOTB);
  ROT();
  kload8(kf,kp0+sl_cur);
  WAIT_BAR(2);
  s16x4 vlo[8],vhi[8]; u32x4 pw0,pw1,pw2,pw3;
  #define PKW(P,B) cvtpk_s(P[B],P[B+1])
  #define PAF(k) __builtin_bit_cast(bf16x8,pw##k)
  #define VFR(i) (bf16x8){vlo[i][0],vlo[i][1],vlo[i][2],vlo[i][3],vhi[i][0],vhi[i][1],vhi[i][2],vhi[i][3]}
  #define PIN(x) asm volatile("":"+v"(x))
  #define MX3(a,b,c) __builtin_fmaxf(__builtin_fmaxf((a),(b)),(c))
  #define GAPA(MF,A0,A1,A2,A3,W0,W1,PW) do{ MF; sacc+=A0; sacc+=A1; sacc+=A2; sacc+=A3; PIN(sacc); W0; W1; PIN(PW); SBAR(); }while(0)
  #define EX(v) __builtin_amdgcn_exp2f(v)
  #define GAPB(MF,X,B,INI) do{ MF; X[B]=EX(X[B]); X[B+1]=EX(X[B+1]); X[B+2]=EX(X[B+2]); X[B+3]=EX(X[B+3]); PIN(X); INI; SBAR(); }while(0)
  #define NI0(P,g) do{ P[4*(g)]=gn##g##_; P[4*(g)+1]=gn##g##_+s2x1; P[4*(g)+2]=gn##g##_+s2x2; P[4*(g)+3]=gn##g##_+s2x3; PIN(P); }while(0)
  #define NI1(P1,P0,g) do{ P1[4*(g)]=P0[4*(g)]+s2_32; P1[4*(g)+1]=P0[4*(g)+1]+s2_32; P1[4*(g)+2]=P0[4*(g)+2]+s2_32; P1[4*(g)+3]=P0[4*(g)+3]+s2_32; PIN(P1); }while(0)
  #define VRD(i) do{ vlo[i]=vtr(vp_+(((i)>>2)*4096+((i)&3)*1024)); vhi[i]=vtr(vp_+(((i)>>2)*4096+((i)&3)*1024+512)); }while(0)
  #define KRD(G,j) do{ if(G){ kload2(kf,kp0+sl_next,j); SBAR(); } }while(0)
  #define STEP(C0,C1,P0,P1,t,GK,GV,GL) do{ SBAR(); \
    const lds_cptr vp_=vp0+sl_prev; \
    VRD(0); SBAR(); float sacc=(P0[0]+P0[1]); \
    GAPA(C0=__builtin_amdgcn_mfma_f32_32x32x16_bf16(kf[0],qr[0],C0,0,0,0), P0[2],P0[3],P0[4],P0[5],     pw0[0]=PKW(P0,0), pw0[1]=PKW(P0,2), pw0); \
    VRD(4); SBAR(); GAPA(C1=__builtin_amdgcn_mfma_f32_32x32x16_bf16(kf[1],qr[0],C1,0,0,0), P0[6],P0[7],P0[8],P0[9],     pw0[2]=PKW(P0,4), pw0[3]=PKW(P0,6), pw0); \
    VRD(1); SBAR(); GAPA(C0=__builtin_amdgcn_mfma_f32_32x32x16_bf16(kf[2],qr[1],C0,0,0,0),   P0[10],P0[11],P0[12],P0[13], pw1[0]=PKW(P0,8), pw1[1]=PKW(P0,10), pw1); \
    VRD(5); SBAR(); GAPA(C1=__builtin_amdgcn_mfma_f32_32x32x16_bf16(kf[3],qr[1],C1,0,0,0),   P0[14],P0[15],P1[0],P1[1],   pw1[2]=PKW(P0,12),pw1[3]=PKW(P0,14), pw1); \
    VRD(2); SBAR(); GAPA(C0=__builtin_amdgcn_mfma_f32_32x32x16_bf16(kf[4],qr[2],C0,0,0,0),   P1[2],P1[3],P1[4],P1[5],     pw2[0]=PKW(P1,0), pw2[1]=PKW(P1,2), pw2); \
    VRD(6); SBAR(); GAPA(C1=__builtin_amdgcn_mfma_f32_32x32x16_bf16(kf[5],qr[2],C1,0,0,0),   P1[6],P1[7],P1[8],P1[9],     pw2[2]=PKW(P1,4), pw2[3]=PKW(P1,6), pw2); \
    VRD(3); SBAR(); GAPA(C0=__builtin_amdgcn_mfma_f32_32x32x16_bf16(kf[6],qr[3],C0,0,0,0),   P1[10],P1[11],P1[12],P1[13], pw3[0]=PKW(P1,8), pw3[1]=PKW(P1,10), pw3); \
    VRD(7); SBAR(); GAPA(C1=__builtin_amdgcn_mfma_f32_32x32x16_bf16(kf[7],qr[3],C1,0,0,0),   P1[14],P1[15],0.f,0.f,       pw3[2]=PKW(P1,12),pw3[3]=PKW(P1,14), pw3); \
    l_reg+=sacc; \
    if(GK){DMA_K((t)+3,sl_cur);} if(GV){DMA_V((t)+1,sl_next);} \
    CMASK(C0,C1,t); \
    { float a=MX3(C0[0],C0[1],C1[0]),b=MX3(C0[2],C0[3],C1[1]); a=MX3(a,C1[2],C1[3]); \
      _Pragma("unroll") for(int r=4;r<16;r+=4){a=MX3(a,C0[r],C0[r+1]);b=MX3(b,C0[r+2],C0[r+3]);a=MX3(a,C1[r],C1[r+1]);b=MX3(b,C1[r+2],C1[r+3]);} \
      float rm=__builtin_fmaxf(a,b); { auto rr=__builtin_amdgcn_permlane32_swap(__float_as_uint(rm),__float_as_uint(rm),false,false); rm=__builtin_fmaxf(__uint_as_float(rr[0]),__uint_as_float(rr[1])); } \
      resc=false; \
      if(__builtin_expect(__any(rm>(float)THRL),0)){ const float dl=__builtin_fmaxf(rm,0.f); mhat+=dl; \
        _Pragma("unroll") for(int r=0;r<16;++r){C0[r]-=dl;C1[r]-=dl;} \
        const float f=__builtin_amdgcn_exp2f(-dl); l_reg*=f; if(hi==0)wsf[r32]=f; resc=true; } } \
    SBAR(); \
    const float gn0_=(s2_64*(float)(((t)+1)-(NT-4))-mhat)+hi4, gn1_=gn0_+s2x8, gn2_=gn0_+s2x16, gn3_=gn0_+s2x24; \
    GAPB(o[0]=__builtin_amdgcn_mfma_f32_32x32x16_bf16(PAF(0),VFR(0),o[0],0,0,0), C0,0, NI0(P0,0)); \
    GAPB(o[1]=__builtin_amdgcn_mfma_f32_32x32x16_bf16(PAF(0),VFR(4),o[1],0,0,0), C0,4, NI0(P0,1)); \
    KRD(GL,0); GAPB(o[0]=__builtin_amdgcn_mfma_f32_32x32x16_bf16(PAF(1),VFR(1),o[0],0,0,0), C0,8, NI0(P0,2)); \
    KRD(GL,1); GAPB(o[1]=__builtin_amdgcn_mfma_f32_32x32x16_bf16(PAF(1),VFR(5),o[1],0,0,0), C0,12, NI0(P0,3)); \
    KRD(GL,2); GAPB(o[0]=__builtin_amdgcn_mfma_f32_32x32x16_bf16(PAF(2),VFR(2),o[0],0,0,0), C1,0, NI1(P1,P0,0)); \
    KRD(GL,3); GAPB(o[1]=__builtin_amdgcn_mfma_f32_32x32x16_bf16(PAF(2),VFR(6),o[1],0,0,0), C1,4, NI1(P1,P0,1)); \
    GAPB(o[0]=__builtin_amdgcn_mfma_f32_32x32x16_bf16(PAF(3),VFR(3),o[0],0,0,0), C1,8, NI1(P1,P0,2)); \
    GAPB(o[1]=__builtin_amdgcn_mfma_f32_32x32x16_bf16(PAF(3),VFR(7),o[1],0,0,0), C1,12, NI1(P1,P0,3)); \
    }while(0)
  CINIT(pB0,pB1,1);
  int t=1;
  #undef CMASK
  #define CMASK(P0,P1,t) do{}while(0)
  for(;t+5<NT;t+=2){
    STEP(pB0,pB1,pA0,pA1,t,true,true,true);     WAIT_BAR(2); RESC(); ROT();
    STEP(pA0,pA1,pB0,pB1,t+1,true,true,true);   WAIT_BAR(2); RESC(); ROT();
  }
  #undef CMASK
  #define CMASK(P0,P1,t) do{int jb_=(t)-(NT-4); if(jb_>=0)cmask(P0,P1,jb_,qrel,hi);}while(0)
  #define ENDW(tt) do{ if((tt)+3<NT){WAIT_BAR(2);} else if((tt)+2<NT){WAIT_BAR(1);} else {WAIT_BAR(0);} }while(0)
  for(;t+2<NT;t+=2){
    STEP(pB0,pB1,pA0,pA1,t,(t+3<NT),(t+1<NT),(t+1<NT));       ENDW(t);   RESC(); ROT();
    STEP(pA0,pA1,pB0,pB1,t+1,(t+4<NT),(t+2<NT),(t+2<NT));     ENDW(t+1); RESC(); ROT();
  }
  STEP(pB0,pB1,pA0,pA1,NT-2,false,true,true);   ENDW(NT-2); RESC(); ROT();
  STEP(pA0,pA1,pB0,pB1,NT-1,false,false,false); RESC();
  { float sacc=pA0[0]+pA0[1]; _Pragma("unroll") for(int r=2;r<16;++r)sacc+=pA0[r]; _Pragma("unroll") for(int r=0;r<16;++r)sacc+=pA1[r]; l_reg+=sacc;
    pw0=(u32x4){PKW(pA0,0),PKW(pA0,2),PKW(pA0,4),PKW(pA0,6)};pw1=(u32x4){PKW(pA0,8),PKW(pA0,10),PKW(pA0,12),PKW(pA0,14)};pw2=(u32x4){PKW(pA1,0),PKW(pA1,2),PKW(pA1,4),PKW(pA1,6)};pw3=(u32x4){PKW(pA1,8),PKW(pA1,10),PKW(pA1,12),PKW(pA1,14)};
    SBAR(); pv(o,vb0+sl_cur,PAF(0),PAF(1),PAF(2),PAF(3)); }
  #undef PKW
  #undef PAF
  #undef VFR
  #undef PIN
  #undef MX3
  #undef GAPA
  #undef GAPB
  #undef NI0
  #undef NI1
  #undef EX
  #undef VRD
  #undef KRD
  #undef STEP
  #undef ENDW
  {auto rr=__builtin_amdgcn_permlane32_swap(__float_as_uint(l_reg),__float_as_uint(l_reg),false,false);l_reg=__uint_as_float(rr[0])+__uint_as_float(rr[1]);}
  if(hi==0)wsf[32+r32]=l_reg;asm volatile("s_waitcnt lgkmcnt(0)":::"memory");
  float rli[16];
  #pragma unroll
  for(int r=0;r<16;++r)rli[r]=__builtin_amdgcn_rcpf(wsf[32+crow(r,hi)]);
  bf16*Ow=O+(rowbase+q0+wid*QBLK)*PO+c*1024+h*128+vh*64;
  { bf16*stg=(bf16*)(shm+LDS_OST)+wid*2048;
    #pragma unroll
    for(int r=0;r<16;++r){const int orow=crow(r,hi);
      #pragma unroll
      for(int d0=0;d0<2;++d0)stg[orow*64+d0*32+r32]=__float2bfloat16(o[d0][r]*rli[r]);}
    asm volatile("s_waitcnt lgkmcnt(0)":::"memory");
    #pragma unroll
    for(int i=0;i<4;++i){const int row=i*8+(lane>>3),ch=lane&7; const u32x4 v=*(const u32x4*)(stg+row*64+ch*8); ATTN_STORE16(Ow+(long)row*PO+ch*8,v);} }
  asm volatile("s_waitcnt lgkmcnt(0)\n\ts_barrier":::"memory");
  #undef DMA_K
  #undef DMA_V
  #undef CINIT
  #undef RFL
  #undef CMASK
  #undef START
  #undef RESC
  #undef ROT
}
constexpr int ATTN_LDS_BYTES=LDS_BYTES;
struct AttnUnit { int b,h,c,vh,qb; };
struct AttnTensors { const bf16* Q; const bf16* K; const bf16* V; bf16* O; const float* NORM; unsigned* qctr; };
template<int THRL=8> __device__ __forceinline__ void attn_phase(char*lds,const AttnTensors&T){
  typedef __attribute__((address_space(3))) unsigned lu32;
  lu32* slot=(lu32*)((__attribute__((address_space(3))) char*)lds+LDS_BYTES+32);
  unsigned nxt=0u; if(threadIdx.x==0)nxt=atomicAdd(T.qctr,1u);
  for(;;){
    if(threadIdx.x==0){ *slot=nxt; nxt=atomicAdd(T.qctr,1u); }
    asm volatile("s_waitcnt lgkmcnt(0)\n\ts_barrier":::"memory");
    const unsigned u=(unsigned)__builtin_amdgcn_readfirstlane((int)*slot);
    if(u>=4096u)break;
    const int qb=31-(int)(u&31u),cr=(int)(u>>5),h=7-(cr>>4),b=(cr>>2)&3,c=(cr>>1)&1,vh=cr&1;
    const float* nq=T.NORM+((0*8+h)*2+c)*2; const float* nk=T.NORM+((1*8+h)*2+c)*2;
    const float q2=__hip_atomic_load(nq,__ATOMIC_RELAXED,__HIP_MEMORY_SCOPE_AGENT)+__hip_atomic_load(nq+1,__ATOMIC_RELAXED,__HIP_MEMORY_SCOPE_AGENT);
    const float k2=__hip_atomic_load(nk,__ATOMIC_RELAXED,__HIP_MEMORY_SCOPE_AGENT)+__hip_atomic_load(nk+1,__ATOMIC_RELAXED,__HIP_MEMORY_SCOPE_AGENT);
    const float S=1.02f*sqrtf(q2*k2);
    const float s2=__builtin_amdgcn_exp2f(-(float)(h+1))*1.4426950408889634f;
    const float Dd=(150.f+2.f*S)/s2;
    const int q0=64+qb*QB, NTfull=(q0+QB)/KVBLK;
    int t0=0; { const float lim=(float)(q0-63)-Dd; if(lim>=0.f){ t0=(int)(lim*(1.f/64.f))+1; } }
    t0&=~1; if(t0>NTfull-5)t0=(NTfull-5)&~1; if(t0<0)t0=0;
    t0=__builtin_amdgcn_readfirstlane(t0);
    attn_unit<THRL>(b,h,c,vh,qb,t0,T.Q,T.K,T.V,T.O,lds);
  }
}
#undef SBAR
#undef WAIT_BAR
}
namespace ssd {
typedef unsigned short bf16_t;
typedef short bf16x8 __attribute__((ext_vector_type(8)));
typedef float f32x4 __attribute__((ext_vector_type(4)));
typedef unsigned u32x4 __attribute__((ext_vector_type(4)));
typedef unsigned u32x2 __attribute__((ext_vector_type(2)));
#define SLAS __attribute__((address_space(3)))
constexpr int LP = 8320, NCH = 65, LDA = 136;
constexpr int OFF_A = 0, OFF_B = 34816, OFF_X = 69632, OFF_P = 87040, OFF_F = 104448;
struct Params { const bf16_t* XBC; const float* DT; const float* conv_w; const float* conv_b; const float* dt_bias; const float* a_log; const float* d_skip; bf16_t* ST; float* CDEC; bf16_t* Y;
    bf16_t* XT; bf16_t* BT; bf16_t* BM; bf16_t* CM; float* DTA; };
typedef float f32x2_t __attribute__((ext_vector_type(2))); typedef __bf16 bf16x2_t __attribute__((ext_vector_type(2)));
__device__ __forceinline__ unsigned cvtpk(float lo, float hi) { f32x2_t v = {lo, hi}; bf16x2_t b = __builtin_convertvector(v, bf16x2_t); return __builtin_bit_cast(unsigned, b); }
__device__ __forceinline__ float bflo(unsigned w) { return __uint_as_float(w << 16); }
__device__ __forceinline__ float bfhi(unsigned w) { return __uint_as_float(w & 0xffff0000u); }

__device__ __forceinline__ void conv_item(const Params& P, int b, int c, int oct, int strip) {
    const int ch = oct * 8, l0 = strip * 8;
    float w[8][4], bias[8], x[11][8];
#pragma unroll
    for (int j = 0; j < 8; ++j) { const f32x4 t = *(const f32x4*)(P.conv_w + (size_t)(ch + j) * 4); w[j][0] = t[0]; w[j][1] = t[1]; w[j][2] = t[2]; w[j][3] = t[3]; }
    { const f32x4 t0 = *(const f32x4*)(P.conv_b + ch), t1 = *(const f32x4*)(P.conv_b + ch + 4); bias[0] = t0[0]; bias[1] = t0[1]; bias[2] = t0[2]; bias[3] = t0[3]; bias[4] = t1[0]; bias[5] = t1[1]; bias[6] = t1[2]; bias[7] = t1[3]; }
    const long prow0 = (long)b * LP + c * 128 + l0 - 3;
#pragma unroll
    for (int i = 0; i < 11; ++i) { const u32x4 raw = *(const u32x4*)(P.XBC + (prow0 + i) * 1536 + ch);
        x[i][0] = bflo(raw.x); x[i][1] = bfhi(raw.x); x[i][2] = bflo(raw.y); x[i][3] = bfhi(raw.y); x[i][4] = bflo(raw.z); x[i][5] = bfhi(raw.z); x[i][6] = bflo(raw.w); x[i][7] = bfhi(raw.w); }
#define CV(rr, j) ({ const float v_ = bias[j] + w[j][0] * x[rr][j] + w[j][1] * x[rr + 1][j] + w[j][2] * x[rr + 2][j] + w[j][3] * x[rr + 3][j]; v_ * __builtin_amdgcn_rcpf(1.f + __expf(-v_)); })
#define CV_T(dst) { _Pragma("unroll") for (int j = 0; j < 8; ++j) { u32x4 wv; wv.x = cvtpk(CV(0, j), CV(1, j)); wv.y = cvtpk(CV(2, j), CV(3, j)); wv.z = cvtpk(CV(4, j), CV(5, j)); wv.w = cvtpk(CV(6, j), CV(7, j)); *(u32x4*)((dst) + j * 128) = wv; } }
#define CV_R(dst) { _Pragma("unroll") for (int rr = 0; rr < 8; ++rr) { u32x4 wv; wv.x = cvtpk(CV(rr, 0), CV(rr, 1)); wv.y = cvtpk(CV(rr, 2), CV(rr, 3)); wv.z = cvtpk(CV(rr, 4), CV(rr, 5)); wv.w = cvtpk(CV(rr, 6), CV(rr, 7)); *(u32x4*)((dst) + rr * 128) = wv; } }
    const size_t bc = (size_t)b * NCH + c;
    if (oct < 128) {
        bf16_t* dst = P.XT + (bc * 16 + (oct >> 3)) * 8192 + (size_t)((oct & 7) * 8) * 128 + l0;
        CV_T(dst)
    } else {
        const int bcsel = (oct - 128) >> 5, g = ((oct - 128) >> 4) & 1, n0 = ((oct - 128) & 15) * 8;
        bf16_t* rm = (bcsel ? P.CM : P.BM) + (bc * 2 + g) * 16384 + (size_t)l0 * 128 + n0;
        CV_R(rm)
        if (bcsel == 0) { bf16_t* dst = P.BT + (bc * 2 + g) * 16384 + (size_t)n0 * 128 + l0; CV_T(dst) }
    }
#undef CV
#undef CV_T
#undef CV_R
}
__device__ __forceinline__ void dta_item(const Params& P, int u, int lane) {
    const int b = u / (NCH * 16), c = (u / 16) % NCH, h = u % 16;
    const long prow = (long)b * LP + c * 128 + 2 * lane;
    const float bias = P.dt_bias[h], a = -__expf(P.a_log[h]);
    float d0 = P.DT[prow * 16 + h] + bias, d1 = P.DT[(prow + 1) * 16 + h] + bias;
    d0 = d0 > 20.f ? d0 : log1pf(__expf(d0)); d1 = d1 > 20.f ? d1 : log1pf(__expf(d1));
    const int i0 = c * 128 + 2 * lane;
    if (i0 < 112) d0 = 0.f;
    if (i0 + 1 < 112) d1 = 0.f;
    const float a0 = d0 * a, a1 = d1 * a; float s = a0 + a1;
#pragma unroll
    for (int o = 1; o < 64; o <<= 1) { const float t = __shfl_up(s, o); if (lane >= o) s += t; }
    const float excl = s - (a0 + a1);
    float* D = P.DTA + (size_t)u * 256;
    *(f32x2_t*)(D + 2 * lane) = (f32x2_t){d0, d1}; *(f32x2_t*)(D + 128 + 2 * lane) = (f32x2_t){excl + a0, s};
    if (lane == 63) P.CDEC[u] = __expf(s);
}
__device__ __forceinline__ void conv_phase(const Params& P, int gw, int NGW, int lane) {
    for (int it = gw; it < 4 * NCH * 48; it += NGW) { const int bc = it / 48, oq = it % 48; conv_item(P, bc / NCH, bc % NCH, oq * 4 + (lane >> 4), lane & 15); }
    for (int u = gw; u < 4 * NCH * 16; u += NGW) dta_item(P, u, lane);
}
#define SSD_FRAG(base, row, k) (*(const SLAS bf16x8*)((base) + (row) * LDA + (k) * 32 + q * 8))
struct ARegs { u32x4 xv[2], bv[4]; f32x4 dtv[2][2], acv[2][2]; float ae; };
__device__ __forceinline__ void passA_load(ARegs& R, const Params& P, int u, int tid) {
    const int h = u & 15, g = h >> 3; const size_t bc = (size_t)(u >> 4), uh = (size_t)u;
    const bf16_t* gX = P.XT + uh * 8192; const bf16_t* gB = P.BT + (bc * 2 + g) * 16384; const float* D = P.DTA + uh * 256;
#pragma unroll
    for (int i = 0; i < 2; ++i) { const int pc = tid + i * 512; R.xv[i] = *(const u32x4*)(gX + pc * 8); const int l0 = (pc & 15) * 8;
        R.dtv[i][0] = *(const f32x4*)(D + l0); R.dtv[i][1] = *(const f32x4*)(D + l0 + 4); R.acv[i][0] = *(const f32x4*)(D + 128 + l0); R.acv[i][1] = *(const f32x4*)(D + 128 + l0 + 4); }
#pragma unroll
    for (int i = 0; i < 4; ++i) R.bv[i] = *(const u32x4*)(gB + (tid + i * 512) * 8);
    R.ae = D[255];
}
__device__ __forceinline__ void passA_phase(SLAS unsigned char* lds, const Params& P, int first, int stride, int nunits) {
    int tid_ = threadIdx.x; asm volatile("" : "+v"(tid_));
    const int tid = tid_, lane = tid & 63, wid = tid >> 6, r = lane & 15, q = lane >> 4;
    SLAS bf16_t* XT = (SLAS bf16_t*)(lds + OFF_X); SLAS bf16_t* BT = (SLAS bf16_t*)(lds + OFF_A);
    int u = first; if (u >= nunits) return;
    ARegs R; passA_load(R, P, u, tid);
    for (;;) {
#pragma unroll
        for (int i = 0; i < 2; ++i) { const int pc = tid + i * 512, p = pc >> 4, l0 = (pc & 15) * 8; float wg[8];
#pragma unroll
            for (int e = 0; e < 4; ++e) { wg[e] = R.dtv[i][0][e] * __expf(R.ae - R.acv[i][0][e]); wg[4 + e] = R.dtv[i][1][e] * __expf(R.ae - R.acv[i][1][e]); }
            u32x4 wv; wv.x = cvtpk(bflo(R.xv[i].x) * wg[0], bfhi(R.xv[i].x) * wg[1]); wv.y = cvtpk(bflo(R.xv[i].y) * wg[2], bfhi(R.xv[i].y) * wg[3]);
            wv.z = cvtpk(bflo(R.xv[i].z) * wg[4], bfhi(R.xv[i].z) * wg[5]); wv.w = cvtpk(bflo(R.xv[i].w) * wg[6], bfhi(R.xv[i].w) * wg[7]);
            *(SLAS u32x4*)(XT + p * LDA + l0) = wv; }
#pragma unroll
        for (int i = 0; i < 4; ++i) { const int pc = tid + i * 512; *(SLAS u32x4*)(BT + (pc >> 4) * LDA + (pc & 15) * 8) = R.bv[i]; }
        __syncthreads();
        const int un = u + stride;
        if (un < nunits) passA_load(R, P, un, tid);
        f32x4 acc[4];
#pragma unroll
        for (int pt = 0; pt < 4; ++pt) acc[pt] = (f32x4){0.f, 0.f, 0.f, 0.f};
#pragma unroll
        for (int k = 0; k < 4; ++k) { const bf16x8 bfr = SSD_FRAG(BT, wid * 16 + r, k);
#pragma unroll
            for (int pt = 0; pt < 4; ++pt) acc[pt] = __builtin_amdgcn_mfma_f32_16x16x32_bf16(bfr, SSD_FRAG(XT, pt * 16 + r, k), acc[pt], 0, 0, 0); }
        bf16_t* S = P.ST + (size_t)u * 8192;
#pragma unroll
        for (int pt = 0; pt < 4; ++pt) { u32x2 wv; wv.x = cvtpk(acc[pt][0], acc[pt][1]); wv.y = cvtpk(acc[pt][2], acc[pt][3]); *(u32x2*)(S + (pt * 16 + r) * 128 + wid * 16 + 4 * q) = wv; }
        __syncthreads();
        if (un >= nunits) break;
        u = un;
    }
}
struct CRegs { u32x4 xv[2], sv[2], bv[4], cv[4]; f32x4 fv; };
__device__ __forceinline__ void passC_load(CRegs& R, const Params& P, int u, int tid) {
    const int h = u & 15, g = h >> 3; const size_t bc = (size_t)(u >> 4), uh = (size_t)u;
    const bf16_t* gX = P.XT + uh * 8192; const bf16_t* gB = P.BM + (bc * 2 + g) * 16384; const bf16_t* gC = P.CM + (bc * 2 + g) * 16384; const bf16_t* gS = P.ST + uh * 8192; const float* D = P.DTA + uh * 256;
#pragma unroll
    for (int i = 0; i < 2; ++i) { R.xv[i] = *(const u32x4*)(gX + (tid + i * 512) * 8); R.sv[i] = *(const u32x4*)(gS + (tid + i * 512) * 8); }
#pragma unroll
    for (int i = 0; i < 4; ++i) { R.bv[i] = *(const u32x4*)(gB + (tid + i * 512) * 8); R.cv[i] = *(const u32x4*)(gC + (tid + i * 512) * 8); }
    R.fv = *(const f32x4*)(D + (tid & 63) * 4);
}
__device__ __forceinline__ void passC_phase(SLAS unsigned char* lds, const Params& P, int first, int stride, int nunits) {
    int tid_ = threadIdx.x; asm volatile("" : "+v"(tid_));
    const int tid = tid_, lane = tid & 63, wid = tid >> 6, r = lane & 15, q = lane >> 4;
    SLAS float* F = (SLAS float*)(lds + OFF_F);
    SLAS bf16_t* CM = (SLAS bf16_t*)(lds + OFF_A); SLAS bf16_t* BM = (SLAS bf16_t*)(lds + OFF_B); SLAS bf16_t* XT = (SLAS bf16_t*)(lds + OFF_X); SLAS bf16_t* PV = (SLAS bf16_t*)(lds + OFF_P);
    int u = first; if (u >= nunits) return;
    CRegs R; passC_load(R, P, u, tid);
    for (;;) {
        const int h = u & 15, c = (u >> 4) % NCH, b = (u >> 4) / NCH;
#pragma unroll
        for (int i = 0; i < 2; ++i) { const int pc = tid + i * 512; *(SLAS u32x4*)(XT + (pc >> 4) * LDA + (pc & 15) * 8) = R.xv[i]; *(SLAS u32x4*)(PV + (pc >> 4) * LDA + (pc & 15) * 8) = R.sv[i]; }
#pragma unroll
        for (int i = 0; i < 4; ++i) { const int pc = tid + i * 512; *(SLAS u32x4*)(BM + (pc >> 4) * LDA + (pc & 15) * 8) = R.bv[i]; *(SLAS u32x4*)(CM + (pc >> 4) * LDA + (pc & 15) * 8) = R.cv[i]; }
        if (tid < 64) *(SLAS f32x4*)(F + tid * 4) = R.fv;
        __syncthreads();
        const int un = u + stride;
        if (un < nunits) passC_load(R, P, un, tid);
        f32x4 sacc[8];
#pragma unroll
        for (int st = 0; st < 8; ++st) sacc[st] = (f32x4){0.f, 0.f, 0.f, 0.f};
#pragma unroll
        for (int k = 0; k < 4; ++k) { const bf16x8 afr = SSD_FRAG(CM, wid * 16 + r, k);
#pragma unroll
            for (int st = 0; st < 8; ++st) sacc[st] = __builtin_amdgcn_mfma_f32_16x16x32_bf16(SSD_FRAG(BM, st * 16 + r, k), afr, sacc[st], 0, 0, 0); }
        __syncthreads();
        const int l = wid * 16 + r; const float al = F[128 + l], Dh = P.d_skip[h];
#pragma unroll
        for (int st = 0; st < 8; ++st) { const int s0 = st * 16 + 4 * q; float gv[4];
#pragma unroll
            for (int j = 0; j < 4; ++j) { const int s = s0 + j; float v = 0.f; if (s <= l) v = sacc[st][j] * __expf(al - F[128 + s]) * F[s]; if (s == l) v += Dh; gv[j] = v; }
            u32x2 wv; wv.x = cvtpk(gv[0], gv[1]); wv.y = cvtpk(gv[2], gv[3]); *(SLAS u32x2*)(BM + l * LDA + s0) = wv; }
        __syncthreads();
        f32x4 yacc[4];
#pragma unroll
        for (int pt = 0; pt < 4; ++pt) yacc[pt] = (f32x4){0.f, 0.f, 0.f, 0.f};
#pragma unroll
        for (int k = 0; k < 4; ++k) { const bf16x8 afr = SSD_FRAG(CM, wid * 16 + r, k);
#pragma unroll
            for (int pt = 0; pt < 4; ++pt) yacc[pt] = __builtin_amdgcn_mfma_f32_16x16x32_bf16(SSD_FRAG(PV, pt * 16 + r, k), afr, yacc[pt], 0, 0, 0); }
        { const float el = __expf(al);
#pragma unroll
            for (int pt = 0; pt < 4; ++pt) yacc[pt] = yacc[pt] * el; }
#pragma unroll
        for (int k = 0; k < 4; ++k) { const bf16x8 afr = SSD_FRAG(BM, wid * 16 + r, k);
#pragma unroll
            for (int pt = 0; pt < 4; ++pt) yacc[pt] = __builtin_amdgcn_mfma_f32_16x16x32_bf16(SSD_FRAG(XT, pt * 16 + r, k), afr, yacc[pt], 0, 0, 0); }
        bf16_t* yrow = P.Y + ((size_t)b * LP + c * 128 + l) * 1024 + h * 64 + 4 * q;
#pragma unroll
        for (int pt = 0; pt < 4; ++pt) { u32x2 wv; wv.x = cvtpk(yacc[pt][0], yacc[pt][1]); wv.y = cvtpk(yacc[pt][2], yacc[pt][3]); *(u32x2*)(yrow + pt * 16) = wv; }
        __syncthreads();
        if (un >= nunits) break;
        u = un;
    }
}
#undef SSD_FRAG
__device__ __forceinline__ void scan_phase(const Params& P, int gtid, int nthreads) {
    for (int qd = gtid; qd < 4 * 32768; qd += nthreads) {
        const int b = qd >> 15, e = (qd & 32767) * 4, h = e >> 13;
        bf16_t* base = P.ST + (size_t)b * NCH * 131072 + e; const float* cd = P.CDEC + b * NCH * 16 + h;
        float s0 = 0.f, s1 = 0.f, s2 = 0.f, s3 = 0.f;
        for (int c0 = 0; c0 < NCH; c0 += 13) {
            u32x2 v[13]; float d[13];
#pragma unroll
            for (int i = 0; i < 13; ++i) { v[i] = *(const u32x2*)(base + (size_t)(c0 + i) * 131072); d[i] = cd[(c0 + i) * 16]; }
#pragma unroll
            for (int i = 0; i < 13; ++i) { u32x2 o; o.x = cvtpk(s0, s1); o.y = cvtpk(s2, s3); *(u32x2*)(base + (size_t)(c0 + i) * 131072) = o;
                s0 = s0 * d[i] + __uint_as_float(v[i].x << 16); s1 = s1 * d[i] + __uint_as_float(v[i].x & 0xffff0000u);
                s2 = s2 * d[i] + __uint_as_float(v[i].y << 16); s3 = s3 * d[i] + __uint_as_float(v[i].y & 0xffff0000u); }
        }
    }
}
}

namespace cg = cooperative_groups;
#define GAS __attribute__((address_space(1)))
#define LAS __attribute__((address_space(3)))
typedef unsigned short bf16;
typedef unsigned v4u __attribute__((ext_vector_type(4)));
typedef float f32x4 __attribute__((ext_vector_type(4)));
constexpr int NWAVES = 8;
constexpr int NB = 4, SEQ = 8192, LP = 8320, MP = NB * LP, MC = NB * SEQ, DMODEL = 1024, DFF = 2816;
constexpr float EPS = 1e-6f;
constexpr size_t MiB = 1u << 20, S1 = 65 * MiB;
constexpr size_t WS_WIN = 0, WS_WZG = 10 * MiB, WS_WSSD = 16 * MiB, WS_WATT = 18 * MiB, WS_WOUT = 20 * MiB, WS_WGU = 22 * MiB, WS_WDN = 33 * MiB;
constexpr size_t WS_DT = 39 * MiB, WS_DTA = 0  , WS_CDEC = 42 * MiB, WS_SSQ = 42 * MiB + 65536, WS_SSQ2 = 42 * MiB + 262144;
constexpr size_t WS_R5 = 44 * MiB, WS_R0 = WS_R5 + S1, WS_R1 = WS_R0 + S1, WS_R2 = WS_R1 + S1, WS_R3 = WS_R2 + S1, WS_R4 = WS_R3 + S1, WS_END = WS_R4 + 2 * S1;
static_assert(WS_END <= 512 * MiB, "d_ws map fits the guaranteed 512 MiB");
constexpr int LDS_BYTES = 147456;
#ifndef PHASES
#define PHASES 0xFFFF
#endif
#ifndef DUP
#define DUP 0
#endif

__device__ __forceinline__ unsigned f2bf(float f) { unsigned u = __builtin_bit_cast(unsigned, f); return (u + 0x7fffu + ((u >> 16) & 1u)) >> 16; }
__device__ __forceinline__ unsigned pk2(float lo, float hi) { return f2bf(lo) | (f2bf(hi) << 16); }
__device__ __forceinline__ float wave_sum(float v) {
#pragma unroll
    for (int o = 1; o < 64; o <<= 1) v += __shfl_xor(v, o);
    return v;
}
__device__ __forceinline__ float blo(unsigned w) { return __uint_as_float(w << 16); }
__device__ __forceinline__ float bhi(unsigned w) { return __uint_as_float(w & 0xffff0000u); }

__device__ __forceinline__ void tr_item(const float* W, int K, int Npitch, int nsrc, int nvalid, bf16* WT, int drow, const float* kscale, int kb, LAS float* scr, int lane) {
    const int k0 = 64 * kb, n4 = (lane & 7) * 4;
#pragma unroll
    for (int i = 0; i < 8; ++i) { const int kk = 8 * i + (lane >> 3); f32x4 v = (f32x4){0.f, 0.f, 0.f, 0.f};
        if (n4 < nvalid) v = *(const f32x4*)(W + (size_t)(k0 + kk) * Npitch + nsrc + n4);
        if (kscale) v = v * kscale[k0 + kk];
        scr[kk * 33 + n4] = v.x; scr[kk * 33 + n4 + 1] = v.y; scr[kk * 33 + n4 + 2] = v.z; scr[kk * 33 + n4 + 3] = v.w; }
    asm volatile("s_waitcnt lgkmcnt(0)" ::: "memory");
    const int c = lane & 7;
#pragma unroll
    for (int jj = 0; jj < 4; ++jj) { const int n = (lane >> 3) + 8 * jj; const LAS float* s = scr + (8 * c) * 33 + n;
        v4u o; o.x = pk2(s[0 * 33], s[1 * 33]); o.y = pk2(s[2 * 33], s[3 * 33]); o.z = pk2(s[4 * 33], s[5 * 33]); o.w = pk2(s[6 * 33], s[7 * 33]);
        *(v4u*)(WT + (size_t)(drow + n) * K + k0 + 8 * c) = o; }
    asm volatile("s_waitcnt lgkmcnt(0)" ::: "memory");
}
template <int NR> __device__ __forceinline__ void u_rows(const float* x, const float* meta, const float* g, bf16* U, float* RS0, int m0, int stride, int lane) {
    f32x4 v[NR][4]; bool live[NR], inr[NR];
#pragma unroll
    for (int k = 0; k < NR; ++k) { const int prow = m0 + k * stride; inr[k] = prow < MP; const int pr = inr[k] ? prow : 0; const int b = pr / LP, i = pr - b * LP; live[k] = inr[k] && i >= 112;
        const f32x4* src = (const f32x4*)(i < 128 ? meta + (size_t)(i < 112 ? 0 : i - 112) * 1024 : x + ((size_t)b * SEQ + (i - 128)) * 1024) + lane;
#pragma unroll
        for (int j = 0; j < 4; ++j) v[k][j] = src[64 * j]; }
    f32x4 gg[4];
#pragma unroll
    for (int j = 0; j < 4; ++j) gg[j] = ((const f32x4*)g)[lane + 64 * j];
#pragma unroll
    for (int k = 0; k < NR; ++k) { if (!inr[k]) continue;
        unsigned long long* o8 = (unsigned long long*)(U + (size_t)(m0 + k * stride) * 1024) + lane; float s = 0.f;
#pragma unroll
        for (int j = 0; j < 4; ++j) s += (v[k][j].x * v[k][j].x + v[k][j].y * v[k][j].y) + (v[k][j].z * v[k][j].z + v[k][j].w * v[k][j].w);
        const float ms = wave_sum(s) * (1.f / 1024.f) + EPS; const float rstd = live[k] ? rsqrtf(ms) : 0.f;
        if (lane == 0) RS0[m0 + k * stride] = live[k] ? ms * rstd : 0.f;
#pragma unroll
        for (int j = 0; j < 4; ++j) o8[64 * j] = (unsigned long long)pk2(v[k][j].x * rstd * gg[j].x, v[k][j].y * rstd * gg[j].y) | ((unsigned long long)pk2(v[k][j].z * rstd * gg[j].z, v[k][j].w * rstd * gg[j].w) << 32); }
}
template <int NR> __device__ __forceinline__ void combine_rows(const bf16* O, bf16* YATT, const float* subln_g, float lam, int r0, int stride, int lane) {
    v4u A0[NR], A1[NR], C0[NR], C1[NR];
#pragma unroll
    for (int k = 0; k < NR; ++k) { const int r = r0 + k * stride; const int rr = r < MC ? r : 0; const int b = rr >> 13, t = rr & 8191; const size_t prow = (size_t)b * LP + 128 + t;
        const v4u* p1 = (const v4u*)(O + prow * 2048 + 16 * lane); const v4u* p2 = (const v4u*)(O + prow * 2048 + 1024 + 16 * lane);
        A0[k] = p1[0]; A1[k] = p1[1]; C0[k] = p2[0]; C1[k] = p2[1]; }
    float gpv[16];
    { const f32x4* gp4 = (const f32x4*)(subln_g + 16 * (lane & 7));
#pragma unroll
      for (int i = 0; i < 4; ++i) { const f32x4 t = gp4[i]; gpv[4 * i] = t.x; gpv[4 * i + 1] = t.y; gpv[4 * i + 2] = t.z; gpv[4 * i + 3] = t.w; } }
#pragma unroll
    for (int k = 0; k < NR; ++k) { const int r = r0 + k * stride; if (r >= MC) continue;
        const v4u a0 = A0[k], a1 = A1[k], c0 = C0[k], c1 = C1[k];
        float a[16];
        a[0] = blo(a0.x) - lam * blo(c0.x); a[1] = bhi(a0.x) - lam * bhi(c0.x); a[2] = blo(a0.y) - lam * blo(c0.y); a[3] = bhi(a0.y) - lam * bhi(c0.y);
        a[4] = blo(a0.z) - lam * blo(c0.z); a[5] = bhi(a0.z) - lam * bhi(c0.z); a[6] = blo(a0.w) - lam * blo(c0.w); a[7] = bhi(a0.w) - lam * bhi(c0.w);
        a[8] = blo(a1.x) - lam * blo(c1.x); a[9] = bhi(a1.x) - lam * bhi(c1.x); a[10] = blo(a1.y) - lam * blo(c1.y); a[11] = bhi(a1.y) - lam * bhi(c1.y);
        a[12] = blo(a1.z) - lam * blo(c1.z); a[13] = bhi(a1.z) - lam * bhi(c1.z); a[14] = blo(a1.w) - lam * blo(c1.w); a[15] = bhi(a1.w) - lam * bhi(c1.w);
        float ss = 0.f;
#pragma unroll
        for (int i = 0; i < 16; ++i) ss += a[i] * a[i];
        ss += __shfl_xor(ss, 1); ss += __shfl_xor(ss, 2); ss += __shfl_xor(ss, 4);
        const float rs = rsqrtf(ss * (1.f / 128.f) + EPS) * 0.8f;
        v4u o0, o1;
        o0.x = pk2(a[0] * rs * gpv[0], a[1] * rs * gpv[1]); o0.y = pk2(a[2] * rs * gpv[2], a[3] * rs * gpv[3]); o0.z = pk2(a[4] * rs * gpv[4], a[5] * rs * gpv[5]); o0.w = pk2(a[6] * rs * gpv[6], a[7] * rs * gpv[7]);
        o1.x = pk2(a[8] * rs * gpv[8], a[9] * rs * gpv[9]); o1.y = pk2(a[10] * rs * gpv[10], a[11] * rs * gpv[11]); o1.z = pk2(a[12] * rs * gpv[12], a[13] * rs * gpv[13]); o1.w = pk2(a[14] * rs * gpv[14], a[15] * rs * gpv[15]);
        v4u* q = (v4u*)(YATT + (size_t)r * 1024 + 16 * lane); q[0] = o0; q[1] = o1; }
}

#define XB_TMO      128
#define XB_XCNT(j)  (256  + 64 * (j))
#define XB_XSUB(j)  (1280 + 64 * (j))
#define XB_XGEN(j)  (2304 + 64 * (j))
#define XB_TOP      3328
#define XB_TOPGEN   3392
#define XCD_BAR_WORDS 3456
#define XB_SPIN_CAP (1u << 18)

__device__ __forceinline__ unsigned xb_ld(unsigned* p)              { return __hip_atomic_load(p, __ATOMIC_RELAXED, __HIP_MEMORY_SCOPE_AGENT); }
__device__ __forceinline__ unsigned xb_add(unsigned* p, unsigned v) { return __hip_atomic_fetch_add(p, v, __ATOMIC_RELAXED, __HIP_MEMORY_SCOPE_AGENT); }
__device__ __forceinline__ unsigned xb_xcc_id() { return (unsigned)__builtin_amdgcn_s_getreg((3 << 11) | 20) & 0xFu; }
#define XB_SPIN(cond, bar) do { unsigned _sp = 0; while (cond) { __builtin_amdgcn_s_sleep(1); \
    if ((++_sp & 255u) == 0u) { if (xb_ld(&(bar)[XB_TMO])) break; if (_sp > XB_SPIN_CAP) { atomicAdd(&(bar)[XB_TMO], 1u); break; } } } } while (0)

struct XcdBarrier {
    unsigned* bar; unsigned x;
    volatile LAS unsigned* st;
};

__device__ __forceinline__ XcdBarrier xcd_barrier_post(unsigned* bar, volatile LAS unsigned* st) {
    XcdBarrier b; b.bar = bar; b.x = xb_xcc_id(); b.st = st;
    if (threadIdx.x == 0) (void)xb_add(&bar[XB_XCNT(b.x)], 1u);
    return b;
}
__device__ __forceinline__ void xcd_barrier_complete(unsigned* bar, unsigned x, unsigned& nloc, unsigned& nx) {
    const unsigned G = gridDim.x * gridDim.y * gridDim.z;
    unsigned sum, cnt, mine, sp = 0u;
    for (;;) {
        sum = 0u; cnt = 0u; mine = 0u;
#pragma unroll
        for (unsigned j = 0; j < 16; ++j) { const unsigned c = xb_ld(&bar[XB_XCNT(j)]); sum += c; cnt += (c > 0u) ? 1u : 0u; mine = (j == x) ? c : mine; }
        if (sum == G) break;
        __builtin_amdgcn_s_sleep(1);
        if ((++sp & 255u) == 0u) { if (xb_ld(&bar[XB_TMO])) break; if (sp > XB_SPIN_CAP) { atomicAdd(&bar[XB_TMO], 1u); break; } }
    }
    nloc = mine > 0u ? mine : 1u; nx = cnt > 0u ? cnt : 1u;
}

__device__ __forceinline__ void xcd_barrier(const XcdBarrier& b) {
    asm volatile("s_waitcnt vmcnt(0)" ::: "memory");
    __syncthreads();
    if (threadIdx.x == 0) {
        unsigned* bar = b.bar;
        __builtin_amdgcn_s_waitcnt(0);
        unsigned nloc = b.st[0], nx = b.st[1];
        if (nloc == 0u) { xcd_barrier_complete(bar, b.x, nloc, nx); b.st[0] = nloc; b.st[1] = nx; }
        const unsigned old = xb_add(&bar[XB_XSUB(b.x)], 1u);
        const unsigned gen = old / nloc;
        if (old + 1u == (gen + 1u) * nloc) {
            __builtin_amdgcn_fence(__ATOMIC_RELEASE, "agent");
            asm volatile("s_waitcnt vmcnt(0)" ::: "memory");
            const unsigned og = xb_add(&bar[XB_TOP], 1u);
            const unsigned tg = og / nx;
            if (og + 1u == (tg + 1u) * nx) xb_add(&bar[XB_TOPGEN], 1u);
            else XB_SPIN(xb_ld(&bar[XB_TOPGEN]) == tg, bar);
            __builtin_amdgcn_fence(__ATOMIC_ACQUIRE, "agent");
            xb_add(&bar[XB_XGEN(b.x)], 1u);
            asm volatile("s_waitcnt vmcnt(0)" ::: "memory");
        } else {
            XB_SPIN(xb_ld(&bar[XB_XGEN(b.x)]) == gen, bar);
            __builtin_amdgcn_fence(__ATOMIC_ACQUIRE, "agent");
            asm volatile("s_waitcnt vmcnt(0)" ::: "memory");
        }
    }
    __syncthreads();
}
constexpr size_t WS_CTL = 43 * MiB, CTL_BYTES = 65536;
constexpr int LDSCTL_OFF = 131072;

struct Args { const float* in[24]; float* out; unsigned char* ws; };
enum { I_X = 0, I_META, I_NMIXG, I_WIN, I_GBIAS, I_CONVW, I_CONVB, I_DTBIAS, I_ALOG, I_DSKIP, I_SSDG, I_LQ1, I_LK1, I_LQ2, I_LK2, I_SUBLNG, I_WSSD, I_WATT, I_WOUT, I_NFFNG, I_WGATE, I_WUP, I_WDOWN, I_NFING };

__global__ void __launch_bounds__(NWAVES * 64, 2) mega_fwd(Args args) {
    extern __shared__ __attribute__((aligned(16))) unsigned char lds[];
    cg::grid_group grid = cg::this_grid();
    { LAS unsigned* z = (LAS unsigned*)(lds + 0) ; (void)z; }
    for (int u = threadIdx.x; u < 64; u += NWAVES * 64) ((LAS unsigned*)((LAS unsigned char*)lds + LDSCTL_OFF))[u] = 0u;
    __syncthreads();
    XcdBarrier xbar = xcd_barrier_post((unsigned*)(args.ws + WS_CTL), (volatile LAS unsigned*)((LAS unsigned char*)lds + LDSCTL_OFF) + 8);
    grid.sync();
    LAS unsigned char* L = (LAS unsigned char*)lds;
    const int G = gridDim.x, bx = blockIdx.x, vcu = (G % 8 == 0) ? (bx % 8) * (G / 8) + bx / 8 : bx;
    const int NGW = G * NWAVES;
#define PHASE_PTRS() \
    const __attribute__((address_space(4))) Args* A_ = (const __attribute__((address_space(4))) Args*)__builtin_amdgcn_kernarg_segment_ptr(); asm volatile("" : "+s"(A_)); \
    unsigned char* ws = A_->ws; (void)ws; \
    int tid_o = threadIdx.x; asm volatile("" : "+v"(tid_o)); const int lane = tid_o & 63, wave = __builtin_amdgcn_readfirstlane(tid_o >> 6), gw = vcu * NWAVES + wave; (void)lane; (void)gw; \
    bf16 *Win_t = (bf16*)(ws + WS_WIN), *Wzg_t = (bf16*)(ws + WS_WZG), *Wssd_t = (bf16*)(ws + WS_WSSD), *Watt_t = (bf16*)(ws + WS_WATT), *Wout_t = (bf16*)(ws + WS_WOUT), *Wgu_t = (bf16*)(ws + WS_WGU), *Wdn_t = (bf16*)(ws + WS_WDN); \
    float *DT = (float*)(ws + WS_DT), *CDEC = (float*)(ws + WS_CDEC), *SSQ = (float*)(ws + WS_SSQ), *SSQ2 = (float*)(ws + WS_SSQ2), *SSQ3 = (float*)(ws + WS_SSQ2 + 131072); (void)SSQ3; \
    bf16 *R5 = (bf16*)(ws + WS_R5), *R0 = (bf16*)(ws + WS_R0), *R1 = (bf16*)(ws + WS_R1), *R2 = (bf16*)(ws + WS_R2), *R3 = (bf16*)(ws + WS_R3), *R4 = (bf16*)(ws + WS_R4); \
    const float* x = A_->in[I_X]; float* outp = A_->out; \
    (void)Win_t; (void)Wzg_t; (void)Wssd_t; (void)Watt_t; (void)Wout_t; (void)Wgu_t; (void)Wdn_t; (void)DT; (void)CDEC; (void)SSQ; (void)SSQ2; (void)R5; (void)R0; (void)R1; (void)R2; (void)R3; (void)R4; (void)x; (void)outp;
#define GRID_SYNC() xcd_barrier(xbar)

    if constexpr ((PHASES >> 0) & 1) for (int rep0_ = 0; rep0_ < 1 + ((DUP >> 0) & 1); ++rep0_) { PHASE_PTRS();
        LAS float* scr = (LAS float*)(L + wave * 16384);
        const float* w_in = A_->in[I_WIN];
        constexpr int NIN = 7696;
        for (int it = gw; it < 3856; it += NGW) {
            int r = it;
#define SEG(W_, K_, NP_, NS_, NBLK_, NVAL_, WT_, DROW_, KS_, IL_) { const int n_ = ((K_) / 64) * (NBLK_); if (r < n_) { const int kb = r / (NBLK_), blk = r % (NBLK_); \
                tr_item(W_, K_, NP_, (NS_) + 32 * blk, NVAL_, WT_, (IL_) ? (DROW_) + 256 * (blk >> 2) + 32 * (blk & 3) : (DROW_) + 32 * blk, KS_, kb, scr, lane); continue; } r -= n_; }
            SEG(w_in, 1024, NIN, 2576, 32, 32, Win_t, 0, nullptr, 0)
            SEG(w_in, 1024, NIN, 3600, 32, 32, Win_t, 1024, nullptr, 0)
            SEG(w_in, 1024, NIN, 4624, 32, 32, Win_t, 2048, nullptr, 0)
            SEG(w_in, 1024, NIN, 1024, 48, 32, Win_t, 3072, nullptr, 0)
            SEG(w_in, 1024, NIN, 2560, 1, 16, Win_t, 4608, nullptr, 0)
            SEG(w_in, 1024, NIN, 0, 32, 32, Wzg_t, 0, nullptr, 0)
            SEG(w_in, 1024, NIN, 5648, 64, 32, Wzg_t, 1024, nullptr, 0)
        }
        {
            const int gt = gw * 64 + lane, NT = NGW * 64;
            v4u* z = (v4u*)(Win_t + (size_t)4640 * 1024);
            for (int i = gt; i < 224 * 128; i += NT) z[i] = (v4u){0u, 0u, 0u, 0u};
            for (int i = gt; i < MC; i += NT) { SSQ[i] = 0.f; SSQ2[i] = 0.f; SSQ3[i] = 0.f; }
        }
        for (int m = gw; m < MP; m += 4 * NGW) u_rows<4>(x, A_->in[I_META], A_->in[I_NMIXG], (bf16*)outp, (float*)(ws + WS_SSQ2 + 262144), m, NGW, lane);
    }
    GRID_SYNC();
    if constexpr ((PHASES >> 1) & 1) { PHASE_PTRS();
        pg8::Gemm g{(const bf16*)outp, Win_t, MP, 4864, 1024, 0}; pg8::StaticOrder S; S.init(MP, 4864, G, bx);
        pg8::EpiProj1 E{R1, R2, R3, R4, DT, (float*)(ws + WS_CTL + 16384)};
        for (int rep_ = 0; rep_ < 1 + ((DUP >> 1) & 1); ++rep_) pg8::gemm_phase<pg8::EpiProj1, pg8::StaticOrder, true, true>(L, g, S, E);
    }
    GRID_SYNC();
    if constexpr ((PHASES >> 2) & 1) { PHASE_PTRS();
        const attn_body::AttnTensors AT{(const attn_body::bf16*)R1, (const attn_body::bf16*)R2, (const attn_body::bf16*)R3, (attn_body::bf16*)R5, (const float*)(ws + WS_CTL + 16384), (unsigned*)(ws + WS_CTL + 32768)};
        attn_body::attn_phase<64>((char*)lds, AT);
        {
            unsigned* wctr = (unsigned*)(ws + WS_CTL + 32768 + 256);
            LAS unsigned* wslot = (LAS unsigned*)(L + 140000);
            LAS float* scr = (LAS float*)(L + wave * 16384);
            for (;;) {
                __syncthreads();
                if (threadIdx.x == 0) *wslot = atomicAdd(wctr, 1u);
                __syncthreads();
                const int it = (int)(*wslot) * NWAVES + wave;
                if ((int)(*wslot) * NWAVES >= 5760) break;
                if (it < 5760) { int r = it; do {
            SEG(A_->in[I_WSSD], 1024, 1024, 0, 32, 32, Wssd_t, 0, A_->in[I_SSDG], 0)
            SEG(A_->in[I_WATT], 1024, 1024, 0, 32, 32, Watt_t, 0, nullptr, 0)
            SEG(A_->in[I_WOUT], 1024, 1024, 0, 32, 32, Wout_t, 0, nullptr, 0)
            SEG(A_->in[I_WGATE], 1024, DFF, 0, 88, 32, Wgu_t, 0, A_->in[I_NFFNG], 1)
            SEG(A_->in[I_WUP], 1024, DFF, 0, 88, 32, Wgu_t, 128, A_->in[I_NFFNG], 1)
            SEG(A_->in[I_WDOWN], DFF, 1024, 0, 32, 32, Wdn_t, 0, nullptr, 0)
                } while (0); }
            }
        }
#undef SEG
    }
    GRID_SYNC();
#define SSD_PARAMS() PHASE_PTRS(); const ssd::Params SP{R4, DT, A_->in[I_CONVW], A_->in[I_CONVB], A_->in[I_DTBIAS], A_->in[I_ALOG], A_->in[I_DSKIP], R3, CDEC, R4, R1, R1 + (size_t)MP * 1024, R1 + (size_t)MP * 1280, R1 + (size_t)MP * 1536, (float*)(ws + WS_DTA)}
    if constexpr ((PHASES >> 3) & 1) { SSD_PARAMS(); for (int rep_ = 0; rep_ < 1 + ((DUP >> 12) & 1); ++rep_) ssd::conv_phase(SP, gw, NGW, lane); }
    GRID_SYNC();
    if constexpr ((PHASES >> 3) & 1) { SSD_PARAMS(); for (int rep_ = 0; rep_ < 1 + ((DUP >> 3) & 1); ++rep_) ssd::passA_phase(L, SP, vcu, G, NB * 65 * 16); }
    GRID_SYNC();
    if constexpr ((PHASES >> 4) & 1) { SSD_PARAMS(); ssd::scan_phase(SP, gw * 64 + lane, NGW * 64); }
    GRID_SYNC();
    if constexpr ((PHASES >> 5) & 1) { SSD_PARAMS(); for (int rep_ = 0; rep_ < 1 + ((DUP >> 5) & 1); ++rep_) ssd::passC_phase(L, SP, vcu, G, NB * 65 * 16);
        const float s1 = wave_sum(A_->in[I_LQ1][lane] * A_->in[I_LK1][lane]), s2 = wave_sum(A_->in[I_LQ2][lane] * A_->in[I_LK2][lane]);
        const float lam = expf(s1) - expf(s2) + 0.2f;
        for (int r = gw; r < MC; r += 4 * NGW) combine_rows<4>(R5, R4 + (size_t)MP * 1024, A_->in[I_SUBLNG], lam, r, NGW, lane);
        }
    GRID_SYNC();
    if constexpr ((PHASES >> 6) & 1) { PHASE_PTRS();
        pg8::Gemm g{(const bf16*)outp, Wzg_t, MC, 3072, 1024, 1}; pg8::StaticOrder S; S.init(MC, 3072, G, bx);
        pg8::EpiZG E{R4, R1, R2, A_->in[I_GBIAS], SSQ3};
        for (int rep_ = 0; rep_ < 1 + ((DUP >> 6) & 1); ++rep_) pg8::gemm_phase<pg8::EpiZG, pg8::StaticOrder, true, true>(L, g, S, E);
    }
    GRID_SYNC();
    if constexpr ((PHASES >> 8) & 1) { PHASE_PTRS();
        pg8::Gemm g{R1, Wssd_t, MC, 1024, 1024, 0, R4 + (size_t)MP * 1024, Watt_t, 0}; pg8::StaticOrder2 S; S.init(MC, 1024, G, bx);
        pg8::EpiBranch E{R2, R4, SSQ3};
        pg8::gemm_phase<pg8::EpiBranch, pg8::StaticOrder2, true, true>(L, g, S, E);
    }
    GRID_SYNC();
    if constexpr ((PHASES >> 9) & 1) { PHASE_PTRS();
        pg8::Gemm g{R4, Wout_t, MC, 1024, 1024, 0}; pg8::StaticOrder S; S.init(MC, 1024, G, bx);
        pg8::EpiWout E{x, (const bf16*)outp, (const float*)(ws + WS_SSQ2 + 262144), A_->in[I_NMIXG], R4 + (size_t)MP * 1024, SSQ};
        pg8::gemm_phase<pg8::EpiWout, pg8::StaticOrder, true, true>(L, g, S, E);
    }
    GRID_SYNC();
    if constexpr ((PHASES >> 10) & 1) { PHASE_PTRS();
        pg8::Gemm g{R4 + (size_t)MP * 1024, Wgu_t, MC, 2 * DFF, 1024, 0}; pg8::StaticOrder S; S.init(MC, 2 * DFF, G, bx);
        pg8::EpiGU E{R5, SSQ};
        for (int rep_ = 0; rep_ < 1 + ((DUP >> 10) & 1); ++rep_) pg8::gemm_phase<pg8::EpiGU, pg8::StaticOrder, true, true>(L, g, S, E);
    }
    GRID_SYNC();
    if constexpr ((PHASES >> 11) & 1) { PHASE_PTRS();
        pg8::Gemm g{R5, Wdn_t, MC, 1024, DFF, 0}; pg8::StaticOrder S; S.init(MC, 1024, G, bx);
        pg8::EpiDownNorm E{outp, R4 + (size_t)MP * 1024, SSQ2, (unsigned*)(ws + WS_CTL + 40960), A_->in[I_NFING]};
        pg8::gemm_phase<pg8::EpiDownNorm, pg8::StaticOrder, true, true>(L, g, S, E);
    }
}

extern "C" void kernel_launch(void* const* d_in, const int* in_sizes, int n_in, void* d_out, int out_size, void* d_ws, size_t ws_size, hipStream_t stream) {
    static int grid = 0;
    if (grid == 0) {
        if (n_in != 24 || in_sizes[0] != MC * 1024 || out_size != MC * 1024 || ws_size < WS_END) { fprintf(stderr, "kernel_launch: unexpected shapes (n_in %d, in0 %d, out %d, ws %zu)\n", n_in, n_in > 0 ? in_sizes[0] : -1, out_size, ws_size); grid = -1; return; }
        int dev = 0, cus = 0, per_cu = 0;
        hipGetDevice(&dev); hipDeviceGetAttribute(&cus, hipDeviceAttributeMultiprocessorCount, dev);
        hipFuncSetAttribute((const void*)mega_fwd, hipFuncAttributeMaxDynamicSharedMemorySize, LDS_BYTES);
        hipOccupancyMaxActiveBlocksPerMultiprocessor(&per_cu, (const void*)mega_fwd, NWAVES * 64, LDS_BYTES);
        (void)hipGetLastError();
        if (per_cu < 1) fprintf(stderr, "kernel_launch: occupancy query says %d blocks per CU\n", per_cu);
        grid = cus > 0 ? cus : 256;
        if (grid != 256) fprintf(stderr, "kernel_launch: built for a 256-CU device (the fused final norm needs the four owners of a row panel in one scheduling round); got %d\n", grid);
    }
    if (grid < 0) return;
    if (hipMemsetAsync((char*)d_ws + WS_CTL, 0, CTL_BYTES, stream) != hipSuccess) { fprintf(stderr, "kernel_launch: hipMemsetAsync failed\n"); return; }
    Args a{};
    for (int i = 0; i < 24; ++i) a.in[i] = (const float*)d_in[i];
    a.out = (float*)d_out; a.ws = (unsigned char*)d_ws;
    void* kargs[] = {&a};
    hipError_t e = hipLaunchCooperativeKernel((const void*)mega_fwd, dim3(grid), dim3(NWAVES * 64), kargs, LDS_BYTES, stream);
    if (e != hipSuccess) fprintf(stderr, "kernel_launch: cooperative launch failed: %s (grid %d)\n", hipGetErrorString(e), grid);
}
```

```cpp
#include <hip/hip_runtime.h>
#include <hip/hip_cooperative_groups.h>
#include <hip/hip_bf16.h>
#include <cstdio>
#include <cstdint>
#include <cmath>
#include <type_traits>
namespace pg8 {
#define PG8_LAS __attribute__((address_space(3)))
typedef unsigned short bf16_t;
typedef short bf16x8 __attribute__((ext_vector_type(8)));
typedef float f32x4 __attribute__((ext_vector_type(4)));
typedef unsigned u32x4 __attribute__((ext_vector_type(4)));
constexpr int BM = 256, BK = 64, HALF = 128, HTB = HALF * BK * 2  , STAGE_BYTES = 8 * HTB, NXCD = 8, WGM = 8;

__host__ __device__ __forceinline__ int lds_byte(int r, int c) { const int st = (r >> 4) * 2 + (c >> 5), rr = r & 15, cc = c & 31, ob = rr * 64 + cc * 2; return st * 1024 + (ob ^ (((ob >> 9) & 1) << 5)); }
__host__ __device__ __forceinline__ void stage_rc(int b, int& R, int& C) { const int st = b / 1024, sb = b % 1024, swz = sb ^ (((sb >> 9) & 1) << 5); R = (st >> 1) * 16 + swz / 64; C = (st & 1) * 32 + (swz % 64) / 2; }
__host__ __device__ __forceinline__ int perm32(int rho) { const int n = rho >> 4, i = rho & 15; return 8 * (i >> 2) + 4 * n + (i & 3); }

struct Unit { int pm, pn, seg; };
struct Gemm { const bf16_t* A; const bf16_t* Bt; int M, N, K, amap; const bf16_t* A2; const bf16_t* Bt2; int amap2; };
__device__ __forceinline__ const char* a_base(const Gemm& g, const Unit& u) { const int am = u.seg ? g.amap2 : g.amap; const int r0 = am ? u.pm * 256 + 128 * (u.pm / 32 + 1) : u.pm * 256; return (const char*)(u.seg ? g.A2 : g.A) + (size_t)r0 * (size_t)g.K * 2; }
__device__ __forceinline__ const char* b_base(const Gemm& g, const Unit& u) { return (const char*)(u.seg ? g.Bt2 : g.Bt) + (size_t)u.pn * 256 * (size_t)g.K * 2; }
template <class T, class = void> struct has_twoseg : std::false_type {};
template <class T> struct has_twoseg<T, std::void_t<decltype(T::TWOSEG)>> : std::true_type {};

struct StaticOrder {
    int nM, nN, nwg, G, c;
    __host__ __device__ void init(int M, int N, int G_, int c_) { nM = M / BM; nN = N / BM; nwg = nM * nN; G = G_; c = c_; }
    __host__ __device__ bool next(int i, Unit& u) const {
        const long L = (long)i * G + c; if (L >= nwg) return false;
        int wgid = (int)L; { const int q = nwg / NXCD, r = nwg % NXCD, xcd = wgid % NXCD, off = wgid / NXCD; wgid = (xcd < r ? xcd * (q + 1) : r * (q + 1) + (xcd - r) * q) + off; }
        const int nig = WGM * nN, gid = wgid / nig, fm = gid * WGM, gsz = (nM - fm) < WGM ? (nM - fm) : WGM;
        u.pm = fm + ((wgid % nig) % gsz); u.pn = (wgid % nig) / gsz; u.seg = 0; return true;
    }
    __device__ __forceinline__ void a_ready(const Unit&) const {}
    __device__ __forceinline__ void done(const Unit&) const {}
};
struct StaticOrder2 { StaticOrder b;
    __host__ __device__ void init(int M, int N, int G_, int c_) { b.init(M, N, G_, c_); }
    __host__ __device__ bool next(int i, Unit& u) const { if (!b.next(i >> 1, u)) return false; u.seg = i & 1; return true; }
    __device__ __forceinline__ void a_ready(const Unit&) const {}
    __device__ __forceinline__ void done(const Unit&) const {}
};
typedef float f32x2c __attribute__((ext_vector_type(2))); typedef __bf16 bf16x2c __attribute__((ext_vector_type(2)));
__device__ __forceinline__ unsigned cvt_pk_bf16(float lo, float hi) { f32x2c v = {lo, hi}; bf16x2c b = __builtin_convertvector(v, bf16x2c); return __builtin_bit_cast(unsigned, b); }
typedef float f32x2 __attribute__((ext_vector_type(2)));
typedef unsigned u32x2 __attribute__((ext_vector_type(2)));
__device__ __forceinline__ u32x4 pack8(const f32x4 v0, const f32x4 v1) { u32x4 w; w.x = cvt_pk_bf16(v0[0], v0[1]); w.y = cvt_pk_bf16(v0[2], v0[3]); w.z = cvt_pk_bf16(v1[0], v1[1]); w.w = cvt_pk_bf16(v1[2], v1[3]); return w; }
__device__ __forceinline__ void unpack8(const u32x4 w, f32x4& a, f32x4& b) {
    a[0] = __uint_as_float(w.x << 16); a[1] = __uint_as_float(w.x & 0xffff0000u); a[2] = __uint_as_float(w.y << 16); a[3] = __uint_as_float(w.y & 0xffff0000u);
    b[0] = __uint_as_float(w.z << 16); b[1] = __uint_as_float(w.z & 0xffff0000u); b[2] = __uint_as_float(w.w << 16); b[3] = __uint_as_float(w.w & 0xffff0000u); }
__device__ __forceinline__ float sigm(float x) { return __builtin_amdgcn_rcpf(1.f + __expf(-x)); }
__device__ __forceinline__ f32x4 sigm4(f32x4 v) { f32x4 r; r[0] = sigm(v[0]); r[1] = sigm(v[1]); r[2] = sigm(v[2]); r[3] = sigm(v[3]); return r; }
__device__ __forceinline__ unsigned q8x4(f32x4 v) { return (unsigned)(v[0] * 255.f + 0.5f) | ((unsigned)(v[1] * 255.f + 0.5f) << 8) | ((unsigned)(v[2] * 255.f + 0.5f) << 16) | ((unsigned)(v[3] * 255.f + 0.5f) << 24); }
__device__ __forceinline__ f32x4 u8x4(unsigned w) { f32x4 r; r[0] = (float)(w & 0xffu); r[1] = (float)((w >> 8) & 0xffu); r[2] = (float)((w >> 16) & 0xffu); r[3] = (float)(w >> 24); return r; }
__device__ __forceinline__ float dot4(f32x4 v) { return (v[0] * v[0] + v[1] * v[1]) + (v[2] * v[2] + v[3] * v[3]); }
constexpr float QSCALE = 0.125f * 1.4426950408889634f;

#define EPI_LOOP_AM _Pragma("unroll") for (int ai = 0; ai < 2; ++ai) _Pragma("unroll") for (int m = 0; m < 4; ++m)

struct EpiProj1 {
    static constexpr bool PERM = true, AFTER_DRAIN = false;
    bf16_t *Q, *K, *V, *XBC; float* DT; float* NORM;
    __device__ __forceinline__ void operator()(const f32x4 (&acc)[2][2][4][2], const Unit& u, int wr, int wc, int fr, int fq) const {
        const int pn = u.pn, row0 = u.pm * BM + wr * 64 + fr;
        if (pn == 18) {
            if (wc == 0 && fq < 2) {
                EPI_LOOP_AM { float* p = DT + (size_t)(row0 + ai * HALF + m * 16) * 16 + 8 * fq; *(f32x4*)p = acc[ai][0][m][0]; *(f32x4*)(p + 4) = acc[ai][0][m][1]; }
            }
            return;
        }
        bf16_t* base; int ldc, colt; float sc = 1.f;
        if (pn < 4) { base = Q; ldc = 1024; colt = pn * 256; sc = QSCALE; }
        else if (pn < 8) { base = K; ldc = 1024; colt = (pn - 4) * 256; }
        else if (pn < 12) { base = V; ldc = 1024; colt = (pn - 8) * 256; }
        else { base = XBC; ldc = 1536; colt = (pn - 12) * 256; }
        const int col0 = colt + wc * 32 + 8 * fq;
        float mx[2] = {0.f, 0.f};
        EPI_LOOP_AM { bf16_t* rowp = base + (size_t)(row0 + ai * HALF + m * 16) * ldc + col0;
#pragma unroll
            for (int bj = 0; bj < 2; ++bj) { const f32x4 v0 = acc[ai][bj][m][0] * sc, v1 = acc[ai][bj][m][1] * sc; *(u32x4*)(rowp + bj * HALF) = pack8(v0, v1);
                if (pn < 8) { float ss = dot4(v0) + dot4(v1); ss += __shfl_xor(ss, 16); ss += __shfl_xor(ss, 32); mx[bj] = fmaxf(mx[bj], ss); } } }
        if (pn < 8) {
#pragma unroll
            for (int bj = 0; bj < 2; ++bj) { float v = mx[bj]; v = fmaxf(v, __shfl_xor(v, 1)); v = fmaxf(v, __shfl_xor(v, 2)); v = fmaxf(v, __shfl_xor(v, 4)); v = fmaxf(v, __shfl_xor(v, 8));
                if (fr == 0 && fq == 0) atomicMax((unsigned*)NORM + (((pn >> 2) * 8 + (pn & 3) * 2 + bj) * 2 + (wc >> 1)) * 2 + (wc & 1), __float_as_uint(v * 1.02f)); }
        }
    }
};
struct EpiZG {
    static constexpr bool PERM = true, AFTER_DRAIN = false;
    const bf16_t* Y; bf16_t *YZ, *G; const float* gbias; float* SSQ3;
    __device__ __forceinline__ void operator()(const f32x4 (&acc)[2][2][4][2], const Unit& u, int wr, int wc, int fr, int fq) const {
        const int pn = u.pn, row0 = u.pm * BM + wr * 64 + fr;
        if (pn < 4) {
            const int col0 = pn * 256 + wc * 32 + 8 * fq; const int prow0 = row0 + 128 * (u.pm / 32 + 1);
            EPI_LOOP_AM { const int rr = ai * HALF + m * 16; float ss = 0.f;
#pragma unroll
                for (int bj = 0; bj < 2; ++bj) { f32x4 y0, y1; unpack8(*(const u32x4*)(Y + (size_t)(prow0 + rr) * 1024 + col0 + bj * HALF), y0, y1);
                    const f32x4 z0 = acc[ai][bj][m][0], z1 = acc[ai][bj][m][1]; const f32x4 v0 = y0 * z0 * sigm4(z0), v1 = y1 * z1 * sigm4(z1);
                    *(u32x4*)(YZ + (size_t)(row0 + rr) * 1024 + col0 + bj * HALF) = pack8(v0, v1); ss += dot4(v0) + dot4(v1); }
                ss += __shfl_xor(ss, 16); ss += __shfl_xor(ss, 32);
                if (fq == 0) atomicAdd(SSQ3 + row0 + rr, ss); }
        } else {
            const int col0 = (pn - 4) * 256 + wc * 32 + 8 * fq;
            f32x4 bv[2][2];
#pragma unroll
            for (int bj = 0; bj < 2; ++bj) { bv[bj][0] = *(const f32x4*)(gbias + col0 + bj * HALF); bv[bj][1] = *(const f32x4*)(gbias + col0 + bj * HALF + 4); }
            EPI_LOOP_AM { unsigned char* rowp = (unsigned char*)G + (size_t)(row0 + ai * HALF + m * 16) * 2048 + col0;
#pragma unroll
                for (int bj = 0; bj < 2; ++bj) { u32x2 w; w.x = q8x4(sigm4(acc[ai][bj][m][0] + bv[bj][0])); w.y = q8x4(sigm4(acc[ai][bj][m][1] + bv[bj][1])); *(u32x2*)(rowp + bj * HALF) = w; } }
        }
    }
};
struct EpiBranch {
    static constexpr bool PERM = true, AFTER_DRAIN = false, TWOSEG = true;
    const bf16_t* G; bf16_t* MG; const float* SSQ3;
    __device__ __forceinline__ void mid(f32x4 (&acc)[2][2][4][2], const Unit& u, int wr, int wc, int fr, int fq) const {
        const int row0 = u.pm * BM + wr * 64 + fr, col0 = u.pn * 256 + wc * 32 + 8 * fq;
        EPI_LOOP_AM { const size_t row = (size_t)(row0 + ai * HALF + m * 16); const float r3 = rsqrtf(SSQ3[row] * (1.f / 1024.f) + 1e-6f);
#pragma unroll
            for (int bj = 0; bj < 2; ++bj) { const int c = col0 + bj * HALF; const unsigned char* gp = (const unsigned char*)G + row * 2048 + c;
                const u32x2 ws = *(const u32x2*)gp, wa = *(const u32x2*)(gp + 1024);
                const f32x4 s0 = u8x4(ws.x), s1 = u8x4(ws.y), a0 = u8x4(wa.x), a1 = u8x4(wa.y);
#pragma unroll
                for (int e = 0; e < 4; ++e) { acc[ai][bj][m][0][e] *= r3 * s0[e] * __builtin_amdgcn_rcpf(fmaxf(a0[e], 1.f)); acc[ai][bj][m][1][e] *= r3 * s1[e] * __builtin_amdgcn_rcpf(fmaxf(a1[e], 1.f)); } } }
    }
    __device__ __forceinline__ void operator()(f32x4 (&acc)[2][2][4][2], const Unit& u, int wr, int wc, int fr, int fq) const {
        const int row0 = u.pm * BM + wr * 64 + fr, col0 = u.pn * 256 + wc * 32 + 8 * fq;
        EPI_LOOP_AM { const size_t row = (size_t)(row0 + ai * HALF + m * 16);
#pragma unroll
            for (int bj = 0; bj < 2; ++bj) { const int c = col0 + bj * HALF; const u32x2 wa = *(const u32x2*)((const unsigned char*)G + row * 2048 + 1024 + c); f32x4 a0 = u8x4(wa.x), a1 = u8x4(wa.y);
#pragma unroll
                for (int e = 0; e < 4; ++e) { a0[e] = fmaxf(a0[e], 1.f) * (1.f / 255.f); a1[e] = fmaxf(a1[e], 1.f) * (1.f / 255.f); }
                *(u32x4*)(MG + row * 1024 + c) = pack8(acc[ai][bj][m][0] * a0, acc[ai][bj][m][1] * a1); } }
    }
};
struct EpiWout {
    static constexpr bool PERM = true, AFTER_DRAIN = false;
    const float* X; float* H1; bf16_t* H1B; float* SSQ;
    __device__ __forceinline__ void operator()(const f32x4 (&acc)[2][2][4][2], const Unit& u, int wr, int wc, int fr, int fq) const {
        const int row0 = u.pm * BM + wr * 64 + fr, col0 = u.pn * 256 + wc * 32 + 8 * fq;
        EPI_LOOP_AM { const size_t row = (size_t)(row0 + ai * HALF + m * 16); float ss = 0.f;
#pragma unroll
            for (int bj = 0; bj < 2; ++bj) { const size_t o = row * 1024 + col0 + bj * HALF;
                const f32x4 v0 = *(const f32x4*)(X + o) + acc[ai][bj][m][0], v1 = *(const f32x4*)(X + o + 4) + acc[ai][bj][m][1];
                *(u32x4*)(H1B + o) = pack8(v0, v1); ss += dot4(v0) + dot4(v1); }
            ss += __shfl_xor(ss, 16); ss += __shfl_xor(ss, 32);
            if (fq == 0) atomicAdd(SSQ + row, ss); }
    }
};
struct EpiGU {
    static constexpr bool PERM = true, AFTER_DRAIN = false;
    bf16_t* HF; const float* SSQ;
    __device__ __forceinline__ void operator()(const f32x4 (&acc)[2][2][4][2], const Unit& u, int wr, int wc, int fr, int fq) const {
        const int row0 = u.pm * BM + wr * 64 + fr, col0 = u.pn * 128 + wc * 32 + 8 * fq;
        EPI_LOOP_AM { const size_t row = (size_t)(row0 + ai * HALF + m * 16); const float rstd = rsqrtf(SSQ[row] * (1.f / 1024.f) + 1e-6f);
            f32x4 h[2];
#pragma unroll
            for (int n = 0; n < 2; ++n) { const f32x4 g = acc[ai][0][m][n] * rstd, up = acc[ai][1][m][n] * rstd; h[n] = g * sigm4(g) * up; }
            *(u32x4*)(HF + row * 2816 + col0) = pack8(h[0], h[1]); }
    }
};
struct EpiDownNorm {
    static constexpr bool PERM = true, AFTER_DRAIN = false;
    float* H; const bf16_t* H1B; float* SSQ; unsigned* CNT; const float* gfin;
    __device__ __forceinline__ void operator()(f32x4 (&acc)[2][2][4][2], const Unit& u, int wr, int wc, int fr, int fq) const {
        const int row0 = u.pm * BM + wr * 64 + fr, col0 = u.pn * 256 + wc * 32 + 8 * fq;
        EPI_LOOP_AM { const size_t row = (size_t)(row0 + ai * HALF + m * 16); float ss = 0.f;
#pragma unroll
            for (int bj = 0; bj < 2; ++bj) { const size_t o = row * 1024 + col0 + bj * HALF;
                f32x4 r0, r1; unpack8(*(const u32x4*)(H1B + o), r0, r1); acc[ai][bj][m][0] = acc[ai][bj][m][0] + r0; acc[ai][bj][m][1] = acc[ai][bj][m][1] + r1;
                ss += dot4(acc[ai][bj][m][0]) + dot4(acc[ai][bj][m][1]); }
            ss += __shfl_xor(ss, 16); ss += __shfl_xor(ss, 32);
            if (fq == 0) (void)__hip_atomic_fetch_add(SSQ + row, ss, __ATOMIC_RELAXED, __HIP_MEMORY_SCOPE_AGENT); }
        asm volatile("s_waitcnt vmcnt(0)" ::: "memory");
        unsigned* cnt = CNT + 16 * u.pm;
        if (fr == 0 && fq == 0) (void)__hip_atomic_fetch_add(cnt, 1u, __ATOMIC_RELAXED, __HIP_MEMORY_SCOPE_AGENT);
        for (unsigned sp = 0; sp < (1u << 22); ++sp) {
            if ((unsigned)__builtin_amdgcn_readfirstlane((int)__hip_atomic_load(cnt, __ATOMIC_RELAXED, __HIP_MEMORY_SCOPE_AGENT)) >= 32u) break;
            __builtin_amdgcn_s_sleep(2); }
        f32x4 gv[2][2];
#pragma unroll
        for (int bj = 0; bj < 2; ++bj) { gv[bj][0] = *(const f32x4*)(gfin + col0 + bj * HALF); gv[bj][1] = *(const f32x4*)(gfin + col0 + bj * HALF + 4); }
        EPI_LOOP_AM { const size_t row = (size_t)(row0 + ai * HALF + m * 16);
            const float rs = rsqrtf(__hip_atomic_load(SSQ + row, __ATOMIC_RELAXED, __HIP_MEMORY_SCOPE_AGENT) * (1.f / 1024.f) + 1e-6f);
#pragma unroll
            for (int bj = 0; bj < 2; ++bj) { const size_t o = row * 1024 + col0 + bj * HALF;
                *(f32x4*)(H + o) = acc[ai][bj][m][0] * rs * gv[bj][0]; *(f32x4*)(H + o + 4) = acc[ai][bj][m][1] * rs * gv[bj][1]; } }
    }
};

template <class Epi, class Sched, bool ALIGN_EPI = false, bool SP2 = false>
__device__ __forceinline__ void gemm_phase(PG8_LAS unsigned char* lds, const Gemm g, const Sched& S, const Epi& E) {
    int tid_ = threadIdx.x; asm volatile("" : "+v"(tid_));
    const int tid = tid_, wid = __builtin_amdgcn_readfirstlane(tid >> 6), lane = tid & 63, wr = wid >> 2, wc = wid & 3, fr = lane & 15, fq = lane >> 4;
    const int K = g.K, nt = K / BK;
    unsigned voffA[2], voffB[2];
#pragma unroll
    for (int i = 0; i < 2; ++i) { int R, C; stage_rc(tid * 16 + i * 8192, R, C); const int Rb = Epi::PERM ? ((R & ~31) + perm32(R & 31)) : R;
        voffA[i] = (unsigned)(R * K + C) * 2u; voffB[i] = (unsigned)(Rb * K + C) * 2u; }
    const size_t kstep = (size_t)(BK * 2);
    const size_t hstep = (size_t)HALF * K * 2;
    const size_t tstep = 2 * hstep;
    const unsigned ldsw = (unsigned)wid * 1024u;
    const int aoff = lds_byte(wr * 64 + fr, fq * 8), boff = lds_byte(wc * 32 + fr, fq * 8);
#define PG8_SA(b, h) (((b) * 2 + (h)) * HTB)
#define PG8_SB(b, h) ((4 + (b) * 2 + (h)) * HTB)
#define PG8_STAGE(bufoff, gbase, voff) do { _Pragma("unroll") for (int _i = 0; _i < 2; ++_i) \
        __builtin_amdgcn_global_load_lds((const unsigned*)((const char*)(gbase) + (voff)[_i]), (PG8_LAS unsigned*)(lds + (bufoff) + ldsw + _i * 8192), 16, 0, 0); } while (0)
#define PG8_LDA(dst, b, h) do { _Pragma("unroll") for (int m = 0; m < 4; ++m) _Pragma("unroll") for (int k = 0; k < 2; ++k) dst[m][k] = *(const PG8_LAS bf16x8*)(lds + PG8_SA(b, h) + aoff + m * 2048 + k * 1024); } while (0)
#define PG8_LDB(dst, b, h) do { _Pragma("unroll") for (int n = 0; n < 2; ++n) _Pragma("unroll") for (int k = 0; k < 2; ++k) dst[n][k] = *(const PG8_LAS bf16x8*)(lds + PG8_SB(b, h) + boff + n * 2048 + k * 1024); } while (0)
#define PG8_MMA(ai, bj, At, Bt) do { __builtin_amdgcn_s_setprio(1); _Pragma("unroll") for (int m = 0; m < 4; ++m) _Pragma("unroll") for (int n = 0; n < 2; ++n) _Pragma("unroll") for (int k = 0; k < 2; ++k) \
        acc[ai][bj][m][n] = __builtin_amdgcn_mfma_f32_16x16x32_bf16(Bt[n][k], At[m][k], acc[ai][bj][m][n], 0, 0, 0); __builtin_amdgcn_s_setprio(0); } while (0)
#define PG8_WAIT_V(n) asm volatile("s_waitcnt vmcnt(" #n ")" ::: "memory")
#define PG8_WAIT_L(n) asm volatile("s_waitcnt lgkmcnt(" #n ")" ::: "memory")
#define PG8_BAR __builtin_amdgcn_s_barrier()
#define PG8_SCHED __builtin_amdgcn_sched_barrier(0)
    Unit cur, nxt; int ui = 0;
    if (!S.next(0, cur)) return;
    f32x4 acc[2][2][4][2];
#pragma unroll
    for (int a = 0; a < 2; ++a)
#pragma unroll
        for (int b = 0; b < 2; ++b)
#pragma unroll
            for (int m = 0; m < 4; ++m)
#pragma unroll
                for (int n = 0; n < 2; ++n) acc[a][b][m][n] = (f32x4){0.f, 0.f, 0.f, 0.f};
    bf16x8 At[4][2], B0[2][2], B1[2][2];
    const char* cA = a_base(g, cur); const char* cB = b_base(g, cur);
    S.a_ready(cur);
    if constexpr (SP2) {
        PG8_STAGE(PG8_SB(0, 0), cB, voffB); PG8_STAGE(PG8_SB(0, 1), cB + hstep, voffB); PG8_STAGE(PG8_SA(0, 0), cA, voffA); PG8_STAGE(PG8_SA(0, 1), cA + hstep, voffA);
        if (wr == 1) PG8_BAR;
        PG8_WAIT_V(2); PG8_BAR;
        PG8_STAGE(PG8_SB(1, 0), cB + kstep, voffB); PG8_STAGE(PG8_SA(1, 0), cA + kstep, voffA); PG8_STAGE(PG8_SB(1, 1), cB + hstep + kstep, voffB);
        PG8_WAIT_V(6); PG8_BAR;
    } else {
        PG8_STAGE(PG8_SB(0, 0), cB, voffB); PG8_STAGE(PG8_SA(0, 0), cA, voffA); PG8_STAGE(PG8_SB(0, 1), cB + hstep, voffB); PG8_STAGE(PG8_SA(0, 1), cA + hstep, voffA);
        if (wr == 1) PG8_BAR;
        PG8_WAIT_V(4); PG8_BAR;
        PG8_STAGE(PG8_SB(1, 0), cB + kstep, voffB); PG8_STAGE(PG8_SA(1, 0), cA + kstep, voffA); PG8_STAGE(PG8_SB(1, 1), cB + hstep + kstep, voffB);
        PG8_WAIT_V(6); PG8_BAR;
    }
    for (;;) {
        const bool has_next = S.next(ui + 1, nxt);
        const char* nA = has_next ? a_base(g, nxt) : cA; const char* nB = has_next ? b_base(g, nxt) : cB;
        for (int t = 0; t < nt; t += 2) {
            const bool last = (t == nt - 2);
            const char* a1 = cA + (size_t)(t + 1) * kstep;
            const char* a2 = last ? nA : cA + (size_t)(t + 2) * kstep; const char* b2 = last ? nB : cB + (size_t)(t + 2) * kstep;
            const char* a3 = a2 + kstep; const char* b3 = b2 + kstep;
            if (last && has_next) S.a_ready(nxt);
            if constexpr (SP2) {
            PG8_LDB(B0, 0, 0); PG8_LDB(B1, 0, 1); PG8_SCHED; PG8_LDA(At, 0, 0); PG8_STAGE(PG8_SA(1, 1), a1 + hstep, voffA);
            PG8_WAIT_V(8); PG8_WAIT_L(0); PG8_BAR; PG8_MMA(0, 0, At, B0); PG8_MMA(0, 1, At, B1); PG8_BAR; PG8_SCHED;
            PG8_LDA(At, 0, 1); PG8_STAGE(PG8_SB(0, 0), b2, voffB); PG8_STAGE(PG8_SB(0, 1), b2 + hstep, voffB); PG8_STAGE(PG8_SA(0, 0), a2, voffA);
            PG8_WAIT_V(8); PG8_WAIT_L(0); PG8_BAR; PG8_MMA(1, 0, At, B0); PG8_MMA(1, 1, At, B1); PG8_BAR; PG8_SCHED;
            PG8_LDB(B0, 1, 0); PG8_LDB(B1, 1, 1); PG8_SCHED; PG8_LDA(At, 1, 0); PG8_STAGE(PG8_SA(0, 1), a2 + hstep, voffA);
            PG8_WAIT_V(8); PG8_WAIT_L(0); PG8_BAR; PG8_MMA(0, 0, At, B0); PG8_MMA(0, 1, At, B1); PG8_BAR; PG8_SCHED;
            PG8_LDA(At, 1, 1); PG8_STAGE(PG8_SB(1, 0), b3, voffB); PG8_STAGE(PG8_SB(1, 1), b3 + hstep, voffB); PG8_STAGE(PG8_SA(1, 0), a3, voffA);
            PG8_WAIT_V(8); PG8_WAIT_L(0); PG8_BAR; PG8_MMA(1, 0, At, B0); PG8_MMA(1, 1, At, B1); PG8_BAR; PG8_SCHED;
            } else {
            PG8_LDB(B0, 0, 0); PG8_SCHED; PG8_LDA(At, 0, 0); PG8_STAGE(PG8_SA(1, 1), a1 + hstep, voffA);
            PG8_WAIT_L(8); PG8_BAR; PG8_WAIT_L(0); PG8_MMA(0, 0, At, B0); PG8_BAR; PG8_SCHED;
            PG8_LDB(B1, 0, 1); PG8_STAGE(PG8_SB(0, 0), b2, voffB);
            PG8_BAR; PG8_WAIT_L(0); PG8_MMA(0, 1, At, B1); PG8_BAR;
            PG8_LDA(At, 0, 1); PG8_STAGE(PG8_SA(0, 0), a2, voffA);
            PG8_BAR; PG8_WAIT_L(0); PG8_MMA(1, 0, At, B0); PG8_BAR; PG8_SCHED;
            PG8_STAGE(PG8_SB(0, 1), b2 + hstep, voffB);
            PG8_WAIT_V(6); PG8_BAR; PG8_MMA(1, 1, At, B1); PG8_BAR;
            PG8_LDB(B0, 1, 0); PG8_SCHED; PG8_LDA(At, 1, 0); PG8_STAGE(PG8_SA(0, 1), a2 + hstep, voffA);
            PG8_WAIT_L(8); PG8_BAR; PG8_WAIT_L(0); PG8_MMA(0, 0, At, B0); PG8_BAR; PG8_SCHED;
            PG8_LDB(B1, 1, 1); PG8_STAGE(PG8_SB(1, 0), b3, voffB);
            PG8_BAR; PG8_WAIT_L(0); PG8_MMA(0, 1, At, B1); PG8_BAR;
            PG8_LDA(At, 1, 1); PG8_STAGE(PG8_SA(1, 0), a3, voffA);
            PG8_BAR; PG8_WAIT_L(0); PG8_MMA(1, 0, At, B0); PG8_BAR; PG8_SCHED;
            PG8_STAGE(PG8_SB(1, 1), b3 + hstep, voffB);
            PG8_WAIT_V(6); PG8_BAR; PG8_MMA(1, 1, At, B1); PG8_BAR;
            }
        }
        if constexpr (ALIGN_EPI) { if (wr == 0) PG8_BAR; }
        bool keep_acc = false;
        if constexpr (has_twoseg<Epi>::value) { if (cur.seg == 0) { E.mid(acc, cur, wr, wc, fr, fq); keep_acc = true; } else { E(acc, cur, wr, wc, fr, fq); } }
        else if constexpr (!Epi::AFTER_DRAIN) { E(acc, cur, wr, wc, fr, fq); S.done(cur); }
        if (!has_next) break;
        if (!keep_acc)
#pragma unroll
        for (int a = 0; a < 2; ++a)
#pragma unroll
            for (int b = 0; b < 2; ++b)
#pragma unroll
                for (int m = 0; m < 4; ++m)
#pragma unroll
                    for (int n = 0; n < 2; ++n) acc[a][b][m][n] = (f32x4){0.f, 0.f, 0.f, 0.f};
        cur = nxt; cA = nA; cB = nB; ++ui;
        if constexpr (ALIGN_EPI) { if (wr == 1) PG8_BAR; }
    }
    PG8_WAIT_V(0);
    if constexpr (!ALIGN_EPI) { if (wr == 0) PG8_BAR; }
    PG8_BAR;
    if constexpr (Epi::AFTER_DRAIN) { E.fused(acc, cur, wr, wc, fr, fq, lds, wid, lane); S.done(cur); }
#undef PG8_SA
#undef PG8_SB
#undef PG8_STAGE
#undef PG8_LDA
#undef PG8_LDB
#undef PG8_MMA
#undef PG8_WAIT_V
#undef PG8_WAIT_L
#undef PG8_BAR
#undef PG8_SCHED
}
}
namespace attn_body {
using bf16=__hip_bfloat16;
using bf16x8=__attribute__((ext_vector_type(8)))short;
using s16x4=__attribute__((ext_vector_type(4)))short;
using f32x16=__attribute__((ext_vector_type(16)))float;
using u32x4=__attribute__((ext_vector_type(4)))unsigned;
constexpr int D=64,PQ=1024,PO=2048,LP=8320;
constexpr int NW=8,QBLK=32,QB=QBLK*NW,KVBLK=64,NQB=32;
__device__ __forceinline__ int crow(int r,int hi){return (r&3)+8*(r>>2)+4*hi;}
#define SBAR() __builtin_amdgcn_sched_barrier(0)
__device__ __forceinline__ void cmask(f32x16&p0,f32x16&p1,int jb,int qrel,int hi){
  const float NEG=-INFINITY; int kb=64*jb+4*hi;
  #pragma unroll
  for(int r=0;r<16;++r){int kv=kb+(r&3)+8*(r>>2); if(kv>qrel)p0[r]=NEG; if(kv+32>qrel)p1[r]=NEG;}
}

constexpr int NSLOT=3, SLOTB=8192;
constexpr int LDS_K=0, LDS_V=NSLOT*SLOTB, LDS_WS=2*NSLOT*SLOTB, LDS_OST=LDS_WS+NW*64*4, LDS_BYTES=LDS_OST+NW*4096;
constexpr float C2=0.125f*1.4426950408889634f;
__device__ __forceinline__ void glds16(const void*gsrc,unsigned lds_dst){unsigned keep;
  asm volatile("s_mov_b32 %0, m0\n\ts_mov_b32 m0, %2\n\ts_nop 0\n\tglobal_load_lds_dwordx4 %1, off\n\ts_mov_b32 m0, %0":"=&s"(keep):"v"(gsrc),"s"(lds_dst):"memory");}
__device__ __forceinline__ float max3f(float a,float b,float c){float r;asm("v_max3_f32 %0, %1, %2, %3":"=v"(r):"v"(a),"v"(b),"v"(c));return r;}
__device__ __forceinline__ float max2f(float a,float b){float r;asm("v_max_f32_e32 %0, %1, %2":"=v"(r):"v"(a),"v"(b));return r;}
__device__ __forceinline__ float fadd_s(float a,float b){float r;asm("v_add_f32_e32 %0, %1, %2":"=v"(r):"v"(a),"v"(b));return r;}
__device__ __forceinline__ float fsub_s(float a,float b){float r;asm("v_sub_f32_e32 %0, %1, %2":"=v"(r):"v"(a),"v"(b));return r;}
typedef float f32x2_t __attribute__((ext_vector_type(2))); typedef __bf16 bf16x2_t __attribute__((ext_vector_type(2)));
__device__ __forceinline__ unsigned cvtpk_s(float lo,float hi){f32x2_t v={lo,hi};bf16x2_t b=__builtin_convertvector(v,bf16x2_t);return __builtin_bit_cast(unsigned,b);}
#define WAIT_BAR(N) asm volatile("s_waitcnt vmcnt(" #N ") lgkmcnt(0)\n\ts_barrier":::"memory")

__device__ __forceinline__ void qkt(f32x16&p0,f32x16&p1,const char*Kslot,const bf16x8*qr,const f32x16&ci0,const f32x16&ci1,int r32,int hi){
  const char*kb=Kslot+hi*1024+r32*16;
  #pragma unroll
  for(int d0=0;d0<4;++d0){
    const bf16x8 b0=*reinterpret_cast<const bf16x8*>(kb+d0*2048);
    const bf16x8 b1=*reinterpret_cast<const bf16x8*>(kb+d0*2048+512);
    if(d0==0){p0=__builtin_amdgcn_mfma_f32_32x32x16_bf16(b0,qr[0],ci0,0,0,0);p1=__builtin_amdgcn_mfma_f32_32x32x16_bf16(b1,qr[0],ci1,0,0,0);}
    else{p0=__builtin_amdgcn_mfma_f32_32x32x16_bf16(b0,qr[d0],p0,0,0,0);p1=__builtin_amdgcn_mfma_f32_32x32x16_bf16(b1,qr[d0],p1,0,0,0);}}
}
typedef __attribute__((address_space(3))) const char* lds_cptr;
typedef short v4i16_t __attribute__((ext_vector_type(4)));
__device__ __forceinline__ void kload8(bf16x8*kf,lds_cptr kp){
  kf[0]=*(const __attribute__((address_space(3))) bf16x8*)(kp);      kf[1]=*(const __attribute__((address_space(3))) bf16x8*)(kp+512);
  kf[2]=*(const __attribute__((address_space(3))) bf16x8*)(kp+2048); kf[3]=*(const __attribute__((address_space(3))) bf16x8*)(kp+2560);
  kf[4]=*(const __attribute__((address_space(3))) bf16x8*)(kp+4096); kf[5]=*(const __attribute__((address_space(3))) bf16x8*)(kp+4608);
  kf[6]=*(const __attribute__((address_space(3))) bf16x8*)(kp+6144); kf[7]=*(const __attribute__((address_space(3))) bf16x8*)(kp+6656);
}
__device__ __forceinline__ void kload2(bf16x8*kf,lds_cptr kp,int j){ kf[2*j]=*(const __attribute__((address_space(3))) bf16x8*)(kp+j*2048); kf[2*j+1]=*(const __attribute__((address_space(3))) bf16x8*)(kp+j*2048+512); }
__device__ __forceinline__ s16x4 vtr(lds_cptr p){ return __builtin_bit_cast(s16x4,__builtin_amdgcn_ds_read_tr16_b64_v4i16((__attribute__((address_space(3))) v4i16_t*)p)); }
__device__ __forceinline__ float rowmax(const f32x16&p0,const f32x16&p1){
  float a=max3f(p0[0],p0[1],p1[0]),b=max3f(p0[2],p0[3],p1[1]);a=max3f(a,p1[2],p1[3]);
  #pragma unroll
  for(int r=4;r<16;r+=4){a=max3f(a,p0[r],p0[r+1]);b=max3f(b,p0[r+2],p0[r+3]);a=max3f(a,p1[r],p1[r+1]);b=max3f(b,p1[r+2],p1[r+3]);}
  const float m=max2f(a,b);
  auto rr=__builtin_amdgcn_permlane32_swap(__float_as_uint(m),__float_as_uint(m),false,false);
  return max2f(__uint_as_float(rr[0]),__uint_as_float(rr[1]));
}
__device__ __forceinline__ void pv(f32x16*o,int vb,bf16x8 pa0,bf16x8 pa1,bf16x8 pa2,bf16x8 pa3){
  #pragma unroll
  for(int d0=0;d0<2;++d0){s16x4 lo[4],hi[4];
    #pragma unroll
    for(int ks=0;ks<4;++ks){
      asm volatile("ds_read_b64_tr_b16 %0,%1 offset:%c2":"=&v"(lo[ks]):"v"(vb),"i"(d0*4096+ks*1024):"memory");
      asm volatile("ds_read_b64_tr_b16 %0,%1 offset:%c2":"=&v"(hi[ks]):"v"(vb),"i"(d0*4096+ks*1024+512):"memory");}
    asm volatile("s_waitcnt lgkmcnt(0)":::"memory");SBAR();
    #define PK(k) (bf16x8){lo[k][0],lo[k][1],lo[k][2],lo[k][3],hi[k][0],hi[k][1],hi[k][2],hi[k][3]}
    o[d0]=__builtin_amdgcn_mfma_f32_32x32x16_bf16(pa0,PK(0),o[d0],0,0,0);
    o[d0]=__builtin_amdgcn_mfma_f32_32x32x16_bf16(pa1,PK(1),o[d0],0,0,0);
    o[d0]=__builtin_amdgcn_mfma_f32_32x32x16_bf16(pa2,PK(2),o[d0],0,0,0);
    o[d0]=__builtin_amdgcn_mfma_f32_32x32x16_bf16(pa3,PK(3),o[d0],0,0,0);
    #undef PK
  }
}

#ifndef ATTN_STORE16
#define ATTN_STORE16(p,v) (*(u32x4*)(p)=(v))
#endif
template<int THRL> __device__ __forceinline__ void attn_unit(int b,int h,int c,int vh,int qb,int t0,const bf16*Q,const bf16*__restrict__ K,const bf16*__restrict__ V,bf16*O,char*shm){
  int tid_=threadIdx.x; asm volatile("":"+v"(tid_)); const int tid=tid_,lane=tid&63,r32=lane&31,hi=lane>>5; const int wid=__builtin_amdgcn_readfirstlane(tid>>6);
  const long rowbase=(long)b*LP+64; const int q0=64+qb*QB;
  const bf16*Qw=Q+(rowbase+q0+wid*QBLK)*PQ+h*128+c*64;
  const bf16*Kh=K+(rowbase+(long)t0*KVBLK)*PQ+h*128+c*64,*Vh=V+(rowbase+(long)t0*KVBLK)*PQ+h*128+vh*64;
  const float s2=__builtin_amdgcn_exp2f(-(float)(h+1))*1.4426950408889634f;
  const unsigned lds0=(unsigned)(uintptr_t)shm;
  float*wsf=(float*)(shm+LDS_WS)+wid*64;
  const bf16*ksrc=Kh+(long)lane*PQ+wid*8;
  const bf16*vsrc=Vh+(long)(16*(wid&3)+(lane>>2))*PQ+(wid>>2)*32+(lane&3)*8;
  const unsigned kdst=lds0+LDS_K+wid*1024, vdst=lds0+LDS_V+wid*1024;
  #define DMA_K(t,slot) glds16(ksrc+(long)(t)*KVBLK*PQ,(unsigned)__builtin_amdgcn_readfirstlane(kdst+(slot)))
  #define DMA_V(t,slot) glds16(vsrc+(long)(t)*KVBLK*PQ,(unsigned)__builtin_amdgcn_readfirstlane(vdst+(slot)))
  const int vb0=(int)(lds0+LDS_V)+((lane>>4)&1)*32+(lane&3)*8+(4*hi+((lane&15)>>2))*64;
  const char*Kbase=shm+LDS_K; bf16x8 kf[8];
  const lds_cptr shm3=(lds_cptr)shm; const lds_cptr kp0=shm3+LDS_K+hi*1024+r32*16; const lds_cptr vp0=shm3+LDS_V+((lane>>4)&1)*32+(lane&3)*8+(4*hi+((lane&15)>>2))*64;
  const int NT=(q0+QB)/KVBLK-t0;
  DMA_K(0,0);DMA_V(0,0);DMA_K(1,SLOTB);
  bf16x8 qr[4];
  #pragma unroll
  for(int d0=0;d0<4;++d0)qr[d0]=*reinterpret_cast<const bf16x8*>(&Qw[(long)r32*PQ+d0*16+hi*8]);
  float mhat=0.f,l_reg=0.f;f32x16 o[2];o[0]=f32x16{};o[1]=f32x16{};
  #define RFL(x) __uint_as_float((unsigned)__builtin_amdgcn_readfirstlane((int)__float_as_uint(x)))
  const float s2x1=RFL(s2),s2x2=RFL(2.f*s2),s2x3=RFL(3.f*s2),s2x8=RFL(8.f*s2),s2x16=RFL(16.f*s2),s2x24=RFL(24.f*s2),s2_32=RFL(32.f*s2),s2_64=RFL(64.f*s2);
  const float hi4=hi?4.f*s2:0.f;
  #define CINIT(C0,C1,t) do{ const float tbh_=(s2_64*(float)((t)-(NT-4))-mhat)+hi4; \
    { const float g0_=tbh_,g1_=tbh_+s2x8,g2_=tbh_+s2x16,g3_=tbh_+s2x24; \
      C0[0]=g0_;C0[1]=g0_+s2x1;C0[2]=g0_+s2x2;C0[3]=g0_+s2x3; C0[4]=g1_;C0[5]=g1_+s2x1;C0[6]=g1_+s2x2;C0[7]=g1_+s2x3; \
      C0[8]=g2_;C0[9]=g2_+s2x1;C0[10]=g2_+s2x2;C0[11]=g2_+s2x3; C0[12]=g3_;C0[13]=g3_+s2x1;C0[14]=g3_+s2x2;C0[15]=g3_+s2x3; } \
    _Pragma("unroll") for(int r=0;r<16;++r)C1[r]=C0[r]+s2_32; }while(0)
  const int qrel=wid*QBLK+r32;
  #define CMASK(P0,P1,t) do{int jb_=(t)-(NT-4); if(jb_>=0)cmask(P0,P1,jb_,qrel,hi);}while(0)
  bool resc=false;
  #define START(P0,P1) do{ const float rm=rowmax(P0,P1); resc=false; \
    { const float dl=rm; mhat=fadd_s(mhat,dl); \
      _Pragma("unroll") for(int r=0;r<16;++r){P0[r]=fsub_s(P0[r],dl);P1[r]=fsub_s(P1[r],dl);} } \
    _Pragma("unroll") for(int r=0;r<16;++r)P0[r]=__builtin_amdgcn_exp2f(P0[r]); }while(0)
  #define RESC() do{ if(resc){ asm volatile("s_waitcnt lgkmcnt(0)":::"memory"); \
      _Pragma("unroll") for(int d_=0;d_<2;++d_) _Pragma("unroll") for(int r=0;r<16;++r)o[d_][r]*=wsf[crow(r,hi)]; } }while(0)
  f32x16 pA0,pA1,pB0,pB1;
  int sl_prev=0,sl_cur=0,sl_next=SLOTB;
  #define ROT() do{sl_prev=sl_cur;sl_cur=sl_next;sl_next=(sl_next==(NSLOT-1)*SLOTB)?0:sl_next+SLOTB;}while(0)
  DMA_K(2,2*SLOTB);
  WAIT_BAR(3);
  { f32x16 ci0,ci1; CINIT(ci0,ci1,0); qkt(pA0,pA1,Kbase,qr,ci0,ci1,r32,hi); } asm volatile("s_nop 15\n\ts_nop 7":"+v"(pA0),"+v"(pA1));
  if(t0==0){ const float NEGI=-INFINITY; _Pragma("unroll") for(int r=0;r<16;++r)pA0[r]=NEGI; _Pragma("unroll") for(int r=0;r<8;++r)pA1[r]=NEGI; }
  START(pA0,pA1);
  _Pragma("unroll") for(int r=0;r<16;++r)pA1[r]=__builtin_amdgcn_exp2f(pA1[r]);
  WAIT_BAR(0);
  DMA_K(3,0);DMA_V(1,SLOTB);
  ROT();
  kload8(kf,kp0+sl_cur);
  WAIT_BAR(2);
  s16x4 vlo[8],vhi[8]; u32x4 pw0,pw1,pw2,pw3;
  #define PKW(P,B) cvtpk_s(P[B],P[B+1])
  #define PAF(k) __builtin_bit_cast(bf16x8,pw##k)
  #define VFR(i) (bf16x8){vlo[i][0],vlo[i][1],vlo[i][2],vlo[i][3],vhi[i][0],vhi[i][1],vhi[i][2],vhi[i][3]}
  #define PIN(x) asm volatile("":"+v"(x))
  #define MX3(a,b,c) __builtin_fmaxf(__builtin_fmaxf((a),(b)),(c))
  #define GAPA(MF,A0,A1,A2,A3,W0,W1,PW) do{ MF; sacc+=A0; sacc+=A1; sacc+=A2; sacc+=A3; PIN(sacc); W0; W1; PIN(PW); SBAR(); }while(0)
  #define EX(v) __builtin_amdgcn_exp2f(v)
  #define GAPB(MF,X,B,INI) do{ MF; X[B]=EX(X[B]); X[B+1]=EX(X[B+1]); X[B+2]=EX(X[B+2]); X[B+3]=EX(X[B+3]); PIN(X); INI; SBAR(); }while(0)
  #define NI0(P,g) do{ P[4*(g)]=gn##g##_; P[4*(g)+1]=gn##g##_+s2x1; P[4*(g)+2]=gn##g##_+s2x2; P[4*(g)+3]=gn##g##_+s2x3; PIN(P); }while(0)
  #define NI1(P1,P0,g) do{ P1[4*(g)]=P0[4*(g)]+s2_32; P1[4*(g)+1]=P0[4*(g)+1]+s2_32; P1[4*(g)+2]=P0[4*(g)+2]+s2_32; P1[4*(g)+3]=P0[4*(g)+3]+s2_32; PIN(P1); }while(0)
  #define VRD(i) do{ vlo[i]=vtr(vp_+(((i)>>2)*4096+((i)&3)*1024)); vhi[i]=vtr(vp_+(((i)>>2)*4096+((i)&3)*1024+512)); }while(0)
  #define KRD(G,j) do{ if(G){ kload2(kf,kp0+sl_next,j); SBAR(); } }while(0)
  #define STEP(C0,C1,P0,P1,t,GK,GV,GL) do{ SBAR(); \
    const lds_cptr vp_=vp0+sl_prev; \
    VRD(0); SBAR(); float sacc=(P0[0]+P0[1]); \
    GAPA(C0=__builtin_amdgcn_mfma_f32_32x32x16_bf16(kf[0],qr[0],C0,0,0,0), P0[2],P0[3],P0[4],P0[5],     pw0[0]=PKW(P0,0), pw0[1]=PKW(P0,2), pw0); \
    VRD(4); SBAR(); GAPA(C1=__builtin_amdgcn_mfma_f32_32x32x16_bf16(kf[1],qr[0],C1,0,0,0), P0[6],P0[7],P0[8],P0[9],     pw0[2]=PKW(P0,4), pw0[3]=PKW(P0,6), pw0); \
    VRD(1); SBAR(); GAPA(C0=__builtin_amdgcn_mfma_f32_32x32x16_bf16(kf[2],qr[1],C0,0,0,0),   P0[10],P0[11],P0[12],P0[13], pw1[0]=PKW(P0,8), pw1[1]=PKW(P0,10), pw1); \
    VRD(5); SBAR(); GAPA(C1=__builtin_amdgcn_mfma_f32_32x32x16_bf16(kf[3],qr[1],C1,0,0,0),   P0[14],P0[15],P1[0],P1[1],   pw1[2]=PKW(P0,12),pw1[3]=PKW(P0,14), pw1); \
    VRD(2); SBAR(); GAPA(C0=__builtin_amdgcn_mfma_f32_32x32x16_bf16(kf[4],qr[2],C0,0,0,0),   P1[2],P1[3],P1[4],P1[5],     pw2[0]=PKW(P1,0), pw2[1]=PKW(P1,2), pw2); \
    VRD(6); SBAR(); GAPA(C1=__builtin_amdgcn_mfma_f32_32x32x16_bf16(kf[5],qr[2],C1,0,0,0),   P1[6],P1[7],P1[8],P1[9],     pw2[2]=PKW(P1,4), pw2[3]=PKW(P1,6), pw2); \
    VRD(3); SBAR(); GAPA(C0=__builtin_amdgcn_mfma_f32_32x32x16_bf16(kf[6],qr[3],C0,0,0,0),   P1[10],P1[11],P1[12],P1[13], pw3[0]=PKW(P1,8), pw3[1]=PKW(P1,10), pw3); \
    VRD(7); SBAR(); GAPA(C1=__builtin_amdgcn_mfma_f32_32x32x16_bf16(kf[7],qr[3],C1,0,0,0),   P1[14],P1[15],0.f,0.f,       pw3[2]=PKW(P1,12),pw3[3]=PKW(P1,14), pw3); \
    l_reg+=sacc; \
    if(GK){DMA_K((t)+3,sl_cur);} if(GV){DMA_V((t)+1,sl_next);} \
    CMASK(C0,C1,t); \
    { float a=MX3(C0[0],C0[1],C1[0]),b=MX3(C0[2],C0[3],C1[1]); a=MX3(a,C1[2],C1[3]); \
      _Pragma("unroll") for(int r=4;r<16;r+=4){a=MX3(a,C0[r],C0[r+1]);b=MX3(b,C0[r+2],C0[r+3]);a=MX3(a,C1[r],C1[r+1]);b=MX3(b,C1[r+2],C1[r+3]);} \
      float rm=__builtin_fmaxf(a,b); { auto rr=__builtin_amdgcn_permlane32_swap(__float_as_uint(rm),__float_as_uint(rm),false,false); rm=__builtin_fmaxf(__uint_as_float(rr[0]),__uint_as_float(rr[1])); } \
      resc=false; \
      if(__builtin_expect(__any(rm>(float)THRL),0)){ const float dl=__builtin_fmaxf(rm,0.f); mhat+=dl; \
        _Pragma("unroll") for(int r=0;r<16;++r){C0[r]-=dl;C1[r]-=dl;} \
        const float f=__builtin_amdgcn_exp2f(-dl); l_reg*=f; if(hi==0)wsf[r32]=f; resc=true; } } \
    SBAR(); \
    const float gn0_=(s2_64*(float)(((t)+1)-(NT-4))-mhat)+hi4, gn1_=gn0_+s2x8, gn2_=gn0_+s2x16, gn3_=gn0_+s2x24; \
    GAPB(o[0]=__builtin_amdgcn_mfma_f32_32x32x16_bf16(PAF(0),VFR(0),o[0],0,0,0), C0,0, NI0(P0,0)); \
    GAPB(o[1]=__builtin_amdgcn_mfma_f32_32x32x16_bf16(PAF(0),VFR(4),o[1],0,0,0), C0,4, NI0(P0,1)); \
    KRD(GL,0); GAPB(o[0]=__builtin_amdgcn_mfma_f32_32x32x16_bf16(PAF(1),VFR(1),o[0],0,0,0), C0,8, NI0(P0,2)); \
    KRD(GL,1); GAPB(o[1]=__builtin_amdgcn_mfma_f32_32x32x16_bf16(PAF(1),VFR(5),o[1],0,0,0), C0,12, NI0(P0,3)); \
    KRD(GL,2); GAPB(o[0]=__builtin_amdgcn_mfma_f32_32x32x16_bf16(PAF(2),VFR(2),o[0],0,0,0), C1,0, NI1(P1,P0,0)); \
    KRD(GL,3); GAPB(o[1]=__builtin_amdgcn_mfma_f32_32x32x16_bf16(PAF(2),VFR(6),o[1],0,0,0), C1,4, NI1(P1,P0,1)); \
    GAPB(o[0]=__builtin_amdgcn_mfma_f32_32x32x16_bf16(PAF(3),VFR(3),o[0],0,0,0), C1,8, NI1(P1,P0,2)); \
    GAPB(o[1]=__builtin_amdgcn_mfma_f32_32x32x16_bf16(PAF(3),VFR(7),o[1],0,0,0), C1,12, NI1(P1,P0,3)); \
    }while(0)
  CINIT(pB0,pB1,1);
  int t=1;
  #undef CMASK
  #define CMASK(P0,P1,t) do{}while(0)
  for(;t+5<NT;t+=2){
    STEP(pB0,pB1,pA0,pA1,t,true,true,true);     WAIT_BAR(2); RESC(); ROT();
    STEP(pA0,pA1,pB0,pB1,t+1,true,true,true);   WAIT_BAR(2); RESC(); ROT();
  }
  #undef CMASK
  #define CMASK(P0,P1,t) do{int jb_=(t)-(NT-4); if(jb_>=0)cmask(P0,P1,jb_,qrel,hi);}while(0)
  #define ENDW(tt) do{ if((tt)+3<NT){WAIT_BAR(2);} else if((tt)+2<NT){WAIT_BAR(1);} else {WAIT_BAR(0);} }while(0)
  for(;t+2<NT;t+=2){
    STEP(pB0,pB1,pA0,pA1,t,(t+3<NT),(t+1<NT),(t+1<NT));       ENDW(t);   RESC(); ROT();
    STEP(pA0,pA1,pB0,pB1,t+1,(t+4<NT),(t+2<NT),(t+2<NT));     ENDW(t+1); RESC(); ROT();
  }
  STEP(pB0,pB1,pA0,pA1,NT-2,false,true,true);   ENDW(NT-2); RESC(); ROT();
  STEP(pA0,pA1,pB0,pB1,NT-1,false,false,false); RESC();
  { float sacc=pA0[0]+pA0[1]; _Pragma("unroll") for(int r=2;r<16;++r)sacc+=pA0[r]; _Pragma("unroll") for(int r=0;r<16;++r)sacc+=pA1[r]; l_reg+=sacc;
    pw0=(u32x4){PKW(pA0,0),PKW(pA0,2),PKW(pA0,4),PKW(pA0,6)};pw1=(u32x4){PKW(pA0,8),PKW(pA0,10),PKW(pA0,12),PKW(pA0,14)};pw2=(u32x4){PKW(pA1,0),PKW(pA1,2),PKW(pA1,4),PKW(pA1,6)};pw3=(u32x4){PKW(pA1,8),PKW(pA1,10),PKW(pA1,12),PKW(pA1,14)};
    SBAR(); pv(o,vb0+sl_cur,PAF(0),PAF(1),PAF(2),PAF(3)); }
  #undef PKW
  #undef PAF
  #undef VFR
  #undef PIN
  #undef MX3
  #undef GAPA
  #undef GAPB
  #undef NI0
  #undef NI1
  #undef EX
  #undef VRD
  #undef KRD
  #undef STEP
  #undef ENDW
  {auto rr=__builtin_amdgcn_permlane32_swap(__float_as_uint(l_reg),__float_as_uint(l_reg),false,false);l_reg=__uint_as_float(rr[0])+__uint_as_float(rr[1]);}
  if(hi==0)wsf[32+r32]=l_reg;asm volatile("s_waitcnt lgkmcnt(0)":::"memory");
  float rli[16];
  #pragma unroll
  for(int r=0;r<16;++r)rli[r]=__builtin_amdgcn_rcpf(wsf[32+crow(r,hi)]);
  bf16*Ow=O+(rowbase+q0+wid*QBLK)*PO+c*1024+h*128+vh*64;
  { bf16*stg=(bf16*)(shm+LDS_OST)+wid*2048;
    #pragma unroll
    for(int r=0;r<16;++r){const int orow=crow(r,hi);
      #pragma unroll
      for(int d0=0;d0<2;++d0)stg[orow*64+d0*32+r32]=__float2bfloat16(o[d0][r]*rli[r]);}
    asm volatile("s_waitcnt lgkmcnt(0)":::"memory");
    #pragma unroll
    for(int i=0;i<4;++i){const int row=i*8+(lane>>3),ch=lane&7; const u32x4 v=*(const u32x4*)(stg+row*64+ch*8); ATTN_STORE16(Ow+(long)row*PO+ch*8,v);} }
  asm volatile("s_waitcnt lgkmcnt(0)\n\ts_barrier":::"memory");
  #undef DMA_K
  #undef DMA_V
  #undef CINIT
  #undef RFL
  #undef CMASK
  #undef START
  #undef RESC
  #undef ROT
}
constexpr int ATTN_LDS_BYTES=LDS_BYTES;
struct AttnUnit { int b,h,c,vh,qb; };
struct AttnTensors { const bf16* Q; const bf16* K; const bf16* V; bf16* O; const float* NORM; unsigned* qctr; };
template<int THRL=8> __device__ __forceinline__ void attn_phase(char*lds,const AttnTensors&T){
  typedef __attribute__((address_space(3))) unsigned lu32;
  lu32* slot=(lu32*)((__attribute__((address_space(3))) char*)lds+LDS_BYTES+32);
  unsigned nxt=0u; if(threadIdx.x==0)nxt=atomicAdd(T.qctr,1u);
  for(;;){
    if(threadIdx.x==0){ *slot=nxt; nxt=atomicAdd(T.qctr,1u); }
    asm volatile("s_waitcnt lgkmcnt(0)\n\ts_barrier":::"memory");
    const unsigned u=(unsigned)__builtin_amdgcn_readfirstlane((int)*slot);
    if(u>=4096u)break;
    const int qb=31-(int)(u&31u),cr=(int)(u>>5),h=7-(cr>>4),b=(cr>>2)&3,c=(cr>>1)&1,vh=cr&1;
    const float* nq=T.NORM+((0*8+h)*2+c)*2; const float* nk=T.NORM+((1*8+h)*2+c)*2;
    const float q2=__hip_atomic_load(nq,__ATOMIC_RELAXED,__HIP_MEMORY_SCOPE_AGENT)+__hip_atomic_load(nq+1,__ATOMIC_RELAXED,__HIP_MEMORY_SCOPE_AGENT);
    const float k2=__hip_atomic_load(nk,__ATOMIC_RELAXED,__HIP_MEMORY_SCOPE_AGENT)+__hip_atomic_load(nk+1,__ATOMIC_RELAXED,__HIP_MEMORY_SCOPE_AGENT);
    const float S=1.02f*sqrtf(q2*k2);
    const float s2=__builtin_amdgcn_exp2f(-(float)(h+1))*1.4426950408889634f;
    const float Dd=(150.f+2.f*S)/s2;
    const int q0=64+qb*QB, NTfull=(q0+QB)/KVBLK;
    int t0=0; { const float lim=(float)(q0-63)-Dd; if(lim>=0.f){ t0=(int)(lim*(1.f/64.f))+1; } }
    t0&=~1; if(t0>NTfull-5)t0=(NTfull-5)&~1; if(t0<0)t0=0;
    t0=__builtin_amdgcn_readfirstlane(t0);
    attn_unit<THRL>(b,h,c,vh,qb,t0,T.Q,T.K,T.V,T.O,lds);
  }
}
#undef SBAR
#undef WAIT_BAR
}
namespace ssd {
typedef unsigned short bf16_t;
typedef short bf16x8 __attribute__((ext_vector_type(8)));
typedef float f32x4 __attribute__((ext_vector_type(4)));
typedef unsigned u32x4 __attribute__((ext_vector_type(4)));
typedef unsigned u32x2 __attribute__((ext_vector_type(2)));
#define SLAS __attribute__((address_space(3)))
constexpr int LP = 8320, NCH = 65, LDA = 136;
constexpr int OFF_A = 0, OFF_B = 34816, OFF_X = 69632, OFF_P = 87040, OFF_F = 104448;
struct Params { const bf16_t* XBC; const float* DT; const float* conv_w; const float* conv_b; const float* dt_bias; const float* a_log; const float* d_skip; bf16_t* ST; float* CDEC; bf16_t* Y;
    bf16_t* XT; bf16_t* BT; bf16_t* BM; bf16_t* CM; float* DTA; };
typedef float f32x2_t __attribute__((ext_vector_type(2))); typedef __bf16 bf16x2_t __attribute__((ext_vector_type(2)));
__device__ __forceinline__ unsigned cvtpk(float lo, float hi) { f32x2_t v = {lo, hi}; bf16x2_t b = __builtin_convertvector(v, bf16x2_t); return __builtin_bit_cast(unsigned, b); }
__device__ __forceinline__ float bflo(unsigned w) { return __uint_as_float(w << 16); }
__device__ __forceinline__ float bfhi(unsigned w) { return __uint_as_float(w & 0xffff0000u); }

__device__ __forceinline__ void conv_item(const Params& P, int b, int c, int oct, int strip) {
    const int ch = oct * 8, l0 = strip * 8;
    float w[8][4], bias[8], x[11][8];
#pragma unroll
    for (int j = 0; j < 8; ++j) { const f32x4 t = *(const f32x4*)(P.conv_w + (size_t)(ch + j) * 4); w[j][0] = t[0]; w[j][1] = t[1]; w[j][2] = t[2]; w[j][3] = t[3]; }
    { const f32x4 t0 = *(const f32x4*)(P.conv_b + ch), t1 = *(const f32x4*)(P.conv_b + ch + 4); bias[0] = t0[0]; bias[1] = t0[1]; bias[2] = t0[2]; bias[3] = t0[3]; bias[4] = t1[0]; bias[5] = t1[1]; bias[6] = t1[2]; bias[7] = t1[3]; }
    const long prow0 = (long)b * LP + c * 128 + l0 - 3;
#pragma unroll
    for (int i = 0; i < 11; ++i) { const u32x4 raw = *(const u32x4*)(P.XBC + (prow0 + i) * 1536 + ch);
        x[i][0] = bflo(raw.x); x[i][1] = bfhi(raw.x); x[i][2] = bflo(raw.y); x[i][3] = bfhi(raw.y); x[i][4] = bflo(raw.z); x[i][5] = bfhi(raw.z); x[i][6] = bflo(raw.w); x[i][7] = bfhi(raw.w); }
#define CV(rr, j) ({ const float v_ = bias[j] + w[j][0] * x[rr][j] + w[j][1] * x[rr + 1][j] + w[j][2] * x[rr + 2][j] + w[j][3] * x[rr + 3][j]; v_ * __builtin_amdgcn_rcpf(1.f + __expf(-v_)); })
#define CV_T(dst) { _Pragma("unroll") for (int j = 0; j < 8; ++j) { u32x4 wv; wv.x = cvtpk(CV(0, j), CV(1, j)); wv.y = cvtpk(CV(2, j), CV(3, j)); wv.z = cvtpk(CV(4, j), CV(5, j)); wv.w = cvtpk(CV(6, j), CV(7, j)); *(u32x4*)((dst) + j * 128) = wv; } }
#define CV_R(dst) { _Pragma("unroll") for (int rr = 0; rr < 8; ++rr) { u32x4 wv; wv.x = cvtpk(CV(rr, 0), CV(rr, 1)); wv.y = cvtpk(CV(rr, 2), CV(rr, 3)); wv.z = cvtpk(CV(rr, 4), CV(rr, 5)); wv.w = cvtpk(CV(rr, 6), CV(rr, 7)); *(u32x4*)((dst) + rr * 128) = wv; } }
    const size_t bc = (size_t)b * NCH + c;
    if (oct < 128) {
        bf16_t* dst = P.XT + (bc * 16 + (oct >> 3)) * 8192 + (size_t)((oct & 7) * 8) * 128 + l0;
        CV_T(dst)
    } else {
        const int bcsel = (oct - 128) >> 5, g = ((oct - 128) >> 4) & 1, n0 = ((oct - 128) & 15) * 8;
        bf16_t* rm = (bcsel ? P.CM : P.BM) + (bc * 2 + g) * 16384 + (size_t)l0 * 128 + n0;
        CV_R(rm)
        if (bcsel == 0) { bf16_t* dst = P.BT + (bc * 2 + g) * 16384 + (size_t)n0 * 128 + l0; CV_T(dst) }
    }
#undef CV
#undef CV_T
#undef CV_R
}
__device__ __forceinline__ void dta_item(const Params& P, int u, int lane) {
    const int b = u / (NCH * 16), c = (u / 16) % NCH, h = u % 16;
    const long prow = (long)b * LP + c * 128 + 2 * lane;
    const float bias = P.dt_bias[h], a = -__expf(P.a_log[h]);
    float d0 = P.DT[prow * 16 + h] + bias, d1 = P.DT[(prow + 1) * 16 + h] + bias;
    d0 = d0 > 20.f ? d0 : log1pf(__expf(d0)); d1 = d1 > 20.f ? d1 : log1pf(__expf(d1));
    const int i0 = c * 128 + 2 * lane;
    if (i0 < 112) d0 = 0.f;
    if (i0 + 1 < 112) d1 = 0.f;
    const float a0 = d0 * a, a1 = d1 * a; float s = a0 + a1;
#pragma unroll
    for (int o = 1; o < 64; o <<= 1) { const float t = __shfl_up(s, o); if (lane >= o) s += t; }
    const float excl = s - (a0 + a1);
    float* D = P.DTA + (size_t)u * 256;
    *(f32x2_t*)(D + 2 * lane) = (f32x2_t){d0, d1}; *(f32x2_t*)(D + 128 + 2 * lane) = (f32x2_t){excl + a0, s};
    if (lane == 63) P.CDEC[u] = __expf(s);
}
__device__ __forceinline__ void conv_phase(const Params& P, int gw, int NGW, int lane) {
    for (int it = gw; it < 4 * NCH * 48; it += NGW) { const int bc = it / 48, oq = it % 48; conv_item(P, bc / NCH, bc % NCH, oq * 4 + (lane >> 4), lane & 15); }
    for (int u = gw; u < 4 * NCH * 16; u += NGW) dta_item(P, u, lane);
}
#define SSD_FRAG(base, row, k) (*(const SLAS bf16x8*)((base) + (row) * LDA + (k) * 32 + q * 8))
struct ARegs { u32x4 xv[2], bv[4]; f32x4 dtv[2][2], acv[2][2]; float ae; };
__device__ __forceinline__ void passA_load(ARegs& R, const Params& P, int u, int tid) {
    const int h = u & 15, g = h >> 3; const size_t bc = (size_t)(u >> 4), uh = (size_t)u;
    const bf16_t* gX = P.XT + uh * 8192; const bf16_t* gB = P.BT + (bc * 2 + g) * 16384; const float* D = P.DTA + uh * 256;
#pragma unroll
    for (int i = 0; i < 2; ++i) { const int pc = tid + i * 512; R.xv[i] = *(const u32x4*)(gX + pc * 8); const int l0 = (pc & 15) * 8;
        R.dtv[i][0] = *(const f32x4*)(D + l0); R.dtv[i][1] = *(const f32x4*)(D + l0 + 4); R.acv[i][0] = *(const f32x4*)(D + 128 + l0); R.acv[i][1] = *(const f32x4*)(D + 128 + l0 + 4); }
#pragma unroll
    for (int i = 0; i < 4; ++i) R.bv[i] = *(const u32x4*)(gB + (tid + i * 512) * 8);
    R.ae = D[255];
}
__device__ __forceinline__ void passA_phase(SLAS unsigned char* lds, const Params& P, int first, int stride, int nunits) {
    int tid_ = threadIdx.x; asm volatile("" : "+v"(tid_));
    const int tid = tid_, lane = tid & 63, wid = tid >> 6, r = lane & 15, q = lane >> 4;
    SLAS bf16_t* XT = (SLAS bf16_t*)(lds + OFF_X); SLAS bf16_t* BT = (SLAS bf16_t*)(lds + OFF_A);
    int u = first; if (u >= nunits) return;
    ARegs R; passA_load(R, P, u, tid);
    for (;;) {
#pragma unroll
        for (int i = 0; i < 2; ++i) { const int pc = tid + i * 512, p = pc >> 4, l0 = (pc & 15) * 8; float wg[8];
#pragma unroll
            for (int e = 0; e < 4; ++e) { wg[e] = R.dtv[i][0][e] * __expf(R.ae - R.acv[i][0][e]); wg[4 + e] = R.dtv[i][1][e] * __expf(R.ae - R.acv[i][1][e]); }
            u32x4 wv; wv.x = cvtpk(bflo(R.xv[i].x) * wg[0], bfhi(R.xv[i].x) * wg[1]); wv.y = cvtpk(bflo(R.xv[i].y) * wg[2], bfhi(R.xv[i].y) * wg[3]);
            wv.z = cvtpk(bflo(R.xv[i].z) * wg[4], bfhi(R.xv[i].z) * wg[5]); wv.w = cvtpk(bflo(R.xv[i].w) * wg[6], bfhi(R.xv[i].w) * wg[7]);
            *(SLAS u32x4*)(XT + p * LDA + l0) = wv; }
#pragma unroll
        for (int i = 0; i < 4; ++i) { const int pc = tid + i * 512; *(SLAS u32x4*)(BT + (pc >> 4) * LDA + (pc & 15) * 8) = R.bv[i]; }
        __syncthreads();
        const int un = u + stride;
        if (un < nunits) passA_load(R, P, un, tid);
        f32x4 acc[4];
#pragma unroll
        for (int pt = 0; pt < 4; ++pt) acc[pt] = (f32x4){0.f, 0.f, 0.f, 0.f};
#pragma unroll
        for (int k = 0; k < 4; ++k) { const bf16x8 bfr = SSD_FRAG(BT, wid * 16 + r, k);
#pragma unroll
            for (int pt = 0; pt < 4; ++pt) acc[pt] = __builtin_amdgcn_mfma_f32_16x16x32_bf16(bfr, SSD_FRAG(XT, pt * 16 + r, k), acc[pt], 0, 0, 0); }
        bf16_t* S = P.ST + (size_t)u * 8192;
#pragma unroll
        for (int pt = 0; pt < 4; ++pt) { u32x2 wv; wv.x = cvtpk(acc[pt][0], acc[pt][1]); wv.y = cvtpk(acc[pt][2], acc[pt][3]); *(u32x2*)(S + (pt * 16 + r) * 128 + wid * 16 + 4 * q) = wv; }
        __syncthreads();
        if (un >= nunits) break;
        u = un;
    }
}
struct CRegs { u32x4 xv[2], sv[2], bv[4], cv[4]; f32x4 fv; };
__device__ __forceinline__ void passC_load(CRegs& R, const Params& P, int u, int tid) {
    const int h = u & 15, g = h >> 3; const size_t bc = (size_t)(u >> 4), uh = (size_t)u;
    const bf16_t* gX = P.XT + uh * 8192; const bf16_t* gB = P.BM + (bc * 2 + g) * 16384; const bf16_t* gC = P.CM + (bc * 2 + g) * 16384; const bf16_t* gS = P.ST + uh * 8192; const float* D = P.DTA + uh * 256;
#pragma unroll
    for (int i = 0; i < 2; ++i) { R.xv[i] = *(const u32x4*)(gX + (tid + i * 512) * 8); R.sv[i] = *(const u32x4*)(gS + (tid + i * 512) * 8); }
#pragma unroll
    for (int i = 0; i < 4; ++i) { R.bv[i] = *(const u32x4*)(gB + (tid + i * 512) * 8); R.cv[i] = *(const u32x4*)(gC + (tid + i * 512) * 8); }
    R.fv = *(const f32x4*)(D + (tid & 63) * 4);
}
__device__ __forceinline__ void passC_phase(SLAS unsigned char* lds, const Params& P, int first, int stride, int nunits) {
    int tid_ = threadIdx.x; asm volatile("" : "+v"(tid_));
    const int tid = tid_, lane = tid & 63, wid = tid >> 6, r = lane & 15, q = lane >> 4;
    SLAS float* F = (SLAS float*)(lds + OFF_F);
    SLAS bf16_t* CM = (SLAS bf16_t*)(lds + OFF_A); SLAS bf16_t* BM = (SLAS bf16_t*)(lds + OFF_B); SLAS bf16_t* XT = (SLAS bf16_t*)(lds + OFF_X); SLAS bf16_t* PV = (SLAS bf16_t*)(lds + OFF_P);
    int u = first; if (u >= nunits) return;
    CRegs R; passC_load(R, P, u, tid);
    for (;;) {
        const int h = u & 15, c = (u >> 4) % NCH, b = (u >> 4) / NCH;
#pragma unroll
        for (int i = 0; i < 2; ++i) { const int pc = tid + i * 512; *(SLAS u32x4*)(XT + (pc >> 4) * LDA + (pc & 15) * 8) = R.xv[i]; *(SLAS u32x4*)(PV + (pc >> 4) * LDA + (pc & 15) * 8) = R.sv[i]; }
#pragma unroll
        for (int i = 0; i < 4; ++i) { const int pc = tid + i * 512; *(SLAS u32x4*)(BM + (pc >> 4) * LDA + (pc & 15) * 8) = R.bv[i]; *(SLAS u32x4*)(CM + (pc >> 4) * LDA + (pc & 15) * 8) = R.cv[i]; }
        if (tid < 64) *(SLAS f32x4*)(F + tid * 4) = R.fv;
        __syncthreads();
        const int un = u + stride;
        if (un < nunits) passC_load(R, P, un, tid);
        f32x4 sacc[8];
#pragma unroll
        for (int st = 0; st < 8; ++st) sacc[st] = (f32x4){0.f, 0.f, 0.f, 0.f};
#pragma unroll
        for (int k = 0; k < 4; ++k) { const bf16x8 afr = SSD_FRAG(CM, wid * 16 + r, k);
#pragma unroll
            for (int st = 0; st < 8; ++st) sacc[st] = __builtin_amdgcn_mfma_f32_16x16x32_bf16(SSD_FRAG(BM, st * 16 + r, k), afr, sacc[st], 0, 0, 0); }
        __syncthreads();
        const int l = wid * 16 + r; const float al = F[128 + l], Dh = P.d_skip[h];
#pragma unroll
        for (int st = 0; st < 8; ++st) { const int s0 = st * 16 + 4 * q; float gv[4];
#pragma unroll
            for (int j = 0; j < 4; ++j) { const int s = s0 + j; float v = 0.f; if (s <= l) v = sacc[st][j] * __expf(al - F[128 + s]) * F[s]; if (s == l) v += Dh; gv[j] = v; }
            u32x2 wv; wv.x = cvtpk(gv[0], gv[1]); wv.y = cvtpk(gv[2], gv[3]); *(SLAS u32x2*)(BM + l * LDA + s0) = wv; }
        __syncthreads();
        f32x4 yacc[4];
#pragma unroll
        for (int pt = 0; pt < 4; ++pt) yacc[pt] = (f32x4){0.f, 0.f, 0.f, 0.f};
#pragma unroll
        for (int k = 0; k < 4; ++k) { const bf16x8 afr = SSD_FRAG(CM, wid * 16 + r, k);
#pragma unroll
            for (int pt = 0; pt < 4; ++pt) yacc[pt] = __builtin_amdgcn_mfma_f32_16x16x32_bf16(SSD_FRAG(PV, pt * 16 + r, k), afr, yacc[pt], 0, 0, 0); }
        { const float el = __expf(al);
#pragma unroll
            for (int pt = 0; pt < 4; ++pt) yacc[pt] = yacc[pt] * el; }
#pragma unroll
        for (int k = 0; k < 4; ++k) { const bf16x8 afr = SSD_FRAG(BM, wid * 16 + r, k);
#pragma unroll
            for (int pt = 0; pt < 4; ++pt) yacc[pt] = __builtin_amdgcn_mfma_f32_16x16x32_bf16(SSD_FRAG(XT, pt * 16 + r, k), afr, yacc[pt], 0, 0, 0); }
        bf16_t* yrow = P.Y + ((size_t)b * LP + c * 128 + l) * 1024 + h * 64 + 4 * q;
#pragma unroll
        for (int pt = 0; pt < 4; ++pt) { u32x2 wv; wv.x = cvtpk(yacc[pt][0], yacc[pt][1]); wv.y = cvtpk(yacc[pt][2], yacc[pt][3]); *(u32x2*)(yrow + pt * 16) = wv; }
        __syncthreads();
        if (un >= nunits) break;
        u = un;
    }
}
#undef SSD_FRAG
__device__ __forceinline__ void scan_phase(const Params& P, int gtid, int nthreads) {
    for (int qd = gtid; qd < 4 * 32768; qd += nthreads) {
        const int b = qd >> 15, e = (qd & 32767) * 4, h = e >> 13;
        bf16_t* base = P.ST + (size_t)b * NCH * 131072 + e; const float* cd = P.CDEC + b * NCH * 16 + h;
        float s0 = 0.f, s1 = 0.f, s2 = 0.f, s3 = 0.f;
        for (int c0 = 0; c0 < NCH; c0 += 13) {
            u32x2 v[13]; float d[13];
#pragma unroll
            for (int i = 0; i < 13; ++i) { v[i] = *(const u32x2*)(base + (size_t)(c0 + i) * 131072); d[i] = cd[(c0 + i) * 16]; }
#pragma unroll
            for (int i = 0; i < 13; ++i) { u32x2 o; o.x = cvtpk(s0, s1); o.y = cvtpk(s2, s3); *(u32x2*)(base + (size_t)(c0 + i) * 131072) = o;
                s0 = s0 * d[i] + __uint_as_float(v[i].x << 16); s1 = s1 * d[i] + __uint_as_float(v[i].x & 0xffff0000u);
                s2 = s2 * d[i] + __uint_as_float(v[i].y << 16); s3 = s3 * d[i] + __uint_as_float(v[i].y & 0xffff0000u); }
        }
    }
}
}

namespace cg = cooperative_groups;
#define GAS __attribute__((address_space(1)))
#define LAS __attribute__((address_space(3)))
typedef unsigned short bf16;
typedef unsigned v4u __attribute__((ext_vector_type(4)));
typedef float f32x4 __attribute__((ext_vector_type(4)));
constexpr int NWAVES = 8;
constexpr int NB = 4, SEQ = 8192, LP = 8320, MP = NB * LP, MC = NB * SEQ, DMODEL = 1024, DFF = 2816;
constexpr float EPS = 1e-6f;
constexpr size_t MiB = 1u << 20, S1 = 65 * MiB;
constexpr size_t WS_WIN = 0, WS_WZG = 10 * MiB, WS_WSSD = 16 * MiB, WS_WATT = 18 * MiB, WS_WOUT = 20 * MiB, WS_WGU = 22 * MiB, WS_WDN = 33 * MiB;
constexpr size_t WS_DT = 39 * MiB, WS_DTA = 0  , WS_CDEC = 42 * MiB, WS_SSQ = 42 * MiB + 65536, WS_SSQ2 = 42 * MiB + 262144;
constexpr size_t WS_R5 = 44 * MiB, WS_R0 = WS_R5 + S1, WS_R1 = WS_R0 + S1, WS_R2 = WS_R1 + S1, WS_R3 = WS_R2 + S1, WS_R4 = WS_R3 + S1, WS_END = WS_R4 + 2 * S1;
static_assert(WS_END <= 512 * MiB, "d_ws map fits the guaranteed 512 MiB");
constexpr int LDS_BYTES = 147456;
#ifndef PHASES
#define PHASES 0xFFFF
#endif
#ifndef DUP
#define DUP 0
#endif

__device__ __forceinline__ unsigned f2bf(float f) { unsigned u = __builtin_bit_cast(unsigned, f); return (u + 0x7fffu + ((u >> 16) & 1u)) >> 16; }
__device__ __forceinline__ unsigned pk2(float lo, float hi) { return f2bf(lo) | (f2bf(hi) << 16); }
__device__ __forceinline__ float wave_sum(float v) {
#pragma unroll
    for (int o = 1; o < 64; o <<= 1) v += __shfl_xor(v, o);
    return v;
}
__device__ __forceinline__ float blo(unsigned w) { return __uint_as_float(w << 16); }
__device__ __forceinline__ float bhi(unsigned w) { return __uint_as_float(w & 0xffff0000u); }

__device__ __forceinline__ void tr_item(const float* W, int K, int Npitch, int nsrc, int nvalid, bf16* WT, int drow, const float* kscale, int kb, LAS float* scr, int lane) {
    const int k0 = 64 * kb, n4 = (lane & 7) * 4;
#pragma unroll
    for (int i = 0; i < 8; ++i) { const int kk = 8 * i + (lane >> 3); f32x4 v = (f32x4){0.f, 0.f, 0.f, 0.f};
        if (n4 < nvalid) v = *(const f32x4*)(W + (size_t)(k0 + kk) * Npitch + nsrc + n4);
        if (kscale) v = v * kscale[k0 + kk];
        scr[kk * 33 + n4] = v.x; scr[kk * 33 + n4 + 1] = v.y; scr[kk * 33 + n4 + 2] = v.z; scr[kk * 33 + n4 + 3] = v.w; }
    asm volatile("s_waitcnt lgkmcnt(0)" ::: "memory");
    const int c = lane & 7;
#pragma unroll
    for (int jj = 0; jj < 4; ++jj) { const int n = (lane >> 3) + 8 * jj; const LAS float* s = scr + (8 * c) * 33 + n;
        v4u o; o.x = pk2(s[0 * 33], s[1 * 33]); o.y = pk2(s[2 * 33], s[3 * 33]); o.z = pk2(s[4 * 33], s[5 * 33]); o.w = pk2(s[6 * 33], s[7 * 33]);
        *(v4u*)(WT + (size_t)(drow + n) * K + k0 + 8 * c) = o; }
    asm volatile("s_waitcnt lgkmcnt(0)" ::: "memory");
}
template <int NR> __device__ __forceinline__ void u_rows(const float* x, const float* meta, const float* g, bf16* U, int m0, int stride, int lane) {
    f32x4 v[NR][4]; bool live[NR], inr[NR];
#pragma unroll
    for (int k = 0; k < NR; ++k) { const int prow = m0 + k * stride; inr[k] = prow < MP; const int pr = inr[k] ? prow : 0; const int b = pr / LP, i = pr - b * LP; live[k] = inr[k] && i >= 112;
        const f32x4* src = (const f32x4*)(i < 128 ? meta + (size_t)(i < 112 ? 0 : i - 112) * 1024 : x + ((size_t)b * SEQ + (i - 128)) * 1024) + lane;
#pragma unroll
        for (int j = 0; j < 4; ++j) v[k][j] = src[64 * j]; }
    f32x4 gg[4];
#pragma unroll
    for (int j = 0; j < 4; ++j) gg[j] = ((const f32x4*)g)[lane + 64 * j];
#pragma unroll
    for (int k = 0; k < NR; ++k) { if (!inr[k]) continue;
        unsigned long long* o8 = (unsigned long long*)(U + (size_t)(m0 + k * stride) * 1024) + lane; float s = 0.f;
#pragma unroll
        for (int j = 0; j < 4; ++j) s += (v[k][j].x * v[k][j].x + v[k][j].y * v[k][j].y) + (v[k][j].z * v[k][j].z + v[k][j].w * v[k][j].w);
        const float rstd = live[k] ? rsqrtf(wave_sum(s) * (1.f / 1024.f) + EPS) : 0.f;
#pragma unroll
        for (int j = 0; j < 4; ++j) o8[64 * j] = (unsigned long long)pk2(v[k][j].x * rstd * gg[j].x, v[k][j].y * rstd * gg[j].y) | ((unsigned long long)pk2(v[k][j].z * rstd * gg[j].z, v[k][j].w * rstd * gg[j].w) << 32); }
}
template <int NR> __device__ __forceinline__ void combine_rows(const bf16* O, bf16* YATT, const float* subln_g, float lam, int r0, int stride, int lane) {
    v4u A0[NR], A1[NR], C0[NR], C1[NR];
#pragma unroll
    for (int k = 0; k < NR; ++k) { const int r = r0 + k * stride; const int rr = r < MC ? r : 0; const int b = rr >> 13, t = rr & 8191; const size_t prow = (size_t)b * LP + 128 + t;
        const v4u* p1 = (const v4u*)(O + prow * 2048 + 16 * lane); const v4u* p2 = (const v4u*)(O + prow * 2048 + 1024 + 16 * lane);
        A0[k] = p1[0]; A1[k] = p1[1]; C0[k] = p2[0]; C1[k] = p2[1]; }
    float gpv[16];
    { const f32x4* gp4 = (const f32x4*)(subln_g + 16 * (lane & 7));
#pragma unroll
      for (int i = 0; i < 4; ++i) { const f32x4 t = gp4[i]; gpv[4 * i] = t.x; gpv[4 * i + 1] = t.y; gpv[4 * i + 2] = t.z; gpv[4 * i + 3] = t.w; } }
#pragma unroll
    for (int k = 0; k < NR; ++k) { const int r = r0 + k * stride; if (r >= MC) continue;
        const v4u a0 = A0[k], a1 = A1[k], c0 = C0[k], c1 = C1[k];
        float a[16];
        a[0] = blo(a0.x) - lam * blo(c0.x); a[1] = bhi(a0.x) - lam * bhi(c0.x); a[2] = blo(a0.y) - lam * blo(c0.y); a[3] = bhi(a0.y) - lam * bhi(c0.y);
        a[4] = blo(a0.z) - lam * blo(c0.z); a[5] = bhi(a0.z) - lam * bhi(c0.z); a[6] = blo(a0.w) - lam * blo(c0.w); a[7] = bhi(a0.w) - lam * bhi(c0.w);
        a[8] = blo(a1.x) - lam * blo(c1.x); a[9] = bhi(a1.x) - lam * bhi(c1.x); a[10] = blo(a1.y) - lam * blo(c1.y); a[11] = bhi(a1.y) - lam * bhi(c1.y);
        a[12] = blo(a1.z) - lam * blo(c1.z); a[13] = bhi(a1.z) - lam * bhi(c1.z); a[14] = blo(a1.w) - lam * blo(c1.w); a[15] = bhi(a1.w) - lam * bhi(c1.w);
        float ss = 0.f;
#pragma unroll
        for (int i = 0; i < 16; ++i) ss += a[i] * a[i];
        ss += __shfl_xor(ss, 1); ss += __shfl_xor(ss, 2); ss += __shfl_xor(ss, 4);
        const float rs = rsqrtf(ss * (1.f / 128.f) + EPS) * 0.8f;
        v4u o0, o1;
        o0.x = pk2(a[0] * rs * gpv[0], a[1] * rs * gpv[1]); o0.y = pk2(a[2] * rs * gpv[2], a[3] * rs * gpv[3]); o0.z = pk2(a[4] * rs * gpv[4], a[5] * rs * gpv[5]); o0.w = pk2(a[6] * rs * gpv[6], a[7] * rs * gpv[7]);
        o1.x = pk2(a[8] * rs * gpv[8], a[9] * rs * gpv[9]); o1.y = pk2(a[10] * rs * gpv[10], a[11] * rs * gpv[11]); o1.z = pk2(a[12] * rs * gpv[12], a[13] * rs * gpv[13]); o1.w = pk2(a[14] * rs * gpv[14], a[15] * rs * gpv[15]);
        v4u* q = (v4u*)(YATT + (size_t)r * 1024 + 16 * lane); q[0] = o0; q[1] = o1; }
}

#define XB_TMO      128
#define XB_XCNT(j)  (256  + 64 * (j))
#define XB_XSUB(j)  (1280 + 64 * (j))
#define XB_XGEN(j)  (2304 + 64 * (j))
#define XB_TOP      3328
#define XB_TOPGEN   3392
#define XCD_BAR_WORDS 3456
#define XB_SPIN_CAP (1u << 18)

__device__ __forceinline__ unsigned xb_ld(unsigned* p)              { return __hip_atomic_load(p, __ATOMIC_RELAXED, __HIP_MEMORY_SCOPE_AGENT); }
__device__ __forceinline__ unsigned xb_add(unsigned* p, unsigned v) { return __hip_atomic_fetch_add(p, v, __ATOMIC_RELAXED, __HIP_MEMORY_SCOPE_AGENT); }
__device__ __forceinline__ unsigned xb_xcc_id() { return (unsigned)__builtin_amdgcn_s_getreg((3 << 11) | 20) & 0xFu; }
#define XB_SPIN(cond, bar) do { unsigned _sp = 0; while (cond) { __builtin_amdgcn_s_sleep(1); \
    if ((++_sp & 255u) == 0u) { if (xb_ld(&(bar)[XB_TMO])) break; if (_sp > XB_SPIN_CAP) { atomicAdd(&(bar)[XB_TMO], 1u); break; } } } } while (0)

struct XcdBarrier {
    unsigned* bar; unsigned x;
    volatile LAS unsigned* st;
};

__device__ __forceinline__ XcdBarrier xcd_barrier_post(unsigned* bar, volatile LAS unsigned* st) {
    XcdBarrier b; b.bar = bar; b.x = xb_xcc_id(); b.st = st;
    if (threadIdx.x == 0) (void)xb_add(&bar[XB_XCNT(b.x)], 1u);
    return b;
}
__device__ __forceinline__ void xcd_barrier_complete(unsigned* bar, unsigned x, unsigned& nloc, unsigned& nx) {
    const unsigned G = gridDim.x * gridDim.y * gridDim.z;
    unsigned sum, cnt, mine, sp = 0u;
    for (;;) {
        sum = 0u; cnt = 0u; mine = 0u;
#pragma unroll
        for (unsigned j = 0; j < 16; ++j) { const unsigned c = xb_ld(&bar[XB_XCNT(j)]); sum += c; cnt += (c > 0u) ? 1u : 0u; mine = (j == x) ? c : mine; }
        if (sum == G) break;
        __builtin_amdgcn_s_sleep(1);
        if ((++sp & 255u) == 0u) { if (xb_ld(&bar[XB_TMO])) break; if (sp > XB_SPIN_CAP) { atomicAdd(&bar[XB_TMO], 1u); break; } }
    }
    nloc = mine > 0u ? mine : 1u; nx = cnt > 0u ? cnt : 1u;
}

__device__ __forceinline__ void xcd_barrier(const XcdBarrier& b) {
    asm volatile("s_waitcnt vmcnt(0)" ::: "memory");
    __syncthreads();
    if (threadIdx.x == 0) {
        unsigned* bar = b.bar;
        __builtin_amdgcn_s_waitcnt(0);
        unsigned nloc = b.st[0], nx = b.st[1];
        if (nloc == 0u) { xcd_barrier_complete(bar, b.x, nloc, nx); b.st[0] = nloc; b.st[1] = nx; }
        const unsigned old = xb_add(&bar[XB_XSUB(b.x)], 1u);
        const unsigned gen = old / nloc;
        if (old + 1u == (gen + 1u) * nloc) {
            __builtin_amdgcn_fence(__ATOMIC_RELEASE, "agent");
            asm volatile("s_waitcnt vmcnt(0)" ::: "memory");
            const unsigned og = xb_add(&bar[XB_TOP], 1u);
            const unsigned tg = og / nx;
            if (og + 1u == (tg + 1u) * nx) xb_add(&bar[XB_TOPGEN], 1u);
            else XB_SPIN(xb_ld(&bar[XB_TOPGEN]) == tg, bar);
            __builtin_amdgcn_fence(__ATOMIC_ACQUIRE, "agent");
            xb_add(&bar[XB_XGEN(b.x)], 1u);
            asm volatile("s_waitcnt vmcnt(0)" ::: "memory");
        } else {
            XB_SPIN(xb_ld(&bar[XB_XGEN(b.x)]) == gen, bar);
            __builtin_amdgcn_fence(__ATOMIC_ACQUIRE, "agent");
            asm volatile("s_waitcnt vmcnt(0)" ::: "memory");
        }
    }
    __syncthreads();
}
constexpr size_t WS_CTL = 43 * MiB, CTL_BYTES = 65536;
constexpr int LDSCTL_OFF = 131072;

struct Args { const float* in[24]; float* out; unsigned char* ws; };
enum { I_X = 0, I_META, I_NMIXG, I_WIN, I_GBIAS, I_CONVW, I_CONVB, I_DTBIAS, I_ALOG, I_DSKIP, I_SSDG, I_LQ1, I_LK1, I_LQ2, I_LK2, I_SUBLNG, I_WSSD, I_WATT, I_WOUT, I_NFFNG, I_WGATE, I_WUP, I_WDOWN, I_NFING };

__global__ void __launch_bounds__(NWAVES * 64, 2) mega_fwd(Args args) {
    extern __shared__ __attribute__((aligned(16))) unsigned char lds[];
    cg::grid_group grid = cg::this_grid();
    { LAS unsigned* z = (LAS unsigned*)(lds + 0) ; (void)z; }
    for (int u = threadIdx.x; u < 64; u += NWAVES * 64) ((LAS unsigned*)((LAS unsigned char*)lds + LDSCTL_OFF))[u] = 0u;
    __syncthreads();
    XcdBarrier xbar = xcd_barrier_post((unsigned*)(args.ws + WS_CTL), (volatile LAS unsigned*)((LAS unsigned char*)lds + LDSCTL_OFF) + 8);
    grid.sync();
    LAS unsigned char* L = (LAS unsigned char*)lds;
    const int G = gridDim.x, bx = blockIdx.x, vcu = (G % 8 == 0) ? (bx % 8) * (G / 8) + bx / 8 : bx;
    const int NGW = G * NWAVES;
#define PHASE_PTRS() \
    const __attribute__((address_space(4))) Args* A_ = (const __attribute__((address_space(4))) Args*)__builtin_amdgcn_kernarg_segment_ptr(); asm volatile("" : "+s"(A_)); \
    unsigned char* ws = A_->ws; (void)ws; \
    int tid_o = threadIdx.x; asm volatile("" : "+v"(tid_o)); const int lane = tid_o & 63, wave = __builtin_amdgcn_readfirstlane(tid_o >> 6), gw = vcu * NWAVES + wave; (void)lane; (void)gw; \
    bf16 *Win_t = (bf16*)(ws + WS_WIN), *Wzg_t = (bf16*)(ws + WS_WZG), *Wssd_t = (bf16*)(ws + WS_WSSD), *Watt_t = (bf16*)(ws + WS_WATT), *Wout_t = (bf16*)(ws + WS_WOUT), *Wgu_t = (bf16*)(ws + WS_WGU), *Wdn_t = (bf16*)(ws + WS_WDN); \
    float *DT = (float*)(ws + WS_DT), *CDEC = (float*)(ws + WS_CDEC), *SSQ = (float*)(ws + WS_SSQ), *SSQ2 = (float*)(ws + WS_SSQ2), *SSQ3 = (float*)(ws + WS_SSQ2 + 131072); (void)SSQ3; \
    bf16 *R5 = (bf16*)(ws + WS_R5), *R0 = (bf16*)(ws + WS_R0), *R1 = (bf16*)(ws + WS_R1), *R2 = (bf16*)(ws + WS_R2), *R3 = (bf16*)(ws + WS_R3), *R4 = (bf16*)(ws + WS_R4); \
    const float* x = A_->in[I_X]; float* outp = A_->out; \
    (void)Win_t; (void)Wzg_t; (void)Wssd_t; (void)Watt_t; (void)Wout_t; (void)Wgu_t; (void)Wdn_t; (void)DT; (void)CDEC; (void)SSQ; (void)SSQ2; (void)R5; (void)R0; (void)R1; (void)R2; (void)R3; (void)R4; (void)x; (void)outp;
#define GRID_SYNC() xcd_barrier(xbar)

    if constexpr ((PHASES >> 0) & 1) for (int rep0_ = 0; rep0_ < 1 + ((DUP >> 0) & 1); ++rep0_) { PHASE_PTRS();
        LAS float* scr = (LAS float*)(L + wave * 16384);
        const float* w_in = A_->in[I_WIN];
        constexpr int NIN = 7696;
        for (int it = gw; it < 3856; it += NGW) {
            int r = it;
#define SEG(W_, K_, NP_, NS_, NBLK_, NVAL_, WT_, DROW_, KS_, IL_) { const int n_ = ((K_) / 64) * (NBLK_); if (r < n_) { const int kb = r / (NBLK_), blk = r % (NBLK_); \
                tr_item(W_, K_, NP_, (NS_) + 32 * blk, NVAL_, WT_, (IL_) ? (DROW_) + 256 * (blk >> 2) + 32 * (blk & 3) : (DROW_) + 32 * blk, KS_, kb, scr, lane); continue; } r -= n_; }
            SEG(w_in, 1024, NIN, 2576, 32, 32, Win_t, 0, nullptr, 0)
            SEG(w_in, 1024, NIN, 3600, 32, 32, Win_t, 1024, nullptr, 0)
            SEG(w_in, 1024, NIN, 4624, 32, 32, Win_t, 2048, nullptr, 0)
            SEG(w_in, 1024, NIN, 1024, 48, 32, Win_t, 3072, nullptr, 0)
            SEG(w_in, 1024, NIN, 2560, 1, 16, Win_t, 4608, nullptr, 0)
            SEG(w_in, 1024, NIN, 0, 32, 32, Wzg_t, 0, nullptr, 0)
            SEG(w_in, 1024, NIN, 5648, 64, 32, Wzg_t, 1024, nullptr, 0)
        }
        {
            const int gt = gw * 64 + lane, NT = NGW * 64;
            v4u* z = (v4u*)(Win_t + (size_t)4640 * 1024);
            for (int i = gt; i < 224 * 128; i += NT) z[i] = (v4u){0u, 0u, 0u, 0u};
            for (int i = gt; i < MC; i += NT) { SSQ[i] = 0.f; SSQ2[i] = 0.f; SSQ3[i] = 0.f; }
        }
        for (int m = gw; m < MP; m += 4 * NGW) u_rows<4>(x, A_->in[I_META], A_->in[I_NMIXG], (bf16*)outp, m, NGW, lane);
    }
    GRID_SYNC();
    if constexpr ((PHASES >> 1) & 1) { PHASE_PTRS();
        pg8::Gemm g{(const bf16*)outp, Win_t, MP, 4864, 1024, 0}; pg8::StaticOrder S; S.init(MP, 4864, G, bx);
        pg8::EpiProj1 E{R1, R2, R3, R4, DT, (float*)(ws + WS_CTL + 16384)};
        for (int rep_ = 0; rep_ < 1 + ((DUP >> 1) & 1); ++rep_) pg8::gemm_phase<pg8::EpiProj1, pg8::StaticOrder, true, true>(L, g, S, E);
    }
    GRID_SYNC();
    if constexpr ((PHASES >> 2) & 1) { PHASE_PTRS();
        const attn_body::AttnTensors AT{(const attn_body::bf16*)R1, (const attn_body::bf16*)R2, (const attn_body::bf16*)R3, (attn_body::bf16*)R5, (const float*)(ws + WS_CTL + 16384), (unsigned*)(ws + WS_CTL + 32768)};
        attn_body::attn_phase<64>((char*)lds, AT);
        {
            unsigned* wctr = (unsigned*)(ws + WS_CTL + 32768 + 256);
            LAS unsigned* wslot = (LAS unsigned*)(L + 140000);
            LAS float* scr = (LAS float*)(L + wave * 16384);
            for (;;) {
                __syncthreads();
                if (threadIdx.x == 0) *wslot = atomicAdd(wctr, 1u);
                __syncthreads();
                const int it = (int)(*wslot) * NWAVES + wave;
                if ((int)(*wslot) * NWAVES >= 5760) break;
                if (it < 5760) { int r = it; do {
            SEG(A_->in[I_WSSD], 1024, 1024, 0, 32, 32, Wssd_t, 0, A_->in[I_SSDG], 0)
            SEG(A_->in[I_WATT], 1024, 1024, 0, 32, 32, Watt_t, 0, nullptr, 0)
            SEG(A_->in[I_WOUT], 1024, 1024, 0, 32, 32, Wout_t, 0, nullptr, 0)
            SEG(A_->in[I_WGATE], 1024, DFF, 0, 88, 32, Wgu_t, 0, A_->in[I_NFFNG], 1)
            SEG(A_->in[I_WUP], 1024, DFF, 0, 88, 32, Wgu_t, 128, A_->in[I_NFFNG], 1)
            SEG(A_->in[I_WDOWN], DFF, 1024, 0, 32, 32, Wdn_t, 0, nullptr, 0)
                } while (0); }
            }
        }
#undef SEG
    }
    GRID_SYNC();
#define SSD_PARAMS() PHASE_PTRS(); const ssd::Params SP{R4, DT, A_->in[I_CONVW], A_->in[I_CONVB], A_->in[I_DTBIAS], A_->in[I_ALOG], A_->in[I_DSKIP], R3, CDEC, R4, R1, R1 + (size_t)MP * 1024, R1 + (size_t)MP * 1280, R1 + (size_t)MP * 1536, (float*)(ws + WS_DTA)}
    if constexpr ((PHASES >> 3) & 1) { SSD_PARAMS(); for (int rep_ = 0; rep_ < 1 + ((DUP >> 12) & 1); ++rep_) ssd::conv_phase(SP, gw, NGW, lane); }
    GRID_SYNC();
    if constexpr ((PHASES >> 3) & 1) { SSD_PARAMS(); for (int rep_ = 0; rep_ < 1 + ((DUP >> 3) & 1); ++rep_) ssd::passA_phase(L, SP, vcu, G, NB * 65 * 16); }
    GRID_SYNC();
    if constexpr ((PHASES >> 4) & 1) { SSD_PARAMS(); ssd::scan_phase(SP, gw * 64 + lane, NGW * 64); }
    GRID_SYNC();
    if constexpr ((PHASES >> 5) & 1) { SSD_PARAMS(); for (int rep_ = 0; rep_ < 1 + ((DUP >> 5) & 1); ++rep_) ssd::passC_phase(L, SP, vcu, G, NB * 65 * 16);
        const float s1 = wave_sum(A_->in[I_LQ1][lane] * A_->in[I_LK1][lane]), s2 = wave_sum(A_->in[I_LQ2][lane] * A_->in[I_LK2][lane]);
        const float lam = expf(s1) - expf(s2) + 0.2f;
        for (int r = gw; r < MC; r += 4 * NGW) combine_rows<4>(R5, R4 + (size_t)MP * 1024, A_->in[I_SUBLNG], lam, r, NGW, lane);
        }
    GRID_SYNC();
    if constexpr ((PHASES >> 6) & 1) { PHASE_PTRS();
        pg8::Gemm g{(const bf16*)outp, Wzg_t, MC, 3072, 1024, 1}; pg8::StaticOrder S; S.init(MC, 3072, G, bx);
        pg8::EpiZG E{R4, R1, R2, A_->in[I_GBIAS], SSQ3};
        for (int rep_ = 0; rep_ < 1 + ((DUP >> 6) & 1); ++rep_) pg8::gemm_phase<pg8::EpiZG, pg8::StaticOrder, true, true>(L, g, S, E);
    }
    GRID_SYNC();
    if constexpr ((PHASES >> 8) & 1) { PHASE_PTRS();
        pg8::Gemm g{R1, Wssd_t, MC, 1024, 1024, 0, R4 + (size_t)MP * 1024, Watt_t, 0}; pg8::StaticOrder2 S; S.init(MC, 1024, G, bx);
        pg8::EpiBranch E{R2, R4, SSQ3};
        pg8::gemm_phase<pg8::EpiBranch, pg8::StaticOrder2, true, true>(L, g, S, E);
    }
    GRID_SYNC();
    if constexpr ((PHASES >> 9) & 1) { PHASE_PTRS();
        pg8::Gemm g{R4, Wout_t, MC, 1024, 1024, 0}; pg8::StaticOrder S; S.init(MC, 1024, G, bx);
        pg8::EpiWout E{x, outp, R4 + (size_t)MP * 1024, SSQ};
        pg8::gemm_phase<pg8::EpiWout, pg8::StaticOrder, true, true>(L, g, S, E);
    }
    GRID_SYNC();
    if constexpr ((PHASES >> 10) & 1) { PHASE_PTRS();
        pg8::Gemm g{R4 + (size_t)MP * 1024, Wgu_t, MC, 2 * DFF, 1024, 0}; pg8::StaticOrder S; S.init(MC, 2 * DFF, G, bx);
        pg8::EpiGU E{R5, SSQ};
        for (int rep_ = 0; rep_ < 1 + ((DUP >> 10) & 1); ++rep_) pg8::gemm_phase<pg8::EpiGU, pg8::StaticOrder, true, true>(L, g, S, E);
    }
    GRID_SYNC();
    if constexpr ((PHASES >> 11) & 1) { PHASE_PTRS();
        pg8::Gemm g{R5, Wdn_t, MC, 1024, DFF, 0}; pg8::StaticOrder S; S.init(MC, 1024, G, bx);
        pg8::EpiDownNorm E{outp, R4 + (size_t)MP * 1024, SSQ2, (unsigned*)(ws + WS_CTL + 40960), A_->in[I_NFING]};
        pg8::gemm_phase<pg8::EpiDownNorm, pg8::StaticOrder, true, true>(L, g, S, E);
    }
}

extern "C" void kernel_launch(void* const* d_in, const int* in_sizes, int n_in, void* d_out, int out_size, void* d_ws, size_t ws_size, hipStream_t stream) {
    static int grid = 0;
    if (grid == 0) {
        if (n_in != 24 || in_sizes[0] != MC * 1024 || out_size != MC * 1024 || ws_size < WS_END) { fprintf(stderr, "kernel_launch: unexpected shapes (n_in %d, in0 %d, out %d, ws %zu)\n", n_in, n_in > 0 ? in_sizes[0] : -1, out_size, ws_size); grid = -1; return; }
        int dev = 0, cus = 0, per_cu = 0;
        hipGetDevice(&dev); hipDeviceGetAttribute(&cus, hipDeviceAttributeMultiprocessorCount, dev);
        hipFuncSetAttribute((const void*)mega_fwd, hipFuncAttributeMaxDynamicSharedMemorySize, LDS_BYTES);
        hipOccupancyMaxActiveBlocksPerMultiprocessor(&per_cu, (const void*)mega_fwd, NWAVES * 64, LDS_BYTES);
        (void)hipGetLastError();
        if (per_cu < 1) fprintf(stderr, "kernel_launch: occupancy query says %d blocks per CU\n", per_cu);
        grid = cus > 0 ? cus : 256;
        if (grid != 256) fprintf(stderr, "kernel_launch: built for a 256-CU device (the fused final norm needs the four owners of a row panel in one scheduling round); got %d\n", grid);
    }
    if (grid < 0) return;
    if (hipMemsetAsync((char*)d_ws + WS_CTL, 0, CTL_BYTES, stream) != hipSuccess) { fprintf(stderr, "kernel_launch: hipMemsetAsync failed\n"); return; }
    Args a{};
    for (int i = 0; i < 24; ++i) a.in[i] = (const float*)d_in[i];
    a.out = (float*)d_out; a.ws = (unsigned char*)d_ws;
    void* kargs[] = {&a};
    hipError_t e = hipLaunchCooperativeKernel((const void*)mega_fwd, dim3(grid), dim3(NWAVES * 64), kargs, LDS_BYTES, stream);
    if (e != hipSuccess) fprintf(stderr, "kernel_launch: cooperative launch failed: %s (grid %d)\n", hipGetErrorString(e), grid);
}
```

```cpp
#include <hip/hip_runtime.h>
#include <hip/hip_cooperative_groups.h>
#include <hip/hip_bf16.h>
#include <cstdio>
#include <cstdint>
#include <cmath>
#include <type_traits>
namespace pg8 {
#define PG8_LAS __attribute__((address_space(3)))
typedef unsigned short bf16_t;
typedef short bf16x8 __attribute__((ext_vector_type(8)));
typedef float f32x4 __attribute__((ext_vector_type(4)));
typedef unsigned u32x4 __attribute__((ext_vector_type(4)));
constexpr int BM = 256, BK = 64, HALF = 128, HTB = HALF * BK * 2  , STAGE_BYTES = 8 * HTB, NXCD = 8, WGM = 8;

__host__ __device__ __forceinline__ int lds_byte(int r, int c) { const int st = (r >> 4) * 2 + (c >> 5), rr = r & 15, cc = c & 31, ob = rr * 64 + cc * 2; return st * 1024 + (ob ^ (((ob >> 9) & 1) << 5)); }
__host__ __device__ __forceinline__ void stage_rc(int b, int& R, int& C) { const int st = b / 1024, sb = b % 1024, swz = sb ^ (((sb >> 9) & 1) << 5); R = (st >> 1) * 16 + swz / 64; C = (st & 1) * 32 + (swz % 64) / 2; }
__host__ __device__ __forceinline__ int perm32(int rho) { const int n = rho >> 4, i = rho & 15; return 8 * (i >> 2) + 4 * n + (i & 3); }

struct Unit { int pm, pn, seg; };
struct Gemm { const bf16_t* A; const bf16_t* Bt; int M, N, K, amap; const bf16_t* A2; const bf16_t* Bt2; int amap2; };
__device__ __forceinline__ const char* a_base(const Gemm& g, const Unit& u) { const int am = u.seg ? g.amap2 : g.amap; const int r0 = am ? u.pm * 256 + 128 * (u.pm / 32 + 1) : u.pm * 256; return (const char*)(u.seg ? g.A2 : g.A) + (size_t)r0 * (size_t)g.K * 2; }
__device__ __forceinline__ const char* b_base(const Gemm& g, const Unit& u) { return (const char*)(u.seg ? g.Bt2 : g.Bt) + (size_t)u.pn * 256 * (size_t)g.K * 2; }
template <class T, class = void> struct has_twoseg : std::false_type {};
template <class T> struct has_twoseg<T, std::void_t<decltype(T::TWOSEG)>> : std::true_type {};

struct StaticOrder {
    int nM, nN, nwg, G, c;
    __host__ __device__ void init(int M, int N, int G_, int c_) { nM = M / BM; nN = N / BM; nwg = nM * nN; G = G_; c = c_; }
    __host__ __device__ bool next(int i, Unit& u) const {
        const long L = (long)i * G + c; if (L >= nwg) return false;
        int wgid = (int)L; { const int q = nwg / NXCD, r = nwg % NXCD, xcd = wgid % NXCD, off = wgid / NXCD; wgid = (xcd < r ? xcd * (q + 1) : r * (q + 1) + (xcd - r) * q) + off; }
        const int nig = WGM * nN, gid = wgid / nig, fm = gid * WGM, gsz = (nM - fm) < WGM ? (nM - fm) : WGM;
        u.pm = fm + ((wgid % nig) % gsz); u.pn = (wgid % nig) / gsz; u.seg = 0; return true;
    }
    __device__ __forceinline__ void a_ready(const Unit&) const {}
    __device__ __forceinline__ void done(const Unit&) const {}
};
struct StaticOrder2 { StaticOrder b;
    __host__ __device__ void init(int M, int N, int G_, int c_) { b.init(M, N, G_, c_); }
    __host__ __device__ bool next(int i, Unit& u) const { if (!b.next(i >> 1, u)) return false; u.seg = i & 1; return true; }
    __device__ __forceinline__ void a_ready(const Unit&) const {}
    __device__ __forceinline__ void done(const Unit&) const {}
};
typedef float f32x2c __attribute__((ext_vector_type(2))); typedef __bf16 bf16x2c __attribute__((ext_vector_type(2)));
__device__ __forceinline__ unsigned cvt_pk_bf16(float lo, float hi) { f32x2c v = {lo, hi}; bf16x2c b = __builtin_convertvector(v, bf16x2c); return __builtin_bit_cast(unsigned, b); }
typedef float f32x2 __attribute__((ext_vector_type(2)));
typedef unsigned u32x2 __attribute__((ext_vector_type(2)));
__device__ __forceinline__ u32x4 pack8(const f32x4 v0, const f32x4 v1) { u32x4 w; w.x = cvt_pk_bf16(v0[0], v0[1]); w.y = cvt_pk_bf16(v0[2], v0[3]); w.z = cvt_pk_bf16(v1[0], v1[1]); w.w = cvt_pk_bf16(v1[2], v1[3]); return w; }
__device__ __forceinline__ void unpack8(const u32x4 w, f32x4& a, f32x4& b) {
    a[0] = __uint_as_float(w.x << 16); a[1] = __uint_as_float(w.x & 0xffff0000u); a[2] = __uint_as_float(w.y << 16); a[3] = __uint_as_float(w.y & 0xffff0000u);
    b[0] = __uint_as_float(w.z << 16); b[1] = __uint_as_float(w.z & 0xffff0000u); b[2] = __uint_as_float(w.w << 16); b[3] = __uint_as_float(w.w & 0xffff0000u); }
__device__ __forceinline__ float sigm(float x) { return __builtin_amdgcn_rcpf(1.f + __expf(-x)); }
__device__ __forceinline__ f32x4 sigm4(f32x4 v) { f32x4 r; r[0] = sigm(v[0]); r[1] = sigm(v[1]); r[2] = sigm(v[2]); r[3] = sigm(v[3]); return r; }
__device__ __forceinline__ unsigned q8x4(f32x4 v) { return (unsigned)(v[0] * 255.f + 0.5f) | ((unsigned)(v[1] * 255.f + 0.5f) << 8) | ((unsigned)(v[2] * 255.f + 0.5f) << 16) | ((unsigned)(v[3] * 255.f + 0.5f) << 24); }
__device__ __forceinline__ f32x4 u8x4(unsigned w) { f32x4 r; r[0] = (float)(w & 0xffu); r[1] = (float)((w >> 8) & 0xffu); r[2] = (float)((w >> 16) & 0xffu); r[3] = (float)(w >> 24); return r; }
__device__ __forceinline__ float dot4(f32x4 v) { return (v[0] * v[0] + v[1] * v[1]) + (v[2] * v[2] + v[3] * v[3]); }
constexpr float QSCALE = 0.125f * 1.4426950408889634f;

#define EPI_LOOP_AM _Pragma("unroll") for (int ai = 0; ai < 2; ++ai) _Pragma("unroll") for (int m = 0; m < 4; ++m)

struct EpiProj1 {
    static constexpr bool PERM = true, AFTER_DRAIN = false;
    bf16_t *Q, *K, *V, *XBC; float* DT; float* NORM;
    __device__ __forceinline__ void operator()(const f32x4 (&acc)[2][2][4][2], const Unit& u, int wr, int wc, int fr, int fq) const {
        const int pn = u.pn, row0 = u.pm * BM + wr * 64 + fr;
        if (pn == 18) {
            if (wc == 0 && fq < 2) {
                EPI_LOOP_AM { float* p = DT + (size_t)(row0 + ai * HALF + m * 16) * 16 + 8 * fq; *(f32x4*)p = acc[ai][0][m][0]; *(f32x4*)(p + 4) = acc[ai][0][m][1]; }
            }
            return;
        }
        bf16_t* base; int ldc, colt; float sc = 1.f;
        if (pn < 4) { base = Q; ldc = 1024; colt = pn * 256; sc = QSCALE; }
        else if (pn < 8) { base = K; ldc = 1024; colt = (pn - 4) * 256; }
        else if (pn < 12) { base = V; ldc = 1024; colt = (pn - 8) * 256; }
        else { base = XBC; ldc = 1536; colt = (pn - 12) * 256; }
        const int col0 = colt + wc * 32 + 8 * fq;
        float mx[2] = {0.f, 0.f};
        EPI_LOOP_AM { bf16_t* rowp = base + (size_t)(row0 + ai * HALF + m * 16) * ldc + col0;
#pragma unroll
            for (int bj = 0; bj < 2; ++bj) { const f32x4 v0 = acc[ai][bj][m][0] * sc, v1 = acc[ai][bj][m][1] * sc; *(u32x4*)(rowp + bj * HALF) = pack8(v0, v1);
                if (pn < 8) { float ss = dot4(v0) + dot4(v1); ss += __shfl_xor(ss, 16); ss += __shfl_xor(ss, 32); mx[bj] = fmaxf(mx[bj], ss); } } }
        if (pn < 8) {
#pragma unroll
            for (int bj = 0; bj < 2; ++bj) { float v = mx[bj]; v = fmaxf(v, __shfl_xor(v, 1)); v = fmaxf(v, __shfl_xor(v, 2)); v = fmaxf(v, __shfl_xor(v, 4)); v = fmaxf(v, __shfl_xor(v, 8));
                if (fr == 0 && fq == 0) atomicMax((unsigned*)NORM + (((pn >> 2) * 8 + (pn & 3) * 2 + bj) * 2 + (wc >> 1)) * 2 + (wc & 1), __float_as_uint(v * 1.02f)); }
        }
    }
};
struct EpiZG {
    static constexpr bool PERM = true, AFTER_DRAIN = false;
    const bf16_t* Y; bf16_t *YZ, *G; const float* gbias; float* SSQ3;
    __device__ __forceinline__ void operator()(const f32x4 (&acc)[2][2][4][2], const Unit& u, int wr, int wc, int fr, int fq) const {
        const int pn = u.pn, row0 = u.pm * BM + wr * 64 + fr;
        if (pn < 4) {
            const int col0 = pn * 256 + wc * 32 + 8 * fq; const int prow0 = row0 + 128 * (u.pm / 32 + 1);
            EPI_LOOP_AM { const int rr = ai * HALF + m * 16; float ss = 0.f;
#pragma unroll
                for (int bj = 0; bj < 2; ++bj) { f32x4 y0, y1; unpack8(*(const u32x4*)(Y + (size_t)(prow0 + rr) * 1024 + col0 + bj * HALF), y0, y1);
                    const f32x4 z0 = acc[ai][bj][m][0], z1 = acc[ai][bj][m][1]; const f32x4 v0 = y0 * z0 * sigm4(z0), v1 = y1 * z1 * sigm4(z1);
                    *(u32x4*)(YZ + (size_t)(row0 + rr) * 1024 + col0 + bj * HALF) = pack8(v0, v1); ss += dot4(v0) + dot4(v1); }
                ss += __shfl_xor(ss, 16); ss += __shfl_xor(ss, 32);
                if (fq == 0) atomicAdd(SSQ3 + row0 + rr, ss); }
        } else {
            const int col0 = (pn - 4) * 256 + wc * 32 + 8 * fq;
            f32x4 bv[2][2];
#pragma unroll
            for (int bj = 0; bj < 2; ++bj) { bv[bj][0] = *(const f32x4*)(gbias + col0 + bj * HALF); bv[bj][1] = *(const f32x4*)(gbias + col0 + bj * HALF + 4); }
            EPI_LOOP_AM { unsigned char* rowp = (unsigned char*)G + (size_t)(row0 + ai * HALF + m * 16) * 2048 + col0;
#pragma unroll
                for (int bj = 0; bj < 2; ++bj) { u32x2 w; w.x = q8x4(sigm4(acc[ai][bj][m][0] + bv[bj][0])); w.y = q8x4(sigm4(acc[ai][bj][m][1] + bv[bj][1])); *(u32x2*)(rowp + bj * HALF) = w; } }
        }
    }
};
struct EpiBranch {
    static constexpr bool PERM = true, AFTER_DRAIN = false, TWOSEG = true;
    const bf16_t* G; bf16_t* MG; const float* SSQ3;
    __device__ __forceinline__ void mid(f32x4 (&acc)[2][2][4][2], const Unit& u, int wr, int wc, int fr, int fq) const {
        const int row0 = u.pm * BM + wr * 64 + fr, col0 = u.pn * 256 + wc * 32 + 8 * fq;
        EPI_LOOP_AM { const size_t row = (size_t)(row0 + ai * HALF + m * 16); const float r3 = rsqrtf(SSQ3[row] * (1.f / 1024.f) + 1e-6f);
#pragma unroll
            for (int bj = 0; bj < 2; ++bj) { const int c = col0 + bj * HALF; const unsigned char* gp = (const unsigned char*)G + row * 2048 + c;
                const u32x2 ws = *(const u32x2*)gp, wa = *(const u32x2*)(gp + 1024);
                const f32x4 s0 = u8x4(ws.x), s1 = u8x4(ws.y), a0 = u8x4(wa.x), a1 = u8x4(wa.y);
#pragma unroll
                for (int e = 0; e < 4; ++e) { acc[ai][bj][m][0][e] *= r3 * s0[e] * __builtin_amdgcn_rcpf(fmaxf(a0[e], 1.f)); acc[ai][bj][m][1][e] *= r3 * s1[e] * __builtin_amdgcn_rcpf(fmaxf(a1[e], 1.f)); } } }
    }
    __device__ __forceinline__ void operator()(f32x4 (&acc)[2][2][4][2], const Unit& u, int wr, int wc, int fr, int fq) const {
        const int row0 = u.pm * BM + wr * 64 + fr, col0 = u.pn * 256 + wc * 32 + 8 * fq;
        EPI_LOOP_AM { const size_t row = (size_t)(row0 + ai * HALF + m * 16);
#pragma unroll
            for (int bj = 0; bj < 2; ++bj) { const int c = col0 + bj * HALF; const u32x2 wa = *(const u32x2*)((const unsigned char*)G + row * 2048 + 1024 + c); f32x4 a0 = u8x4(wa.x), a1 = u8x4(wa.y);
#pragma unroll
                for (int e = 0; e < 4; ++e) { a0[e] = fmaxf(a0[e], 1.f) * (1.f / 255.f); a1[e] = fmaxf(a1[e], 1.f) * (1.f / 255.f); }
                *(u32x4*)(MG + row * 1024 + c) = pack8(acc[ai][bj][m][0] * a0, acc[ai][bj][m][1] * a1); } }
    }
};
struct EpiWout {
    static constexpr bool PERM = true, AFTER_DRAIN = false;
    const float* X; float* H1; bf16_t* H1B; float* SSQ;
    __device__ __forceinline__ void operator()(const f32x4 (&acc)[2][2][4][2], const Unit& u, int wr, int wc, int fr, int fq) const {
        const int row0 = u.pm * BM + wr * 64 + fr, col0 = u.pn * 256 + wc * 32 + 8 * fq;
        EPI_LOOP_AM { const size_t row = (size_t)(row0 + ai * HALF + m * 16); float ss = 0.f;
#pragma unroll
            for (int bj = 0; bj < 2; ++bj) { const size_t o = row * 1024 + col0 + bj * HALF;
                const f32x4 v0 = __builtin_nontemporal_load((const f32x4*)(X + o)) + acc[ai][bj][m][0], v1 = __builtin_nontemporal_load((const f32x4*)(X + o + 4)) + acc[ai][bj][m][1];
                *(u32x4*)(H1B + o) = pack8(v0, v1); ss += dot4(v0) + dot4(v1); }
            ss += __shfl_xor(ss, 16); ss += __shfl_xor(ss, 32);
            if (fq == 0) atomicAdd(SSQ + row, ss); }
    }
};
struct EpiGU {
    static constexpr bool PERM = true, AFTER_DRAIN = false;
    bf16_t* HF; const float* SSQ;
    __device__ __forceinline__ void operator()(const f32x4 (&acc)[2][2][4][2], const Unit& u, int wr, int wc, int fr, int fq) const {
        const int row0 = u.pm * BM + wr * 64 + fr, col0 = u.pn * 128 + wc * 32 + 8 * fq;
        EPI_LOOP_AM { const size_t row = (size_t)(row0 + ai * HALF + m * 16); const float rstd = rsqrtf(SSQ[row] * (1.f / 1024.f) + 1e-6f);
            f32x4 h[2];
#pragma unroll
            for (int n = 0; n < 2; ++n) { const f32x4 g = acc[ai][0][m][n] * rstd, up = acc[ai][1][m][n] * rstd; h[n] = g * sigm4(g) * up; }
            *(u32x4*)(HF + row * 2816 + col0) = pack8(h[0], h[1]); }
    }
};
struct EpiDownNorm {
    static constexpr bool PERM = true, AFTER_DRAIN = false;
    float* H; const bf16_t* H1B; float* SSQ; unsigned* CNT; const float* gfin;
    __device__ __forceinline__ void operator()(f32x4 (&acc)[2][2][4][2], const Unit& u, int wr, int wc, int fr, int fq) const {
        const int row0 = u.pm * BM + wr * 64 + fr, col0 = u.pn * 256 + wc * 32 + 8 * fq;
        EPI_LOOP_AM { const size_t row = (size_t)(row0 + ai * HALF + m * 16); float ss = 0.f;
#pragma unroll
            for (int bj = 0; bj < 2; ++bj) { const size_t o = row * 1024 + col0 + bj * HALF;
                f32x4 r0, r1; unpack8(*(const u32x4*)(H1B + o), r0, r1); acc[ai][bj][m][0] = acc[ai][bj][m][0] + r0; acc[ai][bj][m][1] = acc[ai][bj][m][1] + r1;
                ss += dot4(acc[ai][bj][m][0]) + dot4(acc[ai][bj][m][1]); }
            ss += __shfl_xor(ss, 16); ss += __shfl_xor(ss, 32);
            if (fq == 0) (void)__hip_atomic_fetch_add(SSQ + row, ss, __ATOMIC_RELAXED, __HIP_MEMORY_SCOPE_AGENT); }
        asm volatile("s_waitcnt vmcnt(0)" ::: "memory");
        unsigned* cnt = CNT + 16 * u.pm;
        if (fr == 0 && fq == 0) (void)__hip_atomic_fetch_add(cnt, 1u, __ATOMIC_RELAXED, __HIP_MEMORY_SCOPE_AGENT);
        for (unsigned sp = 0; sp < (1u << 22); ++sp) {
            if ((unsigned)__builtin_amdgcn_readfirstlane((int)__hip_atomic_load(cnt, __ATOMIC_RELAXED, __HIP_MEMORY_SCOPE_AGENT)) >= 32u) break;
            __builtin_amdgcn_s_sleep(2); }
        f32x4 gv[2][2];
#pragma unroll
        for (int bj = 0; bj < 2; ++bj) { gv[bj][0] = *(const f32x4*)(gfin + col0 + bj * HALF); gv[bj][1] = *(const f32x4*)(gfin + col0 + bj * HALF + 4); }
        EPI_LOOP_AM { const size_t row = (size_t)(row0 + ai * HALF + m * 16);
            const float rs = rsqrtf(__hip_atomic_load(SSQ + row, __ATOMIC_RELAXED, __HIP_MEMORY_SCOPE_AGENT) * (1.f / 1024.f) + 1e-6f);
#pragma unroll
            for (int bj = 0; bj < 2; ++bj) { const size_t o = row * 1024 + col0 + bj * HALF;
                *(f32x4*)(H + o) = acc[ai][bj][m][0] * rs * gv[bj][0]; *(f32x4*)(H + o + 4) = acc[ai][bj][m][1] * rs * gv[bj][1]; } }
    }
};

template <class Epi, class Sched, bool ALIGN_EPI = false, bool SP2 = false>
__device__ __forceinline__ void gemm_phase(PG8_LAS unsigned char* lds, const Gemm g, const Sched& S, const Epi& E) {
    int tid_ = threadIdx.x; asm volatile("" : "+v"(tid_));
    const int tid = tid_, wid = __builtin_amdgcn_readfirstlane(tid >> 6), lane = tid & 63, wr = wid >> 2, wc = wid & 3, fr = lane & 15, fq = lane >> 4;
    const int K = g.K, nt = K / BK;
    unsigned voffA[2], voffB[2];
#pragma unroll
    for (int i = 0; i < 2; ++i) { int R, C; stage_rc(tid * 16 + i * 8192, R, C); const int Rb = Epi::PERM ? ((R & ~31) + perm32(R & 31)) : R;
        voffA[i] = (unsigned)(R * K + C) * 2u; voffB[i] = (unsigned)(Rb * K + C) * 2u; }
    const size_t kstep = (size_t)(BK * 2);
    const size_t hstep = (size_t)HALF * K * 2;
    const size_t tstep = 2 * hstep;
    const unsigned ldsw = (unsigned)wid * 1024u;
    const int aoff = lds_byte(wr * 64 + fr, fq * 8), boff = lds_byte(wc * 32 + fr, fq * 8);
#define PG8_SA(b, h) (((b) * 2 + (h)) * HTB)
#define PG8_SB(b, h) ((4 + (b) * 2 + (h)) * HTB)
#define PG8_STAGE(bufoff, gbase, voff) do { _Pragma("unroll") for (int _i = 0; _i < 2; ++_i) \
        __builtin_amdgcn_global_load_lds((const unsigned*)((const char*)(gbase) + (voff)[_i]), (PG8_LAS unsigned*)(lds + (bufoff) + ldsw + _i * 8192), 16, 0, 0); } while (0)
#define PG8_LDA(dst, b, h) do { _Pragma("unroll") for (int m = 0; m < 4; ++m) _Pragma("unroll") for (int k = 0; k < 2; ++k) dst[m][k] = *(const PG8_LAS bf16x8*)(lds + PG8_SA(b, h) + aoff + m * 2048 + k * 1024); } while (0)
#define PG8_LDB(dst, b, h) do { _Pragma("unroll") for (int n = 0; n < 2; ++n) _Pragma("unroll") for (int k = 0; k < 2; ++k) dst[n][k] = *(const PG8_LAS bf16x8*)(lds + PG8_SB(b, h) + boff + n * 2048 + k * 1024); } while (0)
#define PG8_MMA(ai, bj, At, Bt) do { __builtin_amdgcn_s_setprio(1); _Pragma("unroll") for (int m = 0; m < 4; ++m) _Pragma("unroll") for (int n = 0; n < 2; ++n) _Pragma("unroll") for (int k = 0; k < 2; ++k) \
        acc[ai][bj][m][n] = __builtin_amdgcn_mfma_f32_16x16x32_bf16(Bt[n][k], At[m][k], acc[ai][bj][m][n], 0, 0, 0); __builtin_amdgcn_s_setprio(0); } while (0)
#define PG8_WAIT_V(n) asm volatile("s_waitcnt vmcnt(" #n ")" ::: "memory")
#define PG8_WAIT_L(n) asm volatile("s_waitcnt lgkmcnt(" #n ")" ::: "memory")
#define PG8_BAR __builtin_amdgcn_s_barrier()
#define PG8_SCHED __builtin_amdgcn_sched_barrier(0)
    Unit cur, nxt; int ui = 0;
    if (!S.next(0, cur)) return;
    f32x4 acc[2][2][4][2];
#pragma unroll
    for (int a = 0; a < 2; ++a)
#pragma unroll
        for (int b = 0; b < 2; ++b)
#pragma unroll
            for (int m = 0; m < 4; ++m)
#pragma unroll
                for (int n = 0; n < 2; ++n) acc[a][b][m][n] = (f32x4){0.f, 0.f, 0.f, 0.f};
    bf16x8 At[4][2], B0[2][2], B1[2][2];
    const char* cA = a_base(g, cur); const char* cB = b_base(g, cur);
    S.a_ready(cur);
    if constexpr (SP2) {
        PG8_STAGE(PG8_SB(0, 0), cB, voffB); PG8_STAGE(PG8_SB(0, 1), cB + hstep, voffB); PG8_STAGE(PG8_SA(0, 0), cA, voffA); PG8_STAGE(PG8_SA(0, 1), cA + hstep, voffA);
        if (wr == 1) PG8_BAR;
        PG8_WAIT_V(2); PG8_BAR;
        PG8_STAGE(PG8_SB(1, 0), cB + kstep, voffB); PG8_STAGE(PG8_SA(1, 0), cA + kstep, voffA); PG8_STAGE(PG8_SB(1, 1), cB + hstep + kstep, voffB);
        PG8_WAIT_V(6); PG8_BAR;
    } else {
        PG8_STAGE(PG8_SB(0, 0), cB, voffB); PG8_STAGE(PG8_SA(0, 0), cA, voffA); PG8_STAGE(PG8_SB(0, 1), cB + hstep, voffB); PG8_STAGE(PG8_SA(0, 1), cA + hstep, voffA);
        if (wr == 1) PG8_BAR;
        PG8_WAIT_V(4); PG8_BAR;
        PG8_STAGE(PG8_SB(1, 0), cB + kstep, voffB); PG8_STAGE(PG8_SA(1, 0), cA + kstep, voffA); PG8_STAGE(PG8_SB(1, 1), cB + hstep + kstep, voffB);
        PG8_WAIT_V(6); PG8_BAR;
    }
    for (;;) {
        const bool has_next = S.next(ui + 1, nxt);
        const char* nA = has_next ? a_base(g, nxt) : cA; const char* nB = has_next ? b_base(g, nxt) : cB;
        for (int t = 0; t < nt; t += 2) {
            const bool last = (t == nt - 2);
            const char* a1 = cA + (size_t)(t + 1) * kstep;
            const char* a2 = last ? nA : cA + (size_t)(t + 2) * kstep; const char* b2 = last ? nB : cB + (size_t)(t + 2) * kstep;
            const char* a3 = a2 + kstep; const char* b3 = b2 + kstep;
            if (last && has_next) S.a_ready(nxt);
            if constexpr (SP2) {
            PG8_LDB(B0, 0, 0); PG8_LDB(B1, 0, 1); PG8_SCHED; PG8_LDA(At, 0, 0); PG8_STAGE(PG8_SA(1, 1), a1 + hstep, voffA);
            PG8_WAIT_V(8); PG8_WAIT_L(0); PG8_BAR; PG8_MMA(0, 0, At, B0); PG8_MMA(0, 1, At, B1); PG8_BAR; PG8_SCHED;
            PG8_LDA(At, 0, 1); PG8_STAGE(PG8_SB(0, 0), b2, voffB); PG8_STAGE(PG8_SB(0, 1), b2 + hstep, voffB); PG8_STAGE(PG8_SA(0, 0), a2, voffA);
            PG8_WAIT_V(8); PG8_WAIT_L(0); PG8_BAR; PG8_MMA(1, 0, At, B0); PG8_MMA(1, 1, At, B1); PG8_BAR; PG8_SCHED;
            PG8_LDB(B0, 1, 0); PG8_LDB(B1, 1, 1); PG8_SCHED; PG8_LDA(At, 1, 0); PG8_STAGE(PG8_SA(0, 1), a2 + hstep, voffA);
            PG8_WAIT_V(8); PG8_WAIT_L(0); PG8_BAR; PG8_MMA(0, 0, At, B0); PG8_MMA(0, 1, At, B1); PG8_BAR; PG8_SCHED;
            PG8_LDA(At, 1, 1); PG8_STAGE(PG8_SB(1, 0), b3, voffB); PG8_STAGE(PG8_SB(1, 1), b3 + hstep, voffB); PG8_STAGE(PG8_SA(1, 0), a3, voffA);
            PG8_WAIT_V(8); PG8_WAIT_L(0); PG8_BAR; PG8_MMA(1, 0, At, B0); PG8_MMA(1, 1, At, B1); PG8_BAR; PG8_SCHED;
            } else {
            PG8_LDB(B0, 0, 0); PG8_SCHED; PG8_LDA(At, 0, 0); PG8_STAGE(PG8_SA(1, 1), a1 + hstep, voffA);
            PG8_WAIT_L(8); PG8_BAR; PG8_WAIT_L(0); PG8_MMA(0, 0, At, B0); PG8_BAR; PG8_SCHED;
            PG8_LDB(B1, 0, 1); PG8_STAGE(PG8_SB(0, 0), b2, voffB);
            PG8_BAR; PG8_WAIT_L(0); PG8_MMA(0, 1, At, B1); PG8_BAR;
            PG8_LDA(At, 0, 1); PG8_STAGE(PG8_SA(0, 0), a2, voffA);
            PG8_BAR; PG8_WAIT_L(0); PG8_MMA(1, 0, At, B0); PG8_BAR; PG8_SCHED;
            PG8_STAGE(PG8_SB(0, 1), b2 + hstep, voffB);
            PG8_WAIT_V(6); PG8_BAR; PG8_MMA(1, 1, At, B1); PG8_BAR;
            PG8_LDB(B0, 1, 0); PG8_SCHED; PG8_LDA(At, 1, 0); PG8_STAGE(PG8_SA(0, 1), a2 + hstep, voffA);
            PG8_WAIT_L(8); PG8_BAR; PG8_WAIT_L(0); PG8_MMA(0, 0, At, B0); PG8_BAR; PG8_SCHED;
            PG8_LDB(B1, 1, 1); PG8_STAGE(PG8_SB(1, 0), b3, voffB);
            PG8_BAR; PG8_WAIT_L(0); PG8_MMA(0, 1, At, B1); PG8_BAR;
            PG8_LDA(At, 1, 1); PG8_STAGE(PG8_SA(1, 0), a3, voffA);
            PG8_BAR; PG8_WAIT_L(0); PG8_MMA(1, 0, At, B0); PG8_BAR; PG8_SCHED;
            PG8_STAGE(PG8_SB(1, 1), b3 + hstep, voffB);
            PG8_WAIT_V(6); PG8_BAR; PG8_MMA(1, 1, At, B1); PG8_BAR;
            }
        }
        if constexpr (ALIGN_EPI) { if (wr == 0) PG8_BAR; }
        bool keep_acc = false;
        if constexpr (has_twoseg<Epi>::value) { if (cur.seg == 0) { E.mid(acc, cur, wr, wc, fr, fq); keep_acc = true; } else { E(acc, cur, wr, wc, fr, fq); } }
        else if constexpr (!Epi::AFTER_DRAIN) { E(acc, cur, wr, wc, fr, fq); S.done(cur); }
        if (!has_next) break;
        if (!keep_acc)
#pragma unroll
        for (int a = 0; a < 2; ++a)
#pragma unroll
            for (int b = 0; b < 2; ++b)
#pragma unroll
                for (int m = 0; m < 4; ++m)
#pragma unroll
                    for (int n = 0; n < 2; ++n) acc[a][b][m][n] = (f32x4){0.f, 0.f, 0.f, 0.f};
        cur = nxt; cA = nA; cB = nB; ++ui;
        if constexpr (ALIGN_EPI) { if (wr == 1) PG8_BAR; }
    }
    PG8_WAIT_V(0);
    if constexpr (!ALIGN_EPI) { if (wr == 0) PG8_BAR; }
    PG8_BAR;
    if constexpr (Epi::AFTER_DRAIN) { E.fused(acc, cur, wr, wc, fr, fq, lds, wid, lane); S.done(cur); }
#undef PG8_SA
#undef PG8_SB
#undef PG8_STAGE
#undef PG8_LDA
#undef PG8_LDB
#undef PG8_MMA
#undef PG8_WAIT_V
#undef PG8_WAIT_L
#undef PG8_BAR
#undef PG8_SCHED
}
}
namespace attn_body {
using bf16=__hip_bfloat16;
using bf16x8=__attribute__((ext_vector_type(8)))short;
using s16x4=__attribute__((ext_vector_type(4)))short;
using f32x16=__attribute__((ext_vector_type(16)))float;
using u32x4=__attribute__((ext_vector_type(4)))unsigned;
constexpr int D=64,PQ=1024,PO=2048,LP=8320;
constexpr int NW=8,QBLK=32,QB=QBLK*NW,KVBLK=64,NQB=32;
__device__ __forceinline__ int crow(int r,int hi){return (r&3)+8*(r>>2)+4*hi;}
#define SBAR() __builtin_amdgcn_sched_barrier(0)
__device__ __forceinline__ void cmask(f32x16&p0,f32x16&p1,int jb,int qrel,int hi){
  const float NEG=-INFINITY; int kb=64*jb+4*hi;
  #pragma unroll
  for(int r=0;r<16;++r){int kv=kb+(r&3)+8*(r>>2); if(kv>qrel)p0[r]=NEG; if(kv+32>qrel)p1[r]=NEG;}
}

constexpr int NSLOT=3, SLOTB=8192;
constexpr int LDS_K=0, LDS_V=NSLOT*SLOTB, LDS_WS=2*NSLOT*SLOTB, LDS_OST=LDS_WS+NW*64*4, LDS_BYTES=LDS_OST+NW*4096;
constexpr float C2=0.125f*1.4426950408889634f;
__device__ __forceinline__ void glds16(const void*gsrc,unsigned lds_dst){unsigned keep;
  asm volatile("s_mov_b32 %0, m0\n\ts_mov_b32 m0, %2\n\ts_nop 0\n\tglobal_load_lds_dwordx4 %1, off\n\ts_mov_b32 m0, %0":"=&s"(keep):"v"(gsrc),"s"(lds_dst):"memory");}
__device__ __forceinline__ float max3f(float a,float b,float c){float r;asm("v_max3_f32 %0, %1, %2, %3":"=v"(r):"v"(a),"v"(b),"v"(c));return r;}
__device__ __forceinline__ float max2f(float a,float b){float r;asm("v_max_f32_e32 %0, %1, %2":"=v"(r):"v"(a),"v"(b));return r;}
__device__ __forceinline__ float fadd_s(float a,float b){float r;asm("v_add_f32_e32 %0, %1, %2":"=v"(r):"v"(a),"v"(b));return r;}
__device__ __forceinline__ float fsub_s(float a,float b){float r;asm("v_sub_f32_e32 %0, %1, %2":"=v"(r):"v"(a),"v"(b));return r;}
typedef float f32x2_t __attribute__((ext_vector_type(2))); typedef __bf16 bf16x2_t __attribute__((ext_vector_type(2)));
__device__ __forceinline__ unsigned cvtpk_s(float lo,float hi){f32x2_t v={lo,hi};bf16x2_t b=__builtin_convertvector(v,bf16x2_t);return __builtin_bit_cast(unsigned,b);}
#define WAIT_BAR(N) asm volatile("s_waitcnt vmcnt(" #N ") lgkmcnt(0)\n\ts_barrier":::"memory")

__device__ __forceinline__ void qkt(f32x16&p0,f32x16&p1,const char*Kslot,const bf16x8*qr,const f32x16&ci0,const f32x16&ci1,int r32,int hi){
  const char*kb=Kslot+hi*1024+r32*16;
  #pragma unroll
  for(int d0=0;d0<4;++d0){
    const bf16x8 b0=*reinterpret_cast<const bf16x8*>(kb+d0*2048);
    const bf16x8 b1=*reinterpret_cast<const bf16x8*>(kb+d0*2048+512);
    if(d0==0){p0=__builtin_amdgcn_mfma_f32_32x32x16_bf16(b0,qr[0],ci0,0,0,0);p1=__builtin_amdgcn_mfma_f32_32x32x16_bf16(b1,qr[0],ci1,0,0,0);}
    else{p0=__builtin_amdgcn_mfma_f32_32x32x16_bf16(b0,qr[d0],p0,0,0,0);p1=__builtin_amdgcn_mfma_f32_32x32x16_bf16(b1,qr[d0],p1,0,0,0);}}
}
typedef __attribute__((address_space(3))) const char* lds_cptr;
typedef short v4i16_t __attribute__((ext_vector_type(4)));
__device__ __forceinline__ void kload8(bf16x8*kf,lds_cptr kp){
  kf[0]=*(const __attribute__((address_space(3))) bf16x8*)(kp);      kf[1]=*(const __attribute__((address_space(3))) bf16x8*)(kp+512);
  kf[2]=*(const __attribute__((address_space(3))) bf16x8*)(kp+2048); kf[3]=*(const __attribute__((address_space(3))) bf16x8*)(kp+2560);
  kf[4]=*(const __attribute__((address_space(3))) bf16x8*)(kp+4096); kf[5]=*(const __attribute__((address_space(3))) bf16x8*)(kp+4608);
  kf[6]=*(const __attribute__((address_space(3))) bf16x8*)(kp+6144); kf[7]=*(const __attribute__((address_space(3))) bf16x8*)(kp+6656);
}
__device__ __forceinline__ void kload2(bf16x8*kf,lds_cptr kp,int j){ kf[2*j]=*(const __attribute__((address_space(3))) bf16x8*)(kp+j*2048); kf[2*j+1]=*(const __attribute__((address_space(3))) bf16x8*)(kp+j*2048+512); }
__device__ __forceinline__ s16x4 vtr(lds_cptr p){ return __builtin_bit_cast(s16x4,__builtin_amdgcn_ds_read_tr16_b64_v4i16((__attribute__((address_space(3))) v4i16_t*)p)); }
__device__ __forceinline__ float rowmax(const f32x16&p0,const f32x16&p1){
  float a=max3f(p0[0],p0[1],p1[0]),b=max3f(p0[2],p0[3],p1[1]);a=max3f(a,p1[2],p1[3]);
  #pragma unroll
  for(int r=4;r<16;r+=4){a=max3f(a,p0[r],p0[r+1]);b=max3f(b,p0[r+2],p0[r+3]);a=max3f(a,p1[r],p1[r+1]);b=max3f(b,p1[r+2],p1[r+3]);}
  const float m=max2f(a,b);
  auto rr=__builtin_amdgcn_permlane32_swap(__float_as_uint(m),__float_as_uint(m),false,false);
  return max2f(__uint_as_float(rr[0]),__uint_as_float(rr[1]));
}
__device__ __forceinline__ void pv(f32x16*o,int vb,bf16x8 pa0,bf16x8 pa1,bf16x8 pa2,bf16x8 pa3){
  #pragma unroll
  for(int d0=0;d0<2;++d0){s16x4 lo[4],hi[4];
    #pragma unroll
    for(int ks=0;ks<4;++ks){
      asm volatile("ds_read_b64_tr_b16 %0,%1 offset:%c2":"=&v"(lo[ks]):"v"(vb),"i"(d0*4096+ks*1024):"memory");
      asm volatile("ds_read_b64_tr_b16 %0,%1 offset:%c2":"=&v"(hi[ks]):"v"(vb),"i"(d0*4096+ks*1024+512):"memory");}
    asm volatile("s_waitcnt lgkmcnt(0)":::"memory");SBAR();
    #define PK(k) (bf16x8){lo[k][0],lo[k][1],lo[k][2],lo[k][3],hi[k][0],hi[k][1],hi[k][2],hi[k][3]}
    o[d0]=__builtin_amdgcn_mfma_f32_32x32x16_bf16(pa0,PK(0),o[d0],0,0,0);
    o[d0]=__builtin_amdgcn_mfma_f32_32x32x16_bf16(pa1,PK(1),o[d0],0,0,0);
    o[d0]=__builtin_amdgcn_mfma_f32_32x32x16_bf16(pa2,PK(2),o[d0],0,0,0);
    o[d0]=__builtin_amdgcn_mfma_f32_32x32x16_bf16(pa3,PK(3),o[d0],0,0,0);
    #undef PK
  }
}

#ifndef ATTN_STORE16
#define ATTN_STORE16(p,v) (*(u32x4*)(p)=(v))
#endif
template<int THRL> __device__ __forceinline__ void attn_unit(int b,int h,int c,int vh,int qb,int t0,const bf16*Q,const bf16*__restrict__ K,const bf16*__restrict__ V,bf16*O,char*shm){
  int tid_=threadIdx.x; asm volatile("":"+v"(tid_)); const int tid=tid_,lane=tid&63,r32=lane&31,hi=lane>>5; const int wid=__builtin_amdgcn_readfirstlane(tid>>6);
  const long rowbase=(long)b*LP+64; const int q0=64+qb*QB;
  const bf16*Qw=Q+(rowbase+q0+wid*QBLK)*PQ+h*128+c*64;
  const bf16*Kh=K+(rowbase+(long)t0*KVBLK)*PQ+h*128+c*64,*Vh=V+(rowbase+(long)t0*KVBLK)*PQ+h*128+vh*64;
  const float s2=__builtin_amdgcn_exp2f(-(float)(h+1))*1.4426950408889634f;
  const unsigned lds0=(unsigned)(uintptr_t)shm;
  float*wsf=(float*)(shm+LDS_WS)+wid*64;
  const bf16*ksrc=Kh+(long)lane*PQ+wid*8;
  const bf16*vsrc=Vh+(long)(16*(wid&3)+(lane>>2))*PQ+(wid>>2)*32+(lane&3)*8;
  const unsigned kdst=lds0+LDS_K+wid*1024, vdst=lds0+LDS_V+wid*1024;
  #define DMA_K(t,slot) glds16(ksrc+(long)(t)*KVBLK*PQ,(unsigned)__builtin_amdgcn_readfirstlane(kdst+(slot)))
  #define DMA_V(t,slot) glds16(vsrc+(long)(t)*KVBLK*PQ,(unsigned)__builtin_amdgcn_readfirstlane(vdst+(slot)))
  const int vb0=(int)(lds0+LDS_V)+((lane>>4)&1)*32+(lane&3)*8+(4*hi+((lane&15)>>2))*64;
  const char*Kbase=shm+LDS_K; bf16x8 kf[8];
  const lds_cptr shm3=(lds_cptr)shm; const lds_cptr kp0=shm3+LDS_K+hi*1024+r32*16; const lds_cptr vp0=shm3+LDS_V+((lane>>4)&1)*32+(lane&3)*8+(4*hi+((lane&15)>>2))*64;
  const int NT=(q0+QB)/KVBLK-t0;
  DMA_K(0,0);DMA_V(0,0);DMA_K(1,SLOTB);
  bf16x8 qr[4];
  #pragma unroll
  for(int d0=0;d0<4;++d0)qr[d0]=*reinterpret_cast<const bf16x8*>(&Qw[(long)r32*PQ+d0*16+hi*8]);
  float mhat=0.f,l_reg=0.f;f32x16 o[2];o[0]=f32x16{};o[1]=f32x16{};
  #define RFL(x) __uint_as_float((unsigned)__builtin_amdgcn_readfirstlane((int)__float_as_uint(x)))
  const float s2x1=RFL(s2),s2x2=RFL(2.f*s2),s2x3=RFL(3.f*s2),s2x8=RFL(8.f*s2),s2x16=RFL(16.f*s2),s2x24=RFL(24.f*s2),s2_32=RFL(32.f*s2),s2_64=RFL(64.f*s2);
  const float hi4=hi?4.f*s2:0.f;
  #define CINIT(C0,C1,t) do{ const float tbh_=(s2_64*(float)((t)-(NT-4))-mhat)+hi4; \
    { const float g0_=tbh_,g1_=tbh_+s2x8,g2_=tbh_+s2x16,g3_=tbh_+s2x24; \
      C0[0]=g0_;C0[1]=g0_+s2x1;C0[2]=g0_+s2x2;C0[3]=g0_+s2x3; C0[4]=g1_;C0[5]=g1_+s2x1;C0[6]=g1_+s2x2;C0[7]=g1_+s2x3; \
      C0[8]=g2_;C0[9]=g2_+s2x1;C0[10]=g2_+s2x2;C0[11]=g2_+s2x3; C0[12]=g3_;C0[13]=g3_+s2x1;C0[14]=g3_+s2x2;C0[15]=g3_+s2x3; } \
    _Pragma("unroll") for(int r=0;r<16;++r)C1[r]=C0[r]+s2_32; }while(0)
  const int qrel=wid*QBLK+r32;
  #define CMASK(P0,P1,t) do{int jb_=(t)-(NT-4); if(jb_>=0)cmask(P0,P1,jb_,qrel,hi);}while(0)
  bool resc=false;
  #define START(P0,P1) do{ const float rm=rowmax(P0,P1); resc=false; \
    { const float dl=rm; mhat=fadd_s(mhat,dl); \
      _Pragma("unroll") for(int r=0;r<16;++r){P0[r]=fsub_s(P0[r],dl);P1[r]=fsub_s(P1[r],dl);} } \
    _Pragma("unroll") for(int r=0;r<16;++r)P0[r]=__builtin_amdgcn_exp2f(P0[r]); }while(0)
  #define RESC() do{ if(resc){ asm volatile("s_waitcnt lgkmcnt(0)":::"memory"); \
      _Pragma("unroll") for(int d_=0;d_<2;++d_) _Pragma("unroll") for(int r=0;r<16;++r)o[d_][r]*=wsf[crow(r,hi)]; } }while(0)
  f32x16 pA0,pA1,pB0,pB1;
  int sl_prev=0,sl_cur=0,sl_next=SLOTB;
  #define ROT() do{sl_prev=sl_cur;sl_cur=sl_next;sl_next=(sl_next==(NSLOT-1)*SLOTB)?0:sl_next+SLOTB;}while(0)
  DMA_K(2,2*SLOTB);
  WAIT_BAR(3);
  { f32x16 ci0,ci1; CINIT(ci0,ci1,0); qkt(pA0,pA1,Kbase,qr,ci0,ci1,r32,hi); } asm volatile("s_nop 15\n\ts_nop 7":"+v"(pA0),"+v"(pA1));
  if(t0==0){ const float NEGI=-INFINITY; _Pragma("unroll") for(int r=0;r<16;++r)pA0[r]=NEGI; _Pragma("unroll") for(int r=0;r<8;++r)pA1[r]=NEGI; }
  START(pA0,pA1);
  _Pragma("unroll") for(int r=0;r<16;++r)pA1[r]=__builtin_amdgcn_exp2f(pA1[r]);
  WAIT_BAR(0);
  DMA_K(3,0);DMA_V(1,SLOTB);
  ROT();
  kload8(kf,kp0+sl_cur);
  WAIT_BAR(2);
  s16x4 vlo[8],vhi[8]; u32x4 pw0,pw1,pw2,pw3;
  #define PKW(P,B) cvtpk_s(P[B],P[B+1])
  #define PAF(k) __builtin_bit_cast(bf16x8,pw##k)
  #define VFR(i) (bf16x8){vlo[i][0],vlo[i][1],vlo[i][2],vlo[i][3],vhi[i][0],vhi[i][1],vhi[i][2],vhi[i][3]}
  #define PIN(x) asm volatile("":"+v"(x))
  #define MX3(a,b,c) __builtin_fmaxf(__builtin_fmaxf((a),(b)),(c))
  #define GAPA(MF,A0,A1,A2,A3,W0,W1,PW) do{ MF; sacc+=A0; sacc+=A1; sacc+=A2; sacc+=A3; PIN(sacc); W0; W1; PIN(PW); SBAR(); }while(0)
  #define EX(v) __builtin_amdgcn_exp2f(v)
  #define GAPB(MF,X,B,INI) do{ MF; X[B]=EX(X[B]); X[B+1]=EX(X[B+1]); X[B+2]=EX(X[B+2]); X[B+3]=EX(X[B+3]); PIN(X); INI; SBAR(); }while(0)
  #define NI0(P,g) do{ P[4*(g)]=gn##g##_; P[4*(g)+1]=gn##g##_+s2x1; P[4*(g)+2]=gn##g##_+s2x2; P[4*(g)+3]=gn##g##_+s2x3; PIN(P); }while(0)
  #define NI1(P1,P0,g) do{ P1[4*(g)]=P0[4*(g)]+s2_32; P1[4*(g)+1]=P0[4*(g)+1]+s2_32; P1[4*(g)+2]=P0[4*(g)+2]+s2_32; P1[4*(g)+3]=P0[4*(g)+3]+s2_32; PIN(P1); }while(0)
  #define VRD(i) do{ vlo[i]=vtr(vp_+(((i)>>2)*4096+((i)&3)*1024)); vhi[i]=vtr(vp_+(((i)>>2)*4096+((i)&3)*1024+512)); }while(0)
  #define KRD(G,j) do{ if(G){ kload2(kf,kp0+sl_next,j); SBAR(); } }while(0)
  #define STEP(C0,C1,P0,P1,t,GK,GV,GL) do{ SBAR(); \
    const lds_cptr vp_=vp0+sl_prev; \
    VRD(0); SBAR(); float sacc=(P0[0]+P0[1]); \
    GAPA(C0=__builtin_amdgcn_mfma_f32_32x32x16_bf16(kf[0],qr[0],C0,0,0,0), P0[2],P0[3],P0[4],P0[5],     pw0[0]=PKW(P0,0), pw0[1]=PKW(P0,2), pw0); \
    VRD(4); SBAR(); GAPA(C1=__builtin_amdgcn_mfma_f32_32x32x16_bf16(kf[1],qr[0],C1,0,0,0), P0[6],P0[7],P0[8],P0[9],     pw0[2]=PKW(P0,4), pw0[3]=PKW(P0,6), pw0); \
    VRD(1); SBAR(); GAPA(C0=__builtin_amdgcn_mfma_f32_32x32x16_bf16(kf[2],qr[1],C0,0,0,0),   P0[10],P0[11],P0[12],P0[13], pw1[0]=PKW(P0,8), pw1[1]=PKW(P0,10), pw1); \
    VRD(5); SBAR(); GAPA(C1=__builtin_amdgcn_mfma_f32_32x32x16_bf16(kf[3],qr[1],C1,0,0,0),   P0[14],P0[15],P1[0],P1[1],   pw1[2]=PKW(P0,12),pw1[3]=PKW(P0,14), pw1); \
    VRD(2); SBAR(); GAPA(C0=__builtin_amdgcn_mfma_f32_32x32x16_bf16(kf[4],qr[2],C0,0,0,0),   P1[2],P1[3],P1[4],P1[5],     pw2[0]=PKW(P1,0), pw2[1]=PKW(P1,2), pw2); \
    VRD(6); SBAR(); GAPA(C1=__builtin_amdgcn_mfma_f32_32x32x16_bf16(kf[5],qr[2],C1,0,0,0),   P1[6],P1[7],P1[8],P1[9],     pw2[2]=PKW(P1,4), pw2[3]=PKW(P1,6), pw2); \
    VRD(3); SBAR(); GAPA(C0=__builtin_amdgcn_mfma_f32_32x32x16_bf16(kf[6],qr[3],C0,0,0,0),   P1[10],P1[11],P1[12],P1[13], pw3[0]=PKW(P1,8), pw3[1]=PKW(P1,10), pw3); \
    VRD(7); SBAR(); GAPA(C1=__builtin_amdgcn_mfma_f32_32x32x16_bf16(kf[7],qr[3],C1,0,0,0),   P1[14],P1[15],0.f,0.f,       pw3[2]=PKW(P1,12),pw3[3]=PKW(P1,14), pw3); \
    l_reg+=sacc; \
    if(GK){DMA_K((t)+3,sl_cur);} if(GV){DMA_V((t)+1,sl_next);} \
    CMASK(C0,C1,t); \
    { float a=MX3(C0[0],C0[1],C1[0]),b=MX3(C0[2],C0[3],C1[1]); a=MX3(a,C1[2],C1[3]); \
      _Pragma("unroll") for(int r=4;r<16;r+=4){a=MX3(a,C0[r],C0[r+1]);b=MX3(b,C0[r+2],C0[r+3]);a=MX3(a,C1[r],C1[r+1]);b=MX3(b,C1[r+2],C1[r+3]);} \
      float rm=__builtin_fmaxf(a,b); { auto rr=__builtin_amdgcn_permlane32_swap(__float_as_uint(rm),__float_as_uint(rm),false,false); rm=__builtin_fmaxf(__uint_as_float(rr[0]),__uint_as_float(rr[1])); } \
      resc=false; \
      if(__builtin_expect(__any(rm>(float)THRL),0)){ const float dl=__builtin_fmaxf(rm,0.f); mhat+=dl; \
        _Pragma("unroll") for(int r=0;r<16;++r){C0[r]-=dl;C1[r]-=dl;} \
        const float f=__builtin_amdgcn_exp2f(-dl); l_reg*=f; if(hi==0)wsf[r32]=f; resc=true; } } \
    SBAR(); \
    const float gn0_=(s2_64*(float)(((t)+1)-(NT-4))-mhat)+hi4, gn1_=gn0_+s2x8, gn2_=gn0_+s2x16, gn3_=gn0_+s2x24; \
    GAPB(o[0]=__builtin_amdgcn_mfma_f32_32x32x16_bf16(PAF(0),VFR(0),o[0],0,0,0), C0,0, NI0(P0,0)); \
    GAPB(o[1]=__builtin_amdgcn_mfma_f32_32x32x16_bf16(PAF(0),VFR(4),o[1],0,0,0), C0,4, NI0(P0,1)); \
    KRD(GL,0); GAPB(o[0]=__builtin_amdgcn_mfma_f32_32x32x16_bf16(PAF(1),VFR(1),o[0],0,0,0), C0,8, NI0(P0,2)); \
    KRD(GL,1); GAPB(o[1]=__builtin_amdgcn_mfma_f32_32x32x16_bf16(PAF(1),VFR(5),o[1],0,0,0), C0,12, NI0(P0,3)); \
    KRD(GL,2); GAPB(o[0]=__builtin_amdgcn_mfma_f32_32x32x16_bf16(PAF(2),VFR(2),o[0],0,0,0), C1,0, NI1(P1,P0,0)); \
    KRD(GL,3); GAPB(o[1]=__builtin_amdgcn_mfma_f32_32x32x16_bf16(PAF(2),VFR(6),o[1],0,0,0), C1,4, NI1(P1,P0,1)); \
    GAPB(o[0]=__builtin_amdgcn_mfma_f32_32x32x16_bf16(PAF(3),VFR(3),o[0],0,0,0), C1,8, NI1(P1,P0,2)); \
    GAPB(o[1]=__builtin_amdgcn_mfma_f32_32x32x16_bf16(PAF(3),VFR(7),o[1],0,0,0), C1,12, NI1(P1,P0,3)); \
    }while(0)
  CINIT(pB0,pB1,1);
  int t=1;
  #undef CMASK
  #define CMASK(P0,P1,t) do{}while(0)
  for(;t+5<NT;t+=2){
    STEP(pB0,pB1,pA0,pA1,t,true,true,true);     WAIT_BAR(2); RESC(); ROT();
    STEP(pA0,pA1,pB0,pB1,t+1,true,true,true);   WAIT_BAR(2); RESC(); ROT();
  }
  #undef CMASK
  #define CMASK(P0,P1,t) do{int jb_=(t)-(NT-4); if(jb_>=0)cmask(P0,P1,jb_,qrel,hi);}while(0)
  #define ENDW(tt) do{ if((tt)+3<NT){WAIT_BAR(2);} else if((tt)+2<NT){WAIT_BAR(1);} else {WAIT_BAR(0);} }while(0)
  for(;t+2<NT;t+=2){
    STEP(pB0,pB1,pA0,pA1,t,(t+3<NT),(t+1<NT),(t+1<NT));       ENDW(t);   RESC(); ROT();
    STEP(pA0,pA1,pB0,pB1,t+1,(t+4<NT),(t+2<NT),(t+2<NT));     ENDW(t+1); RESC(); ROT();
  }
  STEP(pB0,pB1,pA0,pA1,NT-2,false,true,true);   ENDW(NT-2); RESC(); ROT();
  STEP(pA0,pA1,pB0,pB1,NT-1,false,false,false); RESC();
  { float sacc=pA0[0]+pA0[1]; _Pragma("unroll") for(int r=2;r<16;++r)sacc+=pA0[r]; _Pragma("unroll") for(int r=0;r<16;++r)sacc+=pA1[r]; l_reg+=sacc;
    pw0=(u32x4){PKW(pA0,0),PKW(pA0,2),PKW(pA0,4),PKW(pA0,6)};pw1=(u32x4){PKW(pA0,8),PKW(pA0,10),PKW(pA0,12),PKW(pA0,14)};pw2=(u32x4){PKW(pA1,0),PKW(pA1,2),PKW(pA1,4),PKW(pA1,6)};pw3=(u32x4){PKW(pA1,8),PKW(pA1,10),PKW(pA1,12),PKW(pA1,14)};
    SBAR(); pv(o,vb0+sl_cur,PAF(0),PAF(1),PAF(2),PAF(3)); }
  #undef PKW
  #undef PAF
  #undef VFR
  #undef PIN
  #undef MX3
  #undef GAPA
  #undef GAPB
  #undef NI0
  #undef NI1
  #undef EX
  #undef VRD
  #undef KRD
  #undef STEP
  #undef ENDW
  {auto rr=__builtin_amdgcn_permlane32_swap(__float_as_uint(l_reg),__float_as_uint(l_reg),false,false);l_reg=__uint_as_float(rr[0])+__uint_as_float(rr[1]);}
  if(hi==0)wsf[32+r32]=l_reg;asm volatile("s_waitcnt lgkmcnt(0)":::"memory");
  float rli[16];
  #pragma unroll
  for(int r=0;r<16;++r)rli[r]=__builtin_amdgcn_rcpf(wsf[32+crow(r,hi)]);
  bf16*Ow=O+(rowbase+q0+wid*QBLK)*PO+c*1024+h*128+vh*64;
  { bf16*stg=(bf16*)(shm+LDS_OST)+wid*2048;
    #pragma unroll
    for(int r=0;r<16;++r){const int orow=crow(r,hi);
      #pragma unroll
      for(int d0=0;d0<2;++d0)stg[orow*64+d0*32+r32]=__float2bfloat16(o[d0][r]*rli[r]);}
    asm volatile("s_waitcnt lgkmcnt(0)":::"memory");
    #pragma unroll
    for(int i=0;i<4;++i){const int row=i*8+(lane>>3),ch=lane&7; const u32x4 v=*(const u32x4*)(stg+row*64+ch*8); ATTN_STORE16(Ow+(long)row*PO+ch*8,v);} }
  asm volatile("s_waitcnt lgkmcnt(0)\n\ts_barrier":::"memory");
  #undef DMA_K
  #undef DMA_V
  #undef CINIT
  #undef RFL
  #undef CMASK
  #undef START
  #undef RESC
  #undef ROT
}
constexpr int ATTN_LDS_BYTES=LDS_BYTES;
struct AttnUnit { int b,h,c,vh,qb; };
struct AttnTensors { const bf16* Q; const bf16* K; const bf16* V; bf16* O; const float* NORM; unsigned* qctr; };
template<int THRL=8> __device__ __forceinline__ void attn_phase(char*lds,const AttnTensors&T){
  typedef __attribute__((address_space(3))) unsigned lu32;
  lu32* slot=(lu32*)((__attribute__((address_space(3))) char*)lds+LDS_BYTES+32);
  unsigned nxt=0u; if(threadIdx.x==0)nxt=atomicAdd(T.qctr,1u);
  for(;;){
    if(threadIdx.x==0){ *slot=nxt; nxt=atomicAdd(T.qctr,1u); }
    asm volatile("s_waitcnt lgkmcnt(0)\n\ts_barrier":::"memory");
    const unsigned u=(unsigned)__builtin_amdgcn_readfirstlane((int)*slot);
    if(u>=4096u)break;
    const int qb=31-(int)(u&31u),cr=(int)(u>>5),h=7-(cr>>4),b=(cr>>2)&3,c=(cr>>1)&1,vh=cr&1;
    const float* nq=T.NORM+((0*8+h)*2+c)*2; const float* nk=T.NORM+((1*8+h)*2+c)*2;
    const float q2=__hip_atomic_load(nq,__ATOMIC_RELAXED,__HIP_MEMORY_SCOPE_AGENT)+__hip_atomic_load(nq+1,__ATOMIC_RELAXED,__HIP_MEMORY_SCOPE_AGENT);
    const float k2=__hip_atomic_load(nk,__ATOMIC_RELAXED,__HIP_MEMORY_SCOPE_AGENT)+__hip_atomic_load(nk+1,__ATOMIC_RELAXED,__HIP_MEMORY_SCOPE_AGENT);
    const float S=1.02f*sqrtf(q2*k2);
    const float s2=__builtin_amdgcn_exp2f(-(float)(h+1))*1.4426950408889634f;
    const float Dd=(150.f+2.f*S)/s2;
    const int q0=64+qb*QB, NTfull=(q0+QB)/KVBLK;
    int t0=0; { const float lim=(float)(q0-63)-Dd; if(lim>=0.f){ t0=(int)(lim*(1.f/64.f))+1; } }
    t0&=~1; if(t0>NTfull-5)t0=(NTfull-5)&~1; if(t0<0)t0=0;
    t0=__builtin_amdgcn_readfirstlane(t0);
    attn_unit<THRL>(b,h,c,vh,qb,t0,T.Q,T.K,T.V,T.O,lds);
  }
}
#undef SBAR
#undef WAIT_BAR
}
namespace ssd {
typedef unsigned short bf16_t;
typedef short bf16x8 __attribute__((ext_vector_type(8)));
typedef float f32x4 __attribute__((ext_vector_type(4)));
typedef unsigned u32x4 __attribute__((ext_vector_type(4)));
typedef unsigned u32x2 __attribute__((ext_vector_type(2)));
#define SLAS __attribute__((address_space(3)))
constexpr int LP = 8320, NCH = 65, LDA = 136;
constexpr int OFF_A = 0, OFF_B = 34816, OFF_X = 69632, OFF_P = 87040, OFF_F = 104448;
struct Params { const bf16_t* XBC; const float* DT; const float* conv_w; const float* conv_b; const float* dt_bias; const float* a_log; const float* d_skip; bf16_t* ST; float* CDEC; bf16_t* Y;
    bf16_t* XT; bf16_t* BT; bf16_t* BM; bf16_t* CM; float* DTA; };
typedef float f32x2_t __attribute__((ext_vector_type(2))); typedef __bf16 bf16x2_t __attribute__((ext_vector_type(2)));
__device__ __forceinline__ unsigned cvtpk(float lo, float hi) { f32x2_t v = {lo, hi}; bf16x2_t b = __builtin_convertvector(v, bf16x2_t); return __builtin_bit_cast(unsigned, b); }
__device__ __forceinline__ float bflo(unsigned w) { return __uint_as_float(w << 16); }
__device__ __forceinline__ float bfhi(unsigned w) { return __uint_as_float(w & 0xffff0000u); }

__device__ __forceinline__ void conv_item(const Params& P, int b, int c, int oct, int strip) {
    const int ch = oct * 8, l0 = strip * 8;
    float w[8][4], bias[8], x[11][8];
#pragma unroll
    for (int j = 0; j < 8; ++j) { const f32x4 t = *(const f32x4*)(P.conv_w + (size_t)(ch + j) * 4); w[j][0] = t[0]; w[j][1] = t[1]; w[j][2] = t[2]; w[j][3] = t[3]; }
    { const f32x4 t0 = *(const f32x4*)(P.conv_b + ch), t1 = *(const f32x4*)(P.conv_b + ch + 4); bias[0] = t0[0]; bias[1] = t0[1]; bias[2] = t0[2]; bias[3] = t0[3]; bias[4] = t1[0]; bias[5] = t1[1]; bias[6] = t1[2]; bias[7] = t1[3]; }
    const long prow0 = (long)b * LP + c * 128 + l0 - 3;
#pragma unroll
    for (int i = 0; i < 11; ++i) { const u32x4 raw = *(const u32x4*)(P.XBC + (prow0 + i) * 1536 + ch);
        x[i][0] = bflo(raw.x); x[i][1] = bfhi(raw.x); x[i][2] = bflo(raw.y); x[i][3] = bfhi(raw.y); x[i][4] = bflo(raw.z); x[i][5] = bfhi(raw.z); x[i][6] = bflo(raw.w); x[i][7] = bfhi(raw.w); }
#define CV(rr, j) ({ const float v_ = bias[j] + w[j][0] * x[rr][j] + w[j][1] * x[rr + 1][j] + w[j][2] * x[rr + 2][j] + w[j][3] * x[rr + 3][j]; v_ * __builtin_amdgcn_rcpf(1.f + __expf(-v_)); })
#define CV_T(dst) { _Pragma("unroll") for (int j = 0; j < 8; ++j) { u32x4 wv; wv.x = cvtpk(CV(0, j), CV(1, j)); wv.y = cvtpk(CV(2, j), CV(3, j)); wv.z = cvtpk(CV(4, j), CV(5, j)); wv.w = cvtpk(CV(6, j), CV(7, j)); *(u32x4*)((dst) + j * 128) = wv; } }
#define CV_R(dst) { _Pragma("unroll") for (int rr = 0; rr < 8; ++rr) { u32x4 wv; wv.x = cvtpk(CV(rr, 0), CV(rr, 1)); wv.y = cvtpk(CV(rr, 2), CV(rr, 3)); wv.z = cvtpk(CV(rr, 4), CV(rr, 5)); wv.w = cvtpk(CV(rr, 6), CV(rr, 7)); *(u32x4*)((dst) + rr * 128) = wv; } }
    const size_t bc = (size_t)b * NCH + c;
    if (oct < 128) {
        bf16_t* dst = P.XT + (bc * 16 + (oct >> 3)) * 8192 + (size_t)((oct & 7) * 8) * 128 + l0;
        CV_T(dst)
    } else {
        const int bcsel = (oct - 128) >> 5, g = ((oct - 128) >> 4) & 1, n0 = ((oct - 128) & 15) * 8;
        bf16_t* rm = (bcsel ? P.CM : P.BM) + (bc * 2 + g) * 16384 + (size_t)l0 * 128 + n0;
        CV_R(rm)
        if (bcsel == 0) { bf16_t* dst = P.BT + (bc * 2 + g) * 16384 + (size_t)n0 * 128 + l0; CV_T(dst) }
    }
#undef CV
#undef CV_T
#undef CV_R
}
__device__ __forceinline__ void dta_item(const Params& P, int u, int lane) {
    const int b = u / (NCH * 16), c = (u / 16) % NCH, h = u % 16;
    const long prow = (long)b * LP + c * 128 + 2 * lane;
    const float bias = P.dt_bias[h], a = -__expf(P.a_log[h]);
    float d0 = P.DT[prow * 16 + h] + bias, d1 = P.DT[(prow + 1) * 16 + h] + bias;
    d0 = d0 > 20.f ? d0 : log1pf(__expf(d0)); d1 = d1 > 20.f ? d1 : log1pf(__expf(d1));
    const int i0 = c * 128 + 2 * lane;
    if (i0 < 112) d0 = 0.f;
    if (i0 + 1 < 112) d1 = 0.f;
    const float a0 = d0 * a, a1 = d1 * a; float s = a0 + a1;
#pragma unroll
    for (int o = 1; o < 64; o <<= 1) { const float t = __shfl_up(s, o); if (lane >= o) s += t; }
    const float excl = s - (a0 + a1);
    float* D = P.DTA + (size_t)u * 256;
    *(f32x2_t*)(D + 2 * lane) = (f32x2_t){d0, d1}; *(f32x2_t*)(D + 128 + 2 * lane) = (f32x2_t){excl + a0, s};
    if (lane == 63) P.CDEC[u] = __expf(s);
}
__device__ __forceinline__ void conv_phase(const Params& P, int gw, int NGW, int lane) {
    for (int it = gw; it < 4 * NCH * 48; it += NGW) { const int bc = it / 48, oq = it % 48; conv_item(P, bc / NCH, bc % NCH, oq * 4 + (lane >> 4), lane & 15); }
    for (int u = gw; u < 4 * NCH * 16; u += NGW) dta_item(P, u, lane);
}
#define SSD_FRAG(base, row, k) (*(const SLAS bf16x8*)((base) + (row) * LDA + (k) * 32 + q * 8))
struct ARegs { u32x4 xv[2], bv[4]; f32x4 dtv[2][2], acv[2][2]; float ae; };
__device__ __forceinline__ void passA_load(ARegs& R, const Params& P, int u, int tid) {
    const int h = u & 15, g = h >> 3; const size_t bc = (size_t)(u >> 4), uh = (size_t)u;
    const bf16_t* gX = P.XT + uh * 8192; const bf16_t* gB = P.BT + (bc * 2 + g) * 16384; const float* D = P.DTA + uh * 256;
#pragma unroll
    for (int i = 0; i < 2; ++i) { const int pc = tid + i * 512; R.xv[i] = *(const u32x4*)(gX + pc * 8); const int l0 = (pc & 15) * 8;
        R.dtv[i][0] = *(const f32x4*)(D + l0); R.dtv[i][1] = *(const f32x4*)(D + l0 + 4); R.acv[i][0] = *(const f32x4*)(D + 128 + l0); R.acv[i][1] = *(const f32x4*)(D + 128 + l0 + 4); }
#pragma unroll
    for (int i = 0; i < 4; ++i) R.bv[i] = *(const u32x4*)(gB + (tid + i * 512) * 8);
    R.ae = D[255];
}
__device__ __forceinline__ void passA_phase(SLAS unsigned char* lds, const Params& P, int first, int stride, int nunits) {
    int tid_ = threadIdx.x; asm volatile("" : "+v"(tid_));
    const int tid = tid_, lane = tid & 63, wid = tid >> 6, r = lane & 15, q = lane >> 4;
    SLAS bf16_t* XT = (SLAS bf16_t*)(lds + OFF_X); SLAS bf16_t* BT = (SLAS bf16_t*)(lds + OFF_A);
    int u = first; if (u >= nunits) return;
    ARegs R; passA_load(R, P, u, tid);
    for (;;) {
#pragma unroll
        for (int i = 0; i < 2; ++i) { const int pc = tid + i * 512, p = pc >> 4, l0 = (pc & 15) * 8; float wg[8];
#pragma unroll
            for (int e = 0; e < 4; ++e) { wg[e] = R.dtv[i][0][e] * __expf(R.ae - R.acv[i][0][e]); wg[4 + e] = R.dtv[i][1][e] * __expf(R.ae - R.acv[i][1][e]); }
            u32x4 wv; wv.x = cvtpk(bflo(R.xv[i].x) * wg[0], bfhi(R.xv[i].x) * wg[1]); wv.y = cvtpk(bflo(R.xv[i].y) * wg[2], bfhi(R.xv[i].y) * wg[3]);
            wv.z = cvtpk(bflo(R.xv[i].z) * wg[4], bfhi(R.xv[i].z) * wg[5]); wv.w = cvtpk(bflo(R.xv[i].w) * wg[6], bfhi(R.xv[i].w) * wg[7]);
            *(SLAS u32x4*)(XT + p * LDA + l0) = wv; }
#pragma unroll
        for (int i = 0; i < 4; ++i) { const int pc = tid + i * 512; *(SLAS u32x4*)(BT + (pc >> 4) * LDA + (pc & 15) * 8) = R.bv[i]; }
        __syncthreads();
        const int un = u + stride;
        if (un < nunits) passA_load(R, P, un, tid);
        f32x4 acc[4];
#pragma unroll
        for (int pt = 0; pt < 4; ++pt) acc[pt] = (f32x4){0.f, 0.f, 0.f, 0.f};
#pragma unroll
        for (int k = 0; k < 4; ++k) { const bf16x8 bfr = SSD_FRAG(BT, wid * 16 + r, k);
#pragma unroll
            for (int pt = 0; pt < 4; ++pt) acc[pt] = __builtin_amdgcn_mfma_f32_16x16x32_bf16(bfr, SSD_FRAG(XT, pt * 16 + r, k), acc[pt], 0, 0, 0); }
        bf16_t* S = P.ST + (size_t)u * 8192;
#pragma unroll
        for (int pt = 0; pt < 4; ++pt) { u32x2 wv; wv.x = cvtpk(acc[pt][0], acc[pt][1]); wv.y = cvtpk(acc[pt][2], acc[pt][3]); *(u32x2*)(S + (pt * 16 + r) * 128 + wid * 16 + 4 * q) = wv; }
        __syncthreads();
        if (un >= nunits) break;
        u = un;
    }
}
struct CRegs { u32x4 xv[2], sv[2], bv[4], cv[4]; f32x4 fv; };
__device__ __forceinline__ void passC_load(CRegs& R, const Params& P, int u, int tid) {
    const int h = u & 15, g = h >> 3; const size_t bc = (size_t)(u >> 4), uh = (size_t)u;
    const bf16_t* gX = P.XT + uh * 8192; const bf16_t* gB = P.BM + (bc * 2 + g) * 16384; const bf16_t* gC = P.CM + (bc * 2 + g) * 16384; const bf16_t* gS = P.ST + uh * 8192; const float* D = P.DTA + uh * 256;
#pragma unroll
    for (int i = 0; i < 2; ++i) { R.xv[i] = *(const u32x4*)(gX + (tid + i * 512) * 8); R.sv[i] = *(const u32x4*)(gS + (tid + i * 512) * 8); }
#pragma unroll
    for (int i = 0; i < 4; ++i) { R.bv[i] = *(const u32x4*)(gB + (tid + i * 512) * 8); R.cv[i] = *(const u32x4*)(gC + (tid + i * 512) * 8); }
    R.fv = *(const f32x4*)(D + (tid & 63) * 4);
}
__device__ __forceinline__ void passC_phase(SLAS unsigned char* lds, const Params& P, int first, int stride, int nunits) {
    int tid_ = threadIdx.x; asm volatile("" : "+v"(tid_));
    const int tid = tid_, lane = tid & 63, wid = tid >> 6, r = lane & 15, q = lane >> 4;
    SLAS float* F = (SLAS float*)(lds + OFF_F);
    SLAS bf16_t* CM = (SLAS bf16_t*)(lds + OFF_A); SLAS bf16_t* BM = (SLAS bf16_t*)(lds + OFF_B); SLAS bf16_t* XT = (SLAS bf16_t*)(lds + OFF_X); SLAS bf16_t* PV = (SLAS bf16_t*)(lds + OFF_P);
    int u = first; if (u >= nunits) return;
    CRegs R; passC_load(R, P, u, tid);
    for (;;) {
        const int h = u & 15, c = (u >> 4) % NCH, b = (u >> 4) / NCH;
#pragma unroll
        for (int i = 0; i < 2; ++i) { const int pc = tid + i * 512; *(SLAS u32x4*)(XT + (pc >> 4) * LDA + (pc & 15) * 8) = R.xv[i]; *(SLAS u32x4*)(PV + (pc >> 4) * LDA + (pc & 15) * 8) = R.sv[i]; }
#pragma unroll
        for (int i = 0; i < 4; ++i) { const int pc = tid + i * 512; *(SLAS u32x4*)(BM + (pc >> 4) * LDA + (pc & 15) * 8) = R.bv[i]; *(SLAS u32x4*)(CM + (pc >> 4) * LDA + (pc & 15) * 8) = R.cv[i]; }
        if (tid < 64) *(SLAS f32x4*)(F + tid * 4) = R.fv;
        __syncthreads();
        const int un = u + stride;
        if (un < nunits) passC_load(R, P, un, tid);
        f32x4 sacc[8];
#pragma unroll
        for (int st = 0; st < 8; ++st) sacc[st] = (f32x4){0.f, 0.f, 0.f, 0.f};
#pragma unroll
        for (int k = 0; k < 4; ++k) { const bf16x8 afr = SSD_FRAG(CM, wid * 16 + r, k);
#pragma unroll
            for (int st = 0; st < 8; ++st) sacc[st] = __builtin_amdgcn_mfma_f32_16x16x32_bf16(SSD_FRAG(BM, st * 16 + r, k), afr, sacc[st], 0, 0, 0); }
        __syncthreads();
        const int l = wid * 16 + r; const float al = F[128 + l], Dh = P.d_skip[h];
#pragma unroll
        for (int st = 0; st < 8; ++st) { const int s0 = st * 16 + 4 * q; float gv[4];
#pragma unroll
            for (int j = 0; j < 4; ++j) { const int s = s0 + j; float v = 0.f; if (s <= l) v = sacc[st][j] * __expf(al - F[128 + s]) * F[s]; if (s == l) v += Dh; gv[j] = v; }
            u32x2 wv; wv.x = cvtpk(gv[0], gv[1]); wv.y = cvtpk(gv[2], gv[3]); *(SLAS u32x2*)(BM + l * LDA + s0) = wv; }
        __syncthreads();
        f32x4 yacc[4];
#pragma unroll
        for (int pt = 0; pt < 4; ++pt) yacc[pt] = (f32x4){0.f, 0.f, 0.f, 0.f};
#pragma unroll
        for (int k = 0; k < 4; ++k) { const bf16x8 afr = SSD_FRAG(CM, wid * 16 + r, k);
#pragma unroll
            for (int pt = 0; pt < 4; ++pt) yacc[pt] = __builtin_amdgcn_mfma_f32_16x16x32_bf16(SSD_FRAG(PV, pt * 16 + r, k), afr, yacc[pt], 0, 0, 0); }
        { const float el = __expf(al);
#pragma unroll
            for (int pt = 0; pt < 4; ++pt) yacc[pt] = yacc[pt] * el; }
#pragma unroll
        for (int k = 0; k < 4; ++k) { const bf16x8 afr = SSD_FRAG(BM, wid * 16 + r, k);
#pragma unroll
            for (int pt = 0; pt < 4; ++pt) yacc[pt] = __builtin_amdgcn_mfma_f32_16x16x32_bf16(SSD_FRAG(XT, pt * 16 + r, k), afr, yacc[pt], 0, 0, 0); }
        bf16_t* yrow = P.Y + ((size_t)b * LP + c * 128 + l) * 1024 + h * 64 + 4 * q;
#pragma unroll
        for (int pt = 0; pt < 4; ++pt) { u32x2 wv; wv.x = cvtpk(yacc[pt][0], yacc[pt][1]); wv.y = cvtpk(yacc[pt][2], yacc[pt][3]); *(u32x2*)(yrow + pt * 16) = wv; }
        __syncthreads();
        if (un >= nunits) break;
        u = un;
    }
}
#undef SSD_FRAG
__device__ __forceinline__ void scan_phase(const Params& P, int gtid, int nthreads) {
    for (int qd = gtid; qd < 4 * 32768; qd += nthreads) {
        const int b = qd >> 15, e = (qd & 32767) * 4, h = e >> 13;
        bf16_t* base = P.ST + (size_t)b * NCH * 131072 + e; const float* cd = P.CDEC + b * NCH * 16 + h;
        float s0 = 0.f, s1 = 0.f, s2 = 0.f, s3 = 0.f;
        for (int c0 = 0; c0 < NCH; c0 += 13) {
            u32x2 v[13]; float d[13];
#pragma unroll
            for (int i = 0; i < 13; ++i) { v[i] = *(const u32x2*)(base + (size_t)(c0 + i) * 131072); d[i] = cd[(c0 + i) * 16]; }
#pragma unroll
            for (int i = 0; i < 13; ++i) { u32x2 o; o.x = cvtpk(s0, s1); o.y = cvtpk(s2, s3); *(u32x2*)(base + (size_t)(c0 + i) * 131072) = o;
                s0 = s0 * d[i] + __uint_as_float(v[i].x << 16); s1 = s1 * d[i] + __uint_as_float(v[i].x & 0xffff0000u);
                s2 = s2 * d[i] + __uint_as_float(v[i].y << 16); s3 = s3 * d[i] + __uint_as_float(v[i].y & 0xffff0000u); }
        }
    }
}
}

namespace cg = cooperative_groups;
#define GAS __attribute__((address_space(1)))
#define LAS __attribute__((address_space(3)))
typedef unsigned short bf16;
typedef unsigned v4u __attribute__((ext_vector_type(4)));
typedef float f32x4 __attribute__((ext_vector_type(4)));
constexpr int NWAVES = 8;
constexpr int NB = 4, SEQ = 8192, LP = 8320, MP = NB * LP, MC = NB * SEQ, DMODEL = 1024, DFF = 2816;
constexpr float EPS = 1e-6f;
constexpr size_t MiB = 1u << 20, S1 = 65 * MiB;
constexpr size_t WS_WIN = 0, WS_WZG = 10 * MiB, WS_WSSD = 16 * MiB, WS_WATT = 18 * MiB, WS_WOUT = 20 * MiB, WS_WGU = 22 * MiB, WS_WDN = 33 * MiB;
constexpr size_t WS_DT = 39 * MiB, WS_DTA = 0  , WS_CDEC = 42 * MiB, WS_SSQ = 42 * MiB + 65536, WS_SSQ2 = 42 * MiB + 262144;
constexpr size_t WS_R5 = 44 * MiB, WS_R0 = WS_R5 + S1, WS_R1 = WS_R0 + S1, WS_R2 = WS_R1 + S1, WS_R3 = WS_R2 + S1, WS_R4 = WS_R3 + S1, WS_END = WS_R4 + 2 * S1;
static_assert(WS_END <= 512 * MiB, "d_ws map fits the guaranteed 512 MiB");
constexpr int LDS_BYTES = 147456;
#ifndef PHASES
#define PHASES 0xFFFF
#endif
#ifndef DUP
#define DUP 0
#endif

__device__ __forceinline__ unsigned f2bf(float f) { unsigned u = __builtin_bit_cast(unsigned, f); return (u + 0x7fffu + ((u >> 16) & 1u)) >> 16; }
__device__ __forceinline__ unsigned pk2(float lo, float hi) { return f2bf(lo) | (f2bf(hi) << 16); }
__device__ __forceinline__ float wave_sum(float v) {
#pragma unroll
    for (int o = 1; o < 64; o <<= 1) v += __shfl_xor(v, o);
    return v;
}
__device__ __forceinline__ float blo(unsigned w) { return __uint_as_float(w << 16); }
__device__ __forceinline__ float bhi(unsigned w) { return __uint_as_float(w & 0xffff0000u); }

__device__ __forceinline__ void tr_item(const float* W, int K, int Npitch, int nsrc, int nvalid, bf16* WT, int drow, const float* kscale, int kb, LAS float* scr, int lane) {
    const int k0 = 64 * kb, n4 = (lane & 7) * 4;
#pragma unroll
    for (int i = 0; i < 8; ++i) { const int kk = 8 * i + (lane >> 3); f32x4 v = (f32x4){0.f, 0.f, 0.f, 0.f};
        if (n4 < nvalid) v = __builtin_nontemporal_load((const f32x4*)(W + (size_t)(k0 + kk) * Npitch + nsrc + n4));
        if (kscale) v = v * kscale[k0 + kk];
        scr[kk * 33 + n4] = v.x; scr[kk * 33 + n4 + 1] = v.y; scr[kk * 33 + n4 + 2] = v.z; scr[kk * 33 + n4 + 3] = v.w; }
    asm volatile("s_waitcnt lgkmcnt(0)" ::: "memory");
    const int c = lane & 7;
#pragma unroll
    for (int jj = 0; jj < 4; ++jj) { const int n = (lane >> 3) + 8 * jj; const LAS float* s = scr + (8 * c) * 33 + n;
        v4u o; o.x = pk2(s[0 * 33], s[1 * 33]); o.y = pk2(s[2 * 33], s[3 * 33]); o.z = pk2(s[4 * 33], s[5 * 33]); o.w = pk2(s[6 * 33], s[7 * 33]);
        *(v4u*)(WT + (size_t)(drow + n) * K + k0 + 8 * c) = o; }
    asm volatile("s_waitcnt lgkmcnt(0)" ::: "memory");
}
template <int NR> __device__ __forceinline__ void u_rows(const float* x, const float* meta, const float* g, bf16* U, int m0, int stride, int lane) {
    f32x4 v[NR][4]; bool live[NR], inr[NR];
#pragma unroll
    for (int k = 0; k < NR; ++k) { const int prow = m0 + k * stride; inr[k] = prow < MP; const int pr = inr[k] ? prow : 0; const int b = pr / LP, i = pr - b * LP; live[k] = inr[k] && i >= 112;
        const f32x4* src = (const f32x4*)(i < 128 ? meta + (size_t)(i < 112 ? 0 : i - 112) * 1024 : x + ((size_t)b * SEQ + (i - 128)) * 1024) + lane;
#pragma unroll
        for (int j = 0; j < 4; ++j) v[k][j] = __builtin_nontemporal_load(src + 64 * j); }
    f32x4 gg[4];
#pragma unroll
    for (int j = 0; j < 4; ++j) gg[j] = ((const f32x4*)g)[lane + 64 * j];
#pragma unroll
    for (int k = 0; k < NR; ++k) { if (!inr[k]) continue;
        unsigned long long* o8 = (unsigned long long*)(U + (size_t)(m0 + k * stride) * 1024) + lane; float s = 0.f;
#pragma unroll
        for (int j = 0; j < 4; ++j) s += (v[k][j].x * v[k][j].x + v[k][j].y * v[k][j].y) + (v[k][j].z * v[k][j].z + v[k][j].w * v[k][j].w);
        const float rstd = live[k] ? rsqrtf(wave_sum(s) * (1.f / 1024.f) + EPS) : 0.f;
#pragma unroll
        for (int j = 0; j < 4; ++j) o8[64 * j] = (unsigned long long)pk2(v[k][j].x * rstd * gg[j].x, v[k][j].y * rstd * gg[j].y) | ((unsigned long long)pk2(v[k][j].z * rstd * gg[j].z, v[k][j].w * rstd * gg[j].w) << 32); }
}
template <int NR> __device__ __forceinline__ void combine_rows(const bf16* O, bf16* YATT, const float* subln_g, float lam, int r0, int stride, int lane) {
    v4u A0[NR], A1[NR], C0[NR], C1[NR];
#pragma unroll
    for (int k = 0; k < NR; ++k) { const int r = r0 + k * stride; const int rr = r < MC ? r : 0; const int b = rr >> 13, t = rr & 8191; const size_t prow = (size_t)b * LP + 128 + t;
        const v4u* p1 = (const v4u*)(O + prow * 2048 + 16 * lane); const v4u* p2 = (const v4u*)(O + prow * 2048 + 1024 + 16 * lane);
        A0[k] = __builtin_nontemporal_load(p1); A1[k] = __builtin_nontemporal_load(p1 + 1); C0[k] = __builtin_nontemporal_load(p2); C1[k] = __builtin_nontemporal_load(p2 + 1); }
    float gpv[16];
    { const f32x4* gp4 = (const f32x4*)(subln_g + 16 * (lane & 7));
#pragma unroll
      for (int i = 0; i < 4; ++i) { const f32x4 t = gp4[i]; gpv[4 * i] = t.x; gpv[4 * i + 1] = t.y; gpv[4 * i + 2] = t.z; gpv[4 * i + 3] = t.w; } }
#pragma unroll
    for (int k = 0; k < NR; ++k) { const int r = r0 + k * stride; if (r >= MC) continue;
        const v4u a0 = A0[k], a1 = A1[k], c0 = C0[k], c1 = C1[k];
        float a[16];
        a[0] = blo(a0.x) - lam * blo(c0.x); a[1] = bhi(a0.x) - lam * bhi(c0.x); a[2] = blo(a0.y) - lam * blo(c0.y); a[3] = bhi(a0.y) - lam * bhi(c0.y);
        a[4] = blo(a0.z) - lam * blo(c0.z); a[5] = bhi(a0.z) - lam * bhi(c0.z); a[6] = blo(a0.w) - lam * blo(c0.w); a[7] = bhi(a0.w) - lam * bhi(c0.w);
        a[8] = blo(a1.x) - lam * blo(c1.x); a[9] = bhi(a1.x) - lam * bhi(c1.x); a[10] = blo(a1.y) - lam * blo(c1.y); a[11] = bhi(a1.y) - lam * bhi(c1.y);
        a[12] = blo(a1.z) - lam * blo(c1.z); a[13] = bhi(a1.z) - lam * bhi(c1.z); a[14] = blo(a1.w) - lam * blo(c1.w); a[15] = bhi(a1.w) - lam * bhi(c1.w);
        float ss = 0.f;
#pragma unroll
        for (int i = 0; i < 16; ++i) ss += a[i] * a[i];
        ss += __shfl_xor(ss, 1); ss += __shfl_xor(ss, 2); ss += __shfl_xor(ss, 4);
        const float rs = rsqrtf(ss * (1.f / 128.f) + EPS) * 0.8f;
        v4u o0, o1;
        o0.x = pk2(a[0] * rs * gpv[0], a[1] * rs * gpv[1]); o0.y = pk2(a[2] * rs * gpv[2], a[3] * rs * gpv[3]); o0.z = pk2(a[4] * rs * gpv[4], a[5] * rs * gpv[5]); o0.w = pk2(a[6] * rs * gpv[6], a[7] * rs * gpv[7]);
        o1.x = pk2(a[8] * rs * gpv[8], a[9] * rs * gpv[9]); o1.y = pk2(a[10] * rs * gpv[10], a[11] * rs * gpv[11]); o1.z = pk2(a[12] * rs * gpv[12], a[13] * rs * gpv[13]); o1.w = pk2(a[14] * rs * gpv[14], a[15] * rs * gpv[15]);
        v4u* q = (v4u*)(YATT + (size_t)r * 1024 + 16 * lane); q[0] = o0; q[1] = o1; }
}

#define XB_TMO      128
#define XB_XCNT(j)  (256  + 64 * (j))
#define XB_XSUB(j)  (1280 + 64 * (j))
#define XB_XGEN(j)  (2304 + 64 * (j))
#define XB_TOP      3328
#define XB_TOPGEN   3392
#define XCD_BAR_WORDS 3456
#define XB_SPIN_CAP (1u << 18)

__device__ __forceinline__ unsigned xb_ld(unsigned* p)              { return __hip_atomic_load(p, __ATOMIC_RELAXED, __HIP_MEMORY_SCOPE_AGENT); }
__device__ __forceinline__ unsigned xb_add(unsigned* p, unsigned v) { return __hip_atomic_fetch_add(p, v, __ATOMIC_RELAXED, __HIP_MEMORY_SCOPE_AGENT); }
__device__ __forceinline__ unsigned xb_xcc_id() { return (unsigned)__builtin_amdgcn_s_getreg((3 << 11) | 20) & 0xFu; }
#define XB_SPIN(cond, bar) do { unsigned _sp = 0; while (cond) { __builtin_amdgcn_s_sleep(1); \
    if ((++_sp & 255u) == 0u) { if (xb_ld(&(bar)[XB_TMO])) break; if (_sp > XB_SPIN_CAP) { atomicAdd(&(bar)[XB_TMO], 1u); break; } } } } while (0)

struct XcdBarrier {
    unsigned* bar; unsigned x;
    volatile LAS unsigned* st;
};

__device__ __forceinline__ XcdBarrier xcd_barrier_post(unsigned* bar, volatile LAS unsigned* st) {
    XcdBarrier b; b.bar = bar; b.x = xb_xcc_id(); b.st = st;
    if (threadIdx.x == 0) (void)xb_add(&bar[XB_XCNT(b.x)], 1u);
    return b;
}
__device__ __forceinline__ void xcd_barrier_complete(unsigned* bar, unsigned x, unsigned& nloc, unsigned& nx) {
    const unsigned G = gridDim.x * gridDim.y * gridDim.z;
    unsigned sum, cnt, mine, sp = 0u;
    for (;;) {
        sum = 0u; cnt = 0u; mine = 0u;
#pragma unroll
        for (unsigned j = 0; j < 16; ++j) { const unsigned c = xb_ld(&bar[XB_XCNT(j)]); sum += c; cnt += (c > 0u) ? 1u : 0u; mine = (j == x) ? c : mine; }
        if (sum == G) break;
        __builtin_amdgcn_s_sleep(1);
        if ((++sp & 255u) == 0u) { if (xb_ld(&bar[XB_TMO])) break; if (sp > XB_SPIN_CAP) { atomicAdd(&bar[XB_TMO], 1u); break; } }
    }
    nloc = mine > 0u ? mine : 1u; nx = cnt > 0u ? cnt : 1u;
}

__device__ __forceinline__ void xcd_barrier(const XcdBarrier& b) {
    asm volatile("s_waitcnt vmcnt(0)" ::: "memory");
    __syncthreads();
    if (threadIdx.x == 0) {
        unsigned* bar = b.bar;
        __builtin_amdgcn_s_waitcnt(0);
        unsigned nloc = b.st[0], nx = b.st[1];
        if (nloc == 0u) { xcd_barrier_complete(bar, b.x, nloc, nx); b.st[0] = nloc; b.st[1] = nx; }
        const unsigned old = xb_add(&bar[XB_XSUB(b.x)], 1u);
        const unsigned gen = old / nloc;
        if (old + 1u == (gen + 1u) * nloc) {
            __builtin_amdgcn_fence(__ATOMIC_RELEASE, "agent");
            asm volatile("s_waitcnt vmcnt(0)" ::: "memory");
            const unsigned og = xb_add(&bar[XB_TOP], 1u);
            const unsigned tg = og / nx;
            if (og + 1u == (tg + 1u) * nx) xb_add(&bar[XB_TOPGEN], 1u);
            else XB_SPIN(xb_ld(&bar[XB_TOPGEN]) == tg, bar);
            __builtin_amdgcn_fence(__ATOMIC_ACQUIRE, "agent");
            xb_add(&bar[XB_XGEN(b.x)], 1u);
            asm volatile("s_waitcnt vmcnt(0)" ::: "memory");
        } else {
            XB_SPIN(xb_ld(&bar[XB_XGEN(b.x)]) == gen, bar);
            __builtin_amdgcn_fence(__ATOMIC_ACQUIRE, "agent");
            asm volatile("s_waitcnt vmcnt(0)" ::: "memory");
        }
    }
    __syncthreads();
}
constexpr size_t WS_CTL = 43 * MiB, CTL_BYTES = 65536;
constexpr int LDSCTL_OFF = 131072;

struct Args { const float* in[24]; float* out; unsigned char* ws; };
enum { I_X = 0, I_META, I_NMIXG, I_WIN, I_GBIAS, I_CONVW, I_CONVB, I_DTBIAS, I_ALOG, I_DSKIP, I_SSDG, I_LQ1, I_LK1, I_LQ2, I_LK2, I_SUBLNG, I_WSSD, I_WATT, I_WOUT, I_NFFNG, I_WGATE, I_WUP, I_WDOWN, I_NFING };

__global__ void __launch_bounds__(NWAVES * 64, 2) mega_fwd(Args args) {
    extern __shared__ __attribute__((aligned(16))) unsigned char lds[];
    cg::grid_group grid = cg::this_grid();
    { LAS unsigned* z = (LAS unsigned*)(lds + 0) ; (void)z; }
    for (int u = threadIdx.x; u < 64; u += NWAVES * 64) ((LAS unsigned*)((LAS unsigned char*)lds + LDSCTL_OFF))[u] = 0u;
    __syncthreads();
    XcdBarrier xbar = xcd_barrier_post((unsigned*)(args.ws + WS_CTL), (volatile LAS unsigned*)((LAS unsigned char*)lds + LDSCTL_OFF) + 8);
    grid.sync();
    LAS unsigned char* L = (LAS unsigned char*)lds;
    const int G = gridDim.x, bx = blockIdx.x, vcu = (G % 8 == 0) ? (bx % 8) * (G / 8) + bx / 8 : bx;
    const int NGW = G * NWAVES;
#define PHASE_PTRS() \
    const __attribute__((address_space(4))) Args* A_ = (const __attribute__((address_space(4))) Args*)__builtin_amdgcn_kernarg_segment_ptr(); asm volatile("" : "+s"(A_)); \
    unsigned char* ws = A_->ws; (void)ws; \
    int tid_o = threadIdx.x; asm volatile("" : "+v"(tid_o)); const int lane = tid_o & 63, wave = __builtin_amdgcn_readfirstlane(tid_o >> 6), gw = vcu * NWAVES + wave; (void)lane; (void)gw; \
    bf16 *Win_t = (bf16*)(ws + WS_WIN), *Wzg_t = (bf16*)(ws + WS_WZG), *Wssd_t = (bf16*)(ws + WS_WSSD), *Watt_t = (bf16*)(ws + WS_WATT), *Wout_t = (bf16*)(ws + WS_WOUT), *Wgu_t = (bf16*)(ws + WS_WGU), *Wdn_t = (bf16*)(ws + WS_WDN); \
    float *DT = (float*)(ws + WS_DT), *CDEC = (float*)(ws + WS_CDEC), *SSQ = (float*)(ws + WS_SSQ), *SSQ2 = (float*)(ws + WS_SSQ2), *SSQ3 = (float*)(ws + WS_SSQ2 + 131072); (void)SSQ3; \
    bf16 *R5 = (bf16*)(ws + WS_R5), *R0 = (bf16*)(ws + WS_R0), *R1 = (bf16*)(ws + WS_R1), *R2 = (bf16*)(ws + WS_R2), *R3 = (bf16*)(ws + WS_R3), *R4 = (bf16*)(ws + WS_R4); \
    const float* x = A_->in[I_X]; float* outp = A_->out; \
    (void)Win_t; (void)Wzg_t; (void)Wssd_t; (void)Watt_t; (void)Wout_t; (void)Wgu_t; (void)Wdn_t; (void)DT; (void)CDEC; (void)SSQ; (void)SSQ2; (void)R5; (void)R0; (void)R1; (void)R2; (void)R3; (void)R4; (void)x; (void)outp;
#define GRID_SYNC() xcd_barrier(xbar)

    if constexpr ((PHASES >> 0) & 1) for (int rep0_ = 0; rep0_ < 1 + ((DUP >> 0) & 1); ++rep0_) { PHASE_PTRS();
        LAS float* scr = (LAS float*)(L + wave * 16384);
        const float* w_in = A_->in[I_WIN];
        constexpr int NIN = 7696;
        for (int it = gw; it < 3856; it += NGW) {
            int r = it;
#define SEG(W_, K_, NP_, NS_, NBLK_, NVAL_, WT_, DROW_, KS_, IL_) { const int n_ = ((K_) / 64) * (NBLK_); if (r < n_) { const int kb = r / (NBLK_), blk = r % (NBLK_); \
                tr_item(W_, K_, NP_, (NS_) + 32 * blk, NVAL_, WT_, (IL_) ? (DROW_) + 256 * (blk >> 2) + 32 * (blk & 3) : (DROW_) + 32 * blk, KS_, kb, scr, lane); continue; } r -= n_; }
            SEG(w_in, 1024, NIN, 2576, 32, 32, Win_t, 0, nullptr, 0)
            SEG(w_in, 1024, NIN, 3600, 32, 32, Win_t, 1024, nullptr, 0)
            SEG(w_in, 1024, NIN, 4624, 32, 32, Win_t, 2048, nullptr, 0)
            SEG(w_in, 1024, NIN, 1024, 48, 32, Win_t, 3072, nullptr, 0)
            SEG(w_in, 1024, NIN, 2560, 1, 16, Win_t, 4608, nullptr, 0)
            SEG(w_in, 1024, NIN, 0, 32, 32, Wzg_t, 0, nullptr, 0)
            SEG(w_in, 1024, NIN, 5648, 64, 32, Wzg_t, 1024, nullptr, 0)
        }
        {
            const int gt = gw * 64 + lane, NT = NGW * 64;
            v4u* z = (v4u*)(Win_t + (size_t)4640 * 1024);
            for (int i = gt; i < 224 * 128; i += NT) z[i] = (v4u){0u, 0u, 0u, 0u};
            for (int i = gt; i < MC; i += NT) { SSQ[i] = 0.f; SSQ2[i] = 0.f; SSQ3[i] = 0.f; }
        }
        for (int m = gw; m < MP; m += 4 * NGW) u_rows<4>(x, A_->in[I_META], A_->in[I_NMIXG], (bf16*)outp, m, NGW, lane);
    }
    GRID_SYNC();
    if constexpr ((PHASES >> 1) & 1) { PHASE_PTRS();
        pg8::Gemm g{(const bf16*)outp, Win_t, MP, 4864, 1024, 0}; pg8::StaticOrder S; S.init(MP, 4864, G, bx);
        pg8::EpiProj1 E{R1, R2, R3, R4, DT, (float*)(ws + WS_CTL + 16384)};
        for (int rep_ = 0; rep_ < 1 + ((DUP >> 1) & 1); ++rep_) pg8::gemm_phase<pg8::EpiProj1, pg8::StaticOrder, true, true>(L, g, S, E);
    }
    GRID_SYNC();
    if constexpr ((PHASES >> 2) & 1) { PHASE_PTRS();
        const attn_body::AttnTensors AT{(const attn_body::bf16*)R1, (const attn_body::bf16*)R2, (const attn_body::bf16*)R3, (attn_body::bf16*)R5, (const float*)(ws + WS_CTL + 16384), (unsigned*)(ws + WS_CTL + 32768)};
        attn_body::attn_phase<64>((char*)lds, AT);
        {
            unsigned* wctr = (unsigned*)(ws + WS_CTL + 32768 + 256);
            LAS unsigned* wslot = (LAS unsigned*)(L + 140000);
            LAS float* scr = (LAS float*)(L + wave * 16384);
            for (;;) {
                __syncthreads();
                if (threadIdx.x == 0) *wslot = atomicAdd(wctr, 1u);
                __syncthreads();
                const int it = (int)(*wslot) * NWAVES + wave;
                if ((int)(*wslot) * NWAVES >= 5760) break;
                if (it < 5760) { int r = it; do {
            SEG(A_->in[I_WSSD], 1024, 1024, 0, 32, 32, Wssd_t, 0, A_->in[I_SSDG], 0)
            SEG(A_->in[I_WATT], 1024, 1024, 0, 32, 32, Watt_t, 0, nullptr, 0)
            SEG(A_->in[I_WOUT], 1024, 1024, 0, 32, 32, Wout_t, 0, nullptr, 0)
            SEG(A_->in[I_WGATE], 1024, DFF, 0, 88, 32, Wgu_t, 0, A_->in[I_NFFNG], 1)
            SEG(A_->in[I_WUP], 1024, DFF, 0, 88, 32, Wgu_t, 128, A_->in[I_NFFNG], 1)
            SEG(A_->in[I_WDOWN], DFF, 1024, 0, 32, 32, Wdn_t, 0, nullptr, 0)
                } while (0); }
            }
        }
#undef SEG
    }
    GRID_SYNC();
#define SSD_PARAMS() PHASE_PTRS(); const ssd::Params SP{R4, DT, A_->in[I_CONVW], A_->in[I_CONVB], A_->in[I_DTBIAS], A_->in[I_ALOG], A_->in[I_DSKIP], R3, CDEC, R4, R1, R1 + (size_t)MP * 1024, R1 + (size_t)MP * 1280, R1 + (size_t)MP * 1536, (float*)(ws + WS_DTA)}
    if constexpr ((PHASES >> 3) & 1) { SSD_PARAMS(); for (int rep_ = 0; rep_ < 1 + ((DUP >> 12) & 1); ++rep_) ssd::conv_phase(SP, gw, NGW, lane); }
    GRID_SYNC();
    if constexpr ((PHASES >> 3) & 1) { SSD_PARAMS(); for (int rep_ = 0; rep_ < 1 + ((DUP >> 3) & 1); ++rep_) ssd::passA_phase(L, SP, vcu, G, NB * 65 * 16); }
    GRID_SYNC();
    if constexpr ((PHASES >> 4) & 1) { SSD_PARAMS(); ssd::scan_phase(SP, gw * 64 + lane, NGW * 64); }
    GRID_SYNC();
    if constexpr ((PHASES >> 5) & 1) { SSD_PARAMS(); for (int rep_ = 0; rep_ < 1 + ((DUP >> 5) & 1); ++rep_) ssd::passC_phase(L, SP, vcu, G, NB * 65 * 16);
        const float s1 = wave_sum(A_->in[I_LQ1][lane] * A_->in[I_LK1][lane]), s2 = wave_sum(A_->in[I_LQ2][lane] * A_->in[I_LK2][lane]);
        const float lam = expf(s1) - expf(s2) + 0.2f;
        for (int r = gw; r < MC; r += 4 * NGW) combine_rows<4>(R5, R4 + (size_t)MP * 1024, A_->in[I_SUBLNG], lam, r, NGW, lane);
        }
    GRID_SYNC();
    if constexpr ((PHASES >> 6) & 1) { PHASE_PTRS();
        pg8::Gemm g{(const bf16*)outp, Wzg_t, MC, 3072, 1024, 1}; pg8::StaticOrder S; S.init(MC, 3072, G, bx);
        pg8::EpiZG E{R4, R1, R2, A_->in[I_GBIAS], SSQ3};
        for (int rep_ = 0; rep_ < 1 + ((DUP >> 6) & 1); ++rep_) pg8::gemm_phase<pg8::EpiZG, pg8::StaticOrder, true, true>(L, g, S, E);
    }
    GRID_SYNC();
    if constexpr ((PHASES >> 8) & 1) { PHASE_PTRS();
        pg8::Gemm g{R1, Wssd_t, MC, 1024, 1024, 0, R4 + (size_t)MP * 1024, Watt_t, 0}; pg8::StaticOrder2 S; S.init(MC, 1024, G, bx);
        pg8::EpiBranch E{R2, R4, SSQ3};
        pg8::gemm_phase<pg8::EpiBranch, pg8::StaticOrder2, true, true>(L, g, S, E);
    }
    GRID_SYNC();
    if constexpr ((PHASES >> 9) & 1) { PHASE_PTRS();
        pg8::Gemm g{R4, Wout_t, MC, 1024, 1024, 0}; pg8::StaticOrder S; S.init(MC, 1024, G, bx);
        pg8::EpiWout E{x, outp, R4 + (size_t)MP * 1024, SSQ};
        pg8::gemm_phase<pg8::EpiWout, pg8::StaticOrder, true, true>(L, g, S, E);
    }
    GRID_SYNC();
    if constexpr ((PHASES >> 10) & 1) { PHASE_PTRS();
        pg8::Gemm g{R4 + (size_t)MP * 1024, Wgu_t, MC, 2 * DFF, 1024, 0}; pg8::StaticOrder S; S.init(MC, 2 * DFF, G, bx);
        pg8::EpiGU E{R5, SSQ};
        for (int rep_ = 0; rep_ < 1 + ((DUP >> 10) & 1); ++rep_) pg8::gemm_phase<pg8::EpiGU, pg8::StaticOrder, true, true>(L, g, S, E);
    }
    GRID_SYNC();
    if constexpr ((PHASES >> 11) & 1) { PHASE_PTRS();
        pg8::Gemm g{R5, Wdn_t, MC, 1024, DFF, 0}; pg8::StaticOrder S; S.init(MC, 1024, G, bx);
        pg8::EpiDownNorm E{outp, R4 + (size_t)MP * 1024, SSQ2, (unsigned*)(ws + WS_CTL + 40960), A_->in[I_NFING]};
        pg8::gemm_phase<pg8::EpiDownNorm, pg8::StaticOrder, true, true>(L, g, S, E);
    }
}

extern "C" void kernel_launch(void* const* d_in, const int* in_sizes, int n_in, void* d_out, int out_size, void* d_ws, size_t ws_size, hipStream_t stream) {
    static int grid = 0;
    if (grid == 0) {
        if (n_in != 24 || in_sizes[0] != MC * 1024 || out_size != MC * 1024 || ws_size < WS_END) { fprintf(stderr, "kernel_launch: unexpected shapes (n_in %d, in0 %d, out %d, ws %zu)\n", n_in, n_in > 0 ? in_sizes[0] : -1, out_size, ws_size); grid = -1; return; }
        int dev = 0, cus = 0, per_cu = 0;
        hipGetDevice(&dev); hipDeviceGetAttribute(&cus, hipDeviceAttributeMultiprocessorCount, dev);
        hipFuncSetAttribute((const void*)mega_fwd, hipFuncAttributeMaxDynamicSharedMemorySize, LDS_BYTES);
        hipOccupancyMaxActiveBlocksPerMultiprocessor(&per_cu, (const void*)mega_fwd, NWAVES * 64, LDS_BYTES);
        (void)hipGetLastError();
        if (per_cu < 1) fprintf(stderr, "kernel_launch: occupancy query says %d blocks per CU\n", per_cu);
        grid = cus > 0 ? cus : 256;
        if (grid != 256) fprintf(stderr, "kernel_launch: built for a 256-CU device (the fused final norm needs the four owners of a row panel in one scheduling round); got %d\n", grid);
    }
    if (grid < 0) return;
    if (hipMemsetAsync((char*)d_ws + WS_CTL, 0, CTL_BYTES, stream) != hipSuccess) { fprintf(stderr, "kernel_launch: hipMemsetAsync failed\n"); return; }
    Args a{};
    for (int i = 0; i < 24; ++i) a.in[i] = (const float*)d_in[i];
    a.out = (float*)d_out; a.ws = (unsigned char*)d_ws;
    void* kargs[] = {&a};
    hipError_t e = hipLaunchCooperativeKernel((const void*)mega_fwd, dim3(grid), dim3(NWAVES * 64), kargs, LDS_BYTES, stream);
    if (e != hipSuccess) fprintf(stderr, "kernel_launch: cooperative launch failed: %s (grid %d)\n", hipGetErrorString(e), grid);
}
```

```cpp
#include <hip/hip_runtime.h>
#include <hip/hip_cooperative_groups.h>
#include <hip/hip_bf16.h>
#include <cstdio>
#include <cstdint>
#include <cmath>
#include <type_traits>
namespace pg8 {
#define PG8_LAS __attribute__((address_space(3)))
typedef unsigned short bf16_t;
typedef short bf16x8 __attribute__((ext_vector_type(8)));
typedef float f32x4 __attribute__((ext_vector_type(4)));
typedef unsigned u32x4 __attribute__((ext_vector_type(4)));
constexpr int BM = 256, BK = 64, HALF = 128, HTB = HALF * BK * 2  , STAGE_BYTES = 8 * HTB, NXCD = 8, WGM = 8;

__host__ __device__ __forceinline__ int lds_byte(int r, int c) { const int st = (r >> 4) * 2 + (c >> 5), rr = r & 15, cc = c & 31, ob = rr * 64 + cc * 2; return st * 1024 + (ob ^ (((ob >> 9) & 1) << 5)); }
__host__ __device__ __forceinline__ void stage_rc(int b, int& R, int& C) { const int st = b / 1024, sb = b % 1024, swz = sb ^ (((sb >> 9) & 1) << 5); R = (st >> 1) * 16 + swz / 64; C = (st & 1) * 32 + (swz % 64) / 2; }
__host__ __device__ __forceinline__ int perm32(int rho) { const int n = rho >> 4, i = rho & 15; return 8 * (i >> 2) + 4 * n + (i & 3); }

struct Unit { int pm, pn, seg; };
struct Gemm { const bf16_t* A; const bf16_t* Bt; int M, N, K, amap; const bf16_t* A2; const bf16_t* Bt2; int amap2; };
__device__ __forceinline__ const char* a_base(const Gemm& g, const Unit& u) { const int am = u.seg ? g.amap2 : g.amap; const int r0 = am ? u.pm * 256 + 128 * (u.pm / 32 + 1) : u.pm * 256; return (const char*)(u.seg ? g.A2 : g.A) + (size_t)r0 * (size_t)g.K * 2; }
__device__ __forceinline__ const char* b_base(const Gemm& g, const Unit& u) { return (const char*)(u.seg ? g.Bt2 : g.Bt) + (size_t)u.pn * 256 * (size_t)g.K * 2; }
template <class T, class = void> struct has_twoseg : std::false_type {};
template <class T> struct has_twoseg<T, std::void_t<decltype(T::TWOSEG)>> : std::true_type {};

struct StaticOrder {
    int nM, nN, nwg, G, c;
    __host__ __device__ void init(int M, int N, int G_, int c_) { nM = M / BM; nN = N / BM; nwg = nM * nN; G = G_; c = c_; }
    __host__ __device__ bool next(int i, Unit& u) const {
        const long L = (long)i * G + c; if (L >= nwg) return false;
        int wgid = (int)L; { const int q = nwg / NXCD, r = nwg % NXCD, xcd = wgid % NXCD, off = wgid / NXCD; wgid = (xcd < r ? xcd * (q + 1) : r * (q + 1) + (xcd - r) * q) + off; }
        const int nig = WGM * nN, gid = wgid / nig, fm = gid * WGM, gsz = (nM - fm) < WGM ? (nM - fm) : WGM;
        u.pm = fm + ((wgid % nig) % gsz); u.pn = (wgid % nig) / gsz; u.seg = 0; return true;
    }
    __device__ __forceinline__ void a_ready(const Unit&) const {}
    __device__ __forceinline__ void done(const Unit&) const {}
};
struct StaticOrder2 { StaticOrder b;
    __host__ __device__ void init(int M, int N, int G_, int c_) { b.init(M, N, G_, c_); }
    __host__ __device__ bool next(int i, Unit& u) const { if (!b.next(i >> 1, u)) return false; u.seg = i & 1; return true; }
    __device__ __forceinline__ void a_ready(const Unit&) const {}
    __device__ __forceinline__ void done(const Unit&) const {}
};
typedef float f32x2c __attribute__((ext_vector_type(2))); typedef __bf16 bf16x2c __attribute__((ext_vector_type(2)));
__device__ __forceinline__ unsigned cvt_pk_bf16(float lo, float hi) { f32x2c v = {lo, hi}; bf16x2c b = __builtin_convertvector(v, bf16x2c); return __builtin_bit_cast(unsigned, b); }
typedef float f32x2 __attribute__((ext_vector_type(2)));
typedef unsigned u32x2 __attribute__((ext_vector_type(2)));
__device__ __forceinline__ u32x4 pack8(const f32x4 v0, const f32x4 v1) { u32x4 w; w.x = cvt_pk_bf16(v0[0], v0[1]); w.y = cvt_pk_bf16(v0[2], v0[3]); w.z = cvt_pk_bf16(v1[0], v1[1]); w.w = cvt_pk_bf16(v1[2], v1[3]); return w; }
__device__ __forceinline__ void unpack8(const u32x4 w, f32x4& a, f32x4& b) {
    a[0] = __uint_as_float(w.x << 16); a[1] = __uint_as_float(w.x & 0xffff0000u); a[2] = __uint_as_float(w.y << 16); a[3] = __uint_as_float(w.y & 0xffff0000u);
    b[0] = __uint_as_float(w.z << 16); b[1] = __uint_as_float(w.z & 0xffff0000u); b[2] = __uint_as_float(w.w << 16); b[3] = __uint_as_float(w.w & 0xffff0000u); }
__device__ __forceinline__ float sigm(float x) { return __builtin_amdgcn_rcpf(1.f + __expf(-x)); }
__device__ __forceinline__ f32x4 sigm4(f32x4 v) { f32x4 r; r[0] = sigm(v[0]); r[1] = sigm(v[1]); r[2] = sigm(v[2]); r[3] = sigm(v[3]); return r; }
__device__ __forceinline__ unsigned q8x4(f32x4 v) { return (unsigned)(v[0] * 255.f + 0.5f) | ((unsigned)(v[1] * 255.f + 0.5f) << 8) | ((unsigned)(v[2] * 255.f + 0.5f) << 16) | ((unsigned)(v[3] * 255.f + 0.5f) << 24); }
__device__ __forceinline__ f32x4 u8x4(unsigned w) { f32x4 r; r[0] = (float)(w & 0xffu); r[1] = (float)((w >> 8) & 0xffu); r[2] = (float)((w >> 16) & 0xffu); r[3] = (float)(w >> 24); return r; }
__device__ __forceinline__ float dot4(f32x4 v) { return (v[0] * v[0] + v[1] * v[1]) + (v[2] * v[2] + v[3] * v[3]); }
constexpr float QSCALE = 0.125f * 1.4426950408889634f;

#define EPI_LOOP_AM _Pragma("unroll") for (int ai = 0; ai < 2; ++ai) _Pragma("unroll") for (int m = 0; m < 4; ++m)

struct EpiProj1 {
    static constexpr bool PERM = true, AFTER_DRAIN = false;
    bf16_t *Q, *K, *V, *XBC; float* DT; float* NORM;
    __device__ __forceinline__ void operator()(const f32x4 (&acc)[2][2][4][2], const Unit& u, int wr, int wc, int fr, int fq) const {
        const int pn = u.pn, row0 = u.pm * BM + wr * 64 + fr;
        if (pn == 18) {
            if (wc == 0 && fq < 2) {
                EPI_LOOP_AM { float* p = DT + (size_t)(row0 + ai * HALF + m * 16) * 16 + 8 * fq; *(f32x4*)p = acc[ai][0][m][0]; *(f32x4*)(p + 4) = acc[ai][0][m][1]; }
            }
            return;
        }
        bf16_t* base; int ldc, colt; float sc = 1.f;
        if (pn < 4) { base = Q; ldc = 1024; colt = pn * 256; sc = QSCALE; }
        else if (pn < 8) { base = K; ldc = 1024; colt = (pn - 4) * 256; }
        else if (pn < 12) { base = V; ldc = 1024; colt = (pn - 8) * 256; }
        else { base = XBC; ldc = 1536; colt = (pn - 12) * 256; }
        const int col0 = colt + wc * 32 + 8 * fq;
        float mx[2] = {0.f, 0.f};
        EPI_LOOP_AM { bf16_t* rowp = base + (size_t)(row0 + ai * HALF + m * 16) * ldc + col0;
#pragma unroll
            for (int bj = 0; bj < 2; ++bj) { const f32x4 v0 = acc[ai][bj][m][0] * sc, v1 = acc[ai][bj][m][1] * sc; *(u32x4*)(rowp + bj * HALF) = pack8(v0, v1);
                if (pn < 8) { float ss = dot4(v0) + dot4(v1); ss += __shfl_xor(ss, 16); ss += __shfl_xor(ss, 32); mx[bj] = fmaxf(mx[bj], ss); } } }
        if (pn < 8) {
#pragma unroll
            for (int bj = 0; bj < 2; ++bj) { float v = mx[bj]; v = fmaxf(v, __shfl_xor(v, 1)); v = fmaxf(v, __shfl_xor(v, 2)); v = fmaxf(v, __shfl_xor(v, 4)); v = fmaxf(v, __shfl_xor(v, 8));
                if (fr == 0 && fq == 0) atomicMax((unsigned*)NORM + (((pn >> 2) * 8 + (pn & 3) * 2 + bj) * 2 + (wc >> 1)) * 2 + (wc & 1), __float_as_uint(v * 1.02f)); }
        }
    }
};
struct EpiZG {
    static constexpr bool PERM = true, AFTER_DRAIN = false;
    const bf16_t* Y; bf16_t *YZ, *G; const float* gbias; float* SSQ3;
    __device__ __forceinline__ void operator()(const f32x4 (&acc)[2][2][4][2], const Unit& u, int wr, int wc, int fr, int fq) const {
        const int pn = u.pn, row0 = u.pm * BM + wr * 64 + fr;
        if (pn < 4) {
            const int col0 = pn * 256 + wc * 32 + 8 * fq; const int prow0 = row0 + 128 * (u.pm / 32 + 1);
            EPI_LOOP_AM { const int rr = ai * HALF + m * 16; float ss = 0.f;
#pragma unroll
                for (int bj = 0; bj < 2; ++bj) { f32x4 y0, y1; unpack8(*(const u32x4*)(Y + (size_t)(prow0 + rr) * 1024 + col0 + bj * HALF), y0, y1);
                    const f32x4 z0 = acc[ai][bj][m][0], z1 = acc[ai][bj][m][1]; const f32x4 v0 = y0 * z0 * sigm4(z0), v1 = y1 * z1 * sigm4(z1);
                    *(u32x4*)(YZ + (size_t)(row0 + rr) * 1024 + col0 + bj * HALF) = pack8(v0, v1); ss += dot4(v0) + dot4(v1); }
                ss += __shfl_xor(ss, 16); ss += __shfl_xor(ss, 32);
                if (fq == 0) atomicAdd(SSQ3 + row0 + rr, ss); }
        } else {
            const int col0 = (pn - 4) * 256 + wc * 32 + 8 * fq;
            f32x4 bv[2][2];
#pragma unroll
            for (int bj = 0; bj < 2; ++bj) { bv[bj][0] = *(const f32x4*)(gbias + col0 + bj * HALF); bv[bj][1] = *(const f32x4*)(gbias + col0 + bj * HALF + 4); }
            EPI_LOOP_AM { unsigned char* rowp = (unsigned char*)G + (size_t)(row0 + ai * HALF + m * 16) * 2048 + col0;
#pragma unroll
                for (int bj = 0; bj < 2; ++bj) { u32x2 w; w.x = q8x4(sigm4(acc[ai][bj][m][0] + bv[bj][0])); w.y = q8x4(sigm4(acc[ai][bj][m][1] + bv[bj][1])); *(u32x2*)(rowp + bj * HALF) = w; } }
        }
    }
};
struct EpiBranch {
    static constexpr bool PERM = true, AFTER_DRAIN = false, TWOSEG = true;
    const bf16_t* G; bf16_t* MG; const float* SSQ3;
    __device__ __forceinline__ void mid(f32x4 (&acc)[2][2][4][2], const Unit& u, int wr, int wc, int fr, int fq) const {
        const int row0 = u.pm * BM + wr * 64 + fr, col0 = u.pn * 256 + wc * 32 + 8 * fq;
        EPI_LOOP_AM { const size_t row = (size_t)(row0 + ai * HALF + m * 16); const float r3 = rsqrtf(SSQ3[row] * (1.f / 1024.f) + 1e-6f);
#pragma unroll
            for (int bj = 0; bj < 2; ++bj) { const int c = col0 + bj * HALF; const unsigned char* gp = (const unsigned char*)G + row * 2048 + c;
                const u32x2 ws = *(const u32x2*)gp, wa = *(const u32x2*)(gp + 1024);
                const f32x4 s0 = u8x4(ws.x), s1 = u8x4(ws.y), a0 = u8x4(wa.x), a1 = u8x4(wa.y);
#pragma unroll
                for (int e = 0; e < 4; ++e) { acc[ai][bj][m][0][e] *= r3 * s0[e] * __builtin_amdgcn_rcpf(fmaxf(a0[e], 1.f)); acc[ai][bj][m][1][e] *= r3 * s1[e] * __builtin_amdgcn_rcpf(fmaxf(a1[e], 1.f)); } } }
    }
    __device__ __forceinline__ void operator()(f32x4 (&acc)[2][2][4][2], const Unit& u, int wr, int wc, int fr, int fq) const {
        const int row0 = u.pm * BM + wr * 64 + fr, col0 = u.pn * 256 + wc * 32 + 8 * fq;
        EPI_LOOP_AM { const size_t row = (size_t)(row0 + ai * HALF + m * 16);
#pragma unroll
            for (int bj = 0; bj < 2; ++bj) { const int c = col0 + bj * HALF; const u32x2 wa = *(const u32x2*)((const unsigned char*)G + row * 2048 + 1024 + c); f32x4 a0 = u8x4(wa.x), a1 = u8x4(wa.y);
#pragma unroll
                for (int e = 0; e < 4; ++e) { a0[e] = fmaxf(a0[e], 1.f) * (1.f / 255.f); a1[e] = fmaxf(a1[e], 1.f) * (1.f / 255.f); }
                *(u32x4*)(MG + row * 1024 + c) = pack8(acc[ai][bj][m][0] * a0, acc[ai][bj][m][1] * a1); } }
    }
};
struct EpiWout {
    static constexpr bool PERM = true, AFTER_DRAIN = false;
    const float* X; float* H1; bf16_t* H1B; float* SSQ;
    __device__ __forceinline__ void operator()(const f32x4 (&acc)[2][2][4][2], const Unit& u, int wr, int wc, int fr, int fq) const {
        const int row0 = u.pm * BM + wr * 64 + fr, col0 = u.pn * 256 + wc * 32 + 8 * fq;
        EPI_LOOP_AM { const size_t row = (size_t)(row0 + ai * HALF + m * 16); float ss = 0.f;
#pragma unroll
            for (int bj = 0; bj < 2; ++bj) { const size_t o = row * 1024 + col0 + bj * HALF;
                const f32x4 v0 = __builtin_nontemporal_load((const f32x4*)(X + o)) + acc[ai][bj][m][0], v1 = __builtin_nontemporal_load((const f32x4*)(X + o + 4)) + acc[ai][bj][m][1];
                *(u32x4*)(H1B + o) = pack8(v0, v1); ss += dot4(v0) + dot4(v1); }
            ss += __shfl_xor(ss, 16); ss += __shfl_xor(ss, 32);
            if (fq == 0) atomicAdd(SSQ + row, ss); }
    }
};
struct EpiGU {
    static constexpr bool PERM = true, AFTER_DRAIN = false;
    bf16_t* HF; const float* SSQ;
    __device__ __forceinline__ void operator()(const f32x4 (&acc)[2][2][4][2], const Unit& u, int wr, int wc, int fr, int fq) const {
        const int row0 = u.pm * BM + wr * 64 + fr, col0 = u.pn * 128 + wc * 32 + 8 * fq;
        EPI_LOOP_AM { const size_t row = (size_t)(row0 + ai * HALF + m * 16); const float rstd = rsqrtf(SSQ[row] * (1.f / 1024.f) + 1e-6f);
            f32x4 h[2];
#pragma unroll
            for (int n = 0; n < 2; ++n) { const f32x4 g = acc[ai][0][m][n] * rstd, up = acc[ai][1][m][n] * rstd; h[n] = g * sigm4(g) * up; }
            *(u32x4*)(HF + row * 2816 + col0) = pack8(h[0], h[1]); }
    }
};
struct EpiDownNorm {
    static constexpr bool PERM = true, AFTER_DRAIN = false;
    float* H; const bf16_t* H1B; float* SSQ; unsigned* CNT; const float* gfin;
    __device__ __forceinline__ void operator()(f32x4 (&acc)[2][2][4][2], const Unit& u, int wr, int wc, int fr, int fq) const {
        const int row0 = u.pm * BM + wr * 64 + fr, col0 = u.pn * 256 + wc * 32 + 8 * fq;
        EPI_LOOP_AM { const size_t row = (size_t)(row0 + ai * HALF + m * 16); float ss = 0.f;
#pragma unroll
            for (int bj = 0; bj < 2; ++bj) { const size_t o = row * 1024 + col0 + bj * HALF;
                f32x4 r0, r1; unpack8(*(const u32x4*)(H1B + o), r0, r1); acc[ai][bj][m][0] = acc[ai][bj][m][0] + r0; acc[ai][bj][m][1] = acc[ai][bj][m][1] + r1;
                ss += dot4(acc[ai][bj][m][0]) + dot4(acc[ai][bj][m][1]); }
            ss += __shfl_xor(ss, 16); ss += __shfl_xor(ss, 32);
            if (fq == 0) (void)__hip_atomic_fetch_add(SSQ + row, ss, __ATOMIC_RELAXED, __HIP_MEMORY_SCOPE_AGENT); }
        asm volatile("s_waitcnt vmcnt(0)" ::: "memory");
        unsigned* cnt = CNT + 16 * u.pm;
        if (fr == 0 && fq == 0) (void)__hip_atomic_fetch_add(cnt, 1u, __ATOMIC_RELAXED, __HIP_MEMORY_SCOPE_AGENT);
        for (unsigned sp = 0; sp < (1u << 22); ++sp) {
            if ((unsigned)__builtin_amdgcn_readfirstlane((int)__hip_atomic_load(cnt, __ATOMIC_RELAXED, __HIP_MEMORY_SCOPE_AGENT)) >= 32u) break;
            __builtin_amdgcn_s_sleep(2); }
        f32x4 gv[2][2];
#pragma unroll
        for (int bj = 0; bj < 2; ++bj) { gv[bj][0] = *(const f32x4*)(gfin + col0 + bj * HALF); gv[bj][1] = *(const f32x4*)(gfin + col0 + bj * HALF + 4); }
        EPI_LOOP_AM { const size_t row = (size_t)(row0 + ai * HALF + m * 16);
            const float rs = rsqrtf(__hip_atomic_load(SSQ + row, __ATOMIC_RELAXED, __HIP_MEMORY_SCOPE_AGENT) * (1.f / 1024.f) + 1e-6f);
#pragma unroll
            for (int bj = 0; bj < 2; ++bj) { const size_t o = row * 1024 + col0 + bj * HALF;
                *(f32x4*)(H + o) = acc[ai][bj][m][0] * rs * gv[bj][0]; *(f32x4*)(H + o + 4) = acc[ai][bj][m][1] * rs * gv[bj][1]; } }
    }
};

template <class Epi, class Sched, bool ALIGN_EPI = false, bool SP2 = false>
__device__ __forceinline__ void gemm_phase(PG8_LAS unsigned char* lds, const Gemm g, const Sched& S, const Epi& E) {
    int tid_ = threadIdx.x; asm volatile("" : "+v"(tid_));
    const int tid = tid_, wid = __builtin_amdgcn_readfirstlane(tid >> 6), lane = tid & 63, wr = wid >> 2, wc = wid & 3, fr = lane & 15, fq = lane >> 4;
    const int K = g.K, nt = K / BK;
    unsigned voffA[2], voffB[2];
#pragma unroll
    for (int i = 0; i < 2; ++i) { int R, C; stage_rc(tid * 16 + i * 8192, R, C); const int Rb = Epi::PERM ? ((R & ~31) + perm32(R & 31)) : R;
        voffA[i] = (unsigned)(R * K + C) * 2u; voffB[i] = (unsigned)(Rb * K + C) * 2u; }
    const size_t kstep = (size_t)(BK * 2);
    const size_t hstep = (size_t)HALF * K * 2;
    const size_t tstep = 2 * hstep;
    const unsigned ldsw = (unsigned)wid * 1024u;
    const int aoff = lds_byte(wr * 64 + fr, fq * 8), boff = lds_byte(wc * 32 + fr, fq * 8);
#define PG8_SA(b, h) (((b) * 2 + (h)) * HTB)
#define PG8_SB(b, h) ((4 + (b) * 2 + (h)) * HTB)
#define PG8_STAGE(bufoff, gbase, voff) do { _Pragma("unroll") for (int _i = 0; _i < 2; ++_i) \
        __builtin_amdgcn_global_load_lds((const unsigned*)((const char*)(gbase) + (voff)[_i]), (PG8_LAS unsigned*)(lds + (bufoff) + ldsw + _i * 8192), 16, 0, 0); } while (0)
#define PG8_LDA(dst, b, h) do { _Pragma("unroll") for (int m = 0; m < 4; ++m) _Pragma("unroll") for (int k = 0; k < 2; ++k) dst[m][k] = *(const PG8_LAS bf16x8*)(lds + PG8_SA(b, h) + aoff + m * 2048 + k * 1024); } while (0)
#define PG8_LDB(dst, b, h) do { _Pragma("unroll") for (int n = 0; n < 2; ++n) _Pragma("unroll") for (int k = 0; k < 2; ++k) dst[n][k] = *(const PG8_LAS bf16x8*)(lds + PG8_SB(b, h) + boff + n * 2048 + k * 1024); } while (0)
#define PG8_MMA(ai, bj, At, Bt) do { __builtin_amdgcn_s_setprio(1); _Pragma("unroll") for (int m = 0; m < 4; ++m) _Pragma("unroll") for (int n = 0; n < 2; ++n) _Pragma("unroll") for (int k = 0; k < 2; ++k) \
        acc[ai][bj][m][n] = __builtin_amdgcn_mfma_f32_16x16x32_bf16(Bt[n][k], At[m][k], acc[ai][bj][m][n], 0, 0, 0); __builtin_amdgcn_s_setprio(0); } while (0)
#define PG8_WAIT_V(n) asm volatile("s_waitcnt vmcnt(" #n ")" ::: "memory")
#define PG8_WAIT_L(n) asm volatile("s_waitcnt lgkmcnt(" #n ")" ::: "memory")
#define PG8_BAR __builtin_amdgcn_s_barrier()
#define PG8_SCHED __builtin_amdgcn_sched_barrier(0)
    Unit cur, nxt; int ui = 0;
    if (!S.next(0, cur)) return;
    f32x4 acc[2][2][4][2];
#pragma unroll
    for (int a = 0; a < 2; ++a)
#pragma unroll
        for (int b = 0; b < 2; ++b)
#pragma unroll
            for (int m = 0; m < 4; ++m)
#pragma unroll
                for (int n = 0; n < 2; ++n) acc[a][b][m][n] = (f32x4){0.f, 0.f, 0.f, 0.f};
    bf16x8 At[4][2], B0[2][2], B1[2][2];
    const char* cA = a_base(g, cur); const char* cB = b_base(g, cur);
    S.a_ready(cur);
    if constexpr (SP2) {
        PG8_STAGE(PG8_SB(0, 0), cB, voffB); PG8_STAGE(PG8_SB(0, 1), cB + hstep, voffB); PG8_STAGE(PG8_SA(0, 0), cA, voffA); PG8_STAGE(PG8_SA(0, 1), cA + hstep, voffA);
        if (wr == 1) PG8_BAR;
        PG8_WAIT_V(2); PG8_BAR;
        PG8_STAGE(PG8_SB(1, 0), cB + kstep, voffB); PG8_STAGE(PG8_SA(1, 0), cA + kstep, voffA); PG8_STAGE(PG8_SB(1, 1), cB + hstep + kstep, voffB);
        PG8_WAIT_V(6); PG8_BAR;
    } else {
        PG8_STAGE(PG8_SB(0, 0), cB, voffB); PG8_STAGE(PG8_SA(0, 0), cA, voffA); PG8_STAGE(PG8_SB(0, 1), cB + hstep, voffB); PG8_STAGE(PG8_SA(0, 1), cA + hstep, voffA);
        if (wr == 1) PG8_BAR;
        PG8_WAIT_V(4); PG8_BAR;
        PG8_STAGE(PG8_SB(1, 0), cB + kstep, voffB); PG8_STAGE(PG8_SA(1, 0), cA + kstep, voffA); PG8_STAGE(PG8_SB(1, 1), cB + hstep + kstep, voffB);
        PG8_WAIT_V(6); PG8_BAR;
    }
    for (;;) {
        const bool has_next = S.next(ui + 1, nxt);
        const char* nA = has_next ? a_base(g, nxt) : cA; const char* nB = has_next ? b_base(g, nxt) : cB;
        for (int t = 0; t < nt; t += 2) {
            const bool last = (t == nt - 2);
            const char* a1 = cA + (size_t)(t + 1) * kstep;
            const char* a2 = last ? nA : cA + (size_t)(t + 2) * kstep; const char* b2 = last ? nB : cB + (size_t)(t + 2) * kstep;
            const char* a3 = a2 + kstep; const char* b3 = b2 + kstep;
            if (last && has_next) S.a_ready(nxt);
            if constexpr (SP2) {
            PG8_LDB(B0, 0, 0); PG8_LDB(B1, 0, 1); PG8_SCHED; PG8_LDA(At, 0, 0); PG8_STAGE(PG8_SA(1, 1), a1 + hstep, voffA);
            PG8_WAIT_V(8); PG8_WAIT_L(0); PG8_BAR; PG8_MMA(0, 0, At, B0); PG8_MMA(0, 1, At, B1); PG8_BAR; PG8_SCHED;
            PG8_LDA(At, 0, 1); PG8_STAGE(PG8_SB(0, 0), b2, voffB); PG8_STAGE(PG8_SB(0, 1), b2 + hstep, voffB); PG8_STAGE(PG8_SA(0, 0), a2, voffA);
            PG8_WAIT_V(8); PG8_WAIT_L(0); PG8_BAR; PG8_MMA(1, 0, At, B0); PG8_MMA(1, 1, At, B1); PG8_BAR; PG8_SCHED;
            PG8_LDB(B0, 1, 0); PG8_LDB(B1, 1, 1); PG8_SCHED; PG8_LDA(At, 1, 0); PG8_STAGE(PG8_SA(0, 1), a2 + hstep, voffA);
            PG8_WAIT_V(8); PG8_WAIT_L(0); PG8_BAR; PG8_MMA(0, 0, At, B0); PG8_MMA(0, 1, At, B1); PG8_BAR; PG8_SCHED;
            PG8_LDA(At, 1, 1); PG8_STAGE(PG8_SB(1, 0), b3, voffB); PG8_STAGE(PG8_SB(1, 1), b3 + hstep, voffB); PG8_STAGE(PG8_SA(1, 0), a3, voffA);
            PG8_WAIT_V(8); PG8_WAIT_L(0); PG8_BAR; PG8_MMA(1, 0, At, B0); PG8_MMA(1, 1, At, B1); PG8_BAR; PG8_SCHED;
            } else {
            PG8_LDB(B0, 0, 0); PG8_SCHED; PG8_LDA(At, 0, 0); PG8_STAGE(PG8_SA(1, 1), a1 + hstep, voffA);
            PG8_WAIT_L(8); PG8_BAR; PG8_WAIT_L(0); PG8_MMA(0, 0, At, B0); PG8_BAR; PG8_SCHED;
            PG8_LDB(B1, 0, 1); PG8_STAGE(PG8_SB(0, 0), b2, voffB);
            PG8_BAR; PG8_WAIT_L(0); PG8_MMA(0, 1, At, B1); PG8_BAR;
            PG8_LDA(At, 0, 1); PG8_STAGE(PG8_SA(0, 0), a2, voffA);
            PG8_BAR; PG8_WAIT_L(0); PG8_MMA(1, 0, At, B0); PG8_BAR; PG8_SCHED;
            PG8_STAGE(PG8_SB(0, 1), b2 + hstep, voffB);
            PG8_WAIT_V(6); PG8_BAR; PG8_MMA(1, 1, At, B1); PG8_BAR;
            PG8_LDB(B0, 1, 0); PG8_SCHED; PG8_LDA(At, 1, 0); PG8_STAGE(PG8_SA(0, 1), a2 + hstep, voffA);
            PG8_WAIT_L(8); PG8_BAR; PG8_WAIT_L(0); PG8_MMA(0, 0, At, B0); PG8_BAR; PG8_SCHED;
            PG8_LDB(B1, 1, 1); PG8_STAGE(PG8_SB(1, 0), b3, voffB);
            PG8_BAR; PG8_WAIT_L(0); PG8_MMA(0, 1, At, B1); PG8_BAR;
            PG8_LDA(At, 1, 1); PG8_STAGE(PG8_SA(1, 0), a3, voffA);
            PG8_BAR; PG8_WAIT_L(0); PG8_MMA(1, 0, At, B0); PG8_BAR; PG8_SCHED;
            PG8_STAGE(PG8_SB(1, 1), b3 + hstep, voffB);
            PG8_WAIT_V(6); PG8_BAR; PG8_MMA(1, 1, At, B1); PG8_BAR;
            }
        }
        if constexpr (ALIGN_EPI) { if (wr == 0) PG8_BAR; }
        bool keep_acc = false;
        if constexpr (has_twoseg<Epi>::value) { if (cur.seg == 0) { E.mid(acc, cur, wr, wc, fr, fq); keep_acc = true; } else { E(acc, cur, wr, wc, fr, fq); } }
        else if constexpr (!Epi::AFTER_DRAIN) { E(acc, cur, wr, wc, fr, fq); S.done(cur); }
        if (!has_next) break;
        if (!keep_acc)
#pragma unroll
        for (int a = 0; a < 2; ++a)
#pragma unroll
            for (int b = 0; b < 2; ++b)
#pragma unroll
                for (int m = 0; m < 4; ++m)
#pragma unroll
                    for (int n = 0; n < 2; ++n) acc[a][b][m][n] = (f32x4){0.f, 0.f, 0.f, 0.f};
        cur = nxt; cA = nA; cB = nB; ++ui;
        if constexpr (ALIGN_EPI) { if (wr == 1) PG8_BAR; }
    }
    PG8_WAIT_V(0);
    if constexpr (!ALIGN_EPI) { if (wr == 0) PG8_BAR; }
    PG8_BAR;
    if constexpr (Epi::AFTER_DRAIN) { E.fused(acc, cur, wr, wc, fr, fq, lds, wid, lane); S.done(cur); }
#undef PG8_SA
#undef PG8_SB
#undef PG8_STAGE
#undef PG8_LDA
#undef PG8_LDB
#undef PG8_MMA
#undef PG8_WAIT_V
#undef PG8_WAIT_L
#undef PG8_BAR
#undef PG8_SCHED
}
}
namespace attn_body {
using bf16=__hip_bfloat16;
using bf16x8=__attribute__((ext_vector_type(8)))short;
using s16x4=__attribute__((ext_vector_type(4)))short;
using f32x16=__attribute__((ext_vector_type(16)))float;
using u32x4=__attribute__((ext_vector_type(4)))unsigned;
constexpr int D=64,PQ=1024,PO=2048,LP=8320;
constexpr int NW=8,QBLK=32,QB=QBLK*NW,KVBLK=64,NQB=32;
__device__ __forceinline__ int crow(int r,int hi){return (r&3)+8*(r>>2)+4*hi;}
#define SBAR() __builtin_amdgcn_sched_barrier(0)
__device__ __forceinline__ void cmask(f32x16&p0,f32x16&p1,int jb,int qrel,int hi){
  const float NEG=-INFINITY; int kb=64*jb+4*hi;
  #pragma unroll
  for(int r=0;r<16;++r){int kv=kb+(r&3)+8*(r>>2); if(kv>qrel)p0[r]=NEG; if(kv+32>qrel)p1[r]=NEG;}
}

constexpr int NSLOT=3, SLOTB=8192;
constexpr int LDS_K=0, LDS_V=NSLOT*SLOTB, LDS_WS=2*NSLOT*SLOTB, LDS_OST=LDS_WS+NW*64*4, LDS_BYTES=LDS_OST+NW*4096;
constexpr float C2=0.125f*1.4426950408889634f;
__device__ __forceinline__ void glds16(const void*gsrc,unsigned lds_dst){unsigned keep;
  asm volatile("s_mov_b32 %0, m0\n\ts_mov_b32 m0, %2\n\ts_nop 0\n\tglobal_load_lds_dwordx4 %1, off\n\ts_mov_b32 m0, %0":"=&s"(keep):"v"(gsrc),"s"(lds_dst):"memory");}
__device__ __forceinline__ float max3f(float a,float b,float c){float r;asm("v_max3_f32 %0, %1, %2, %3":"=v"(r):"v"(a),"v"(b),"v"(c));return r;}
__device__ __forceinline__ float max2f(float a,float b){float r;asm("v_max_f32_e32 %0, %1, %2":"=v"(r):"v"(a),"v"(b));return r;}
__device__ __forceinline__ float fadd_s(float a,float b){float r;asm("v_add_f32_e32 %0, %1, %2":"=v"(r):"v"(a),"v"(b));return r;}
__device__ __forceinline__ float fsub_s(float a,float b){float r;asm("v_sub_f32_e32 %0, %1, %2":"=v"(r):"v"(a),"v"(b));return r;}
typedef float f32x2_t __attribute__((ext_vector_type(2))); typedef __bf16 bf16x2_t __attribute__((ext_vector_type(2)));
__device__ __forceinline__ unsigned cvtpk_s(float lo,float hi){f32x2_t v={lo,hi};bf16x2_t b=__builtin_convertvector(v,bf16x2_t);return __builtin_bit_cast(unsigned,b);}
#define WAIT_BAR(N) asm volatile("s_waitcnt vmcnt(" #N ") lgkmcnt(0)\n\ts_barrier":::"memory")

__device__ __forceinline__ void qkt(f32x16&p0,f32x16&p1,const char*Kslot,const bf16x8*qr,const f32x16&ci0,const f32x16&ci1,int r32,int hi){
  const char*kb=Kslot+hi*1024+r32*16;
  #pragma unroll
  for(int d0=0;d0<4;++d0){
    const bf16x8 b0=*reinterpret_cast<const bf16x8*>(kb+d0*2048);
    const bf16x8 b1=*reinterpret_cast<const bf16x8*>(kb+d0*2048+512);
    if(d0==0){p0=__builtin_amdgcn_mfma_f32_32x32x16_bf16(b0,qr[0],ci0,0,0,0);p1=__builtin_amdgcn_mfma_f32_32x32x16_bf16(b1,qr[0],ci1,0,0,0);}
    else{p0=__builtin_amdgcn_mfma_f32_32x32x16_bf16(b0,qr[d0],p0,0,0,0);p1=__builtin_amdgcn_mfma_f32_32x32x16_bf16(b1,qr[d0],p1,0,0,0);}}
}
typedef __attribute__((address_space(3))) const char* lds_cptr;
typedef short v4i16_t __attribute__((ext_vector_type(4)));
__device__ __forceinline__ void kload8(bf16x8*kf,lds_cptr kp){
  kf[0]=*(const __attribute__((address_space(3))) bf16x8*)(kp);      kf[1]=*(const __attribute__((address_space(3))) bf16x8*)(kp+512);
  kf[2]=*(const __attribute__((address_space(3))) bf16x8*)(kp+2048); kf[3]=*(const __attribute__((address_space(3))) bf16x8*)(kp+2560);
  kf[4]=*(const __attribute__((address_space(3))) bf16x8*)(kp+4096); kf[5]=*(const __attribute__((address_space(3))) bf16x8*)(kp+4608);
  kf[6]=*(const __attribute__((address_space(3))) bf16x8*)(kp+6144); kf[7]=*(const __attribute__((address_space(3))) bf16x8*)(kp+6656);
}
__device__ __forceinline__ void kload2(bf16x8*kf,lds_cptr kp,int j){ kf[2*j]=*(const __attribute__((address_space(3))) bf16x8*)(kp+j*2048); kf[2*j+1]=*(const __attribute__((address_space(3))) bf16x8*)(kp+j*2048+512); }
__device__ __forceinline__ s16x4 vtr(lds_cptr p){ return __builtin_bit_cast(s16x4,__builtin_amdgcn_ds_read_tr16_b64_v4i16((__attribute__((address_space(3))) v4i16_t*)p)); }
__device__ __forceinline__ float rowmax(const f32x16&p0,const f32x16&p1){
  float a=max3f(p0[0],p0[1],p1[0]),b=max3f(p0[2],p0[3],p1[1]);a=max3f(a,p1[2],p1[3]);
  #pragma unroll
  for(int r=4;r<16;r+=4){a=max3f(a,p0[r],p0[r+1]);b=max3f(b,p0[r+2],p0[r+3]);a=max3f(a,p1[r],p1[r+1]);b=max3f(b,p1[r+2],p1[r+3]);}
  const float m=max2f(a,b);
  auto rr=__builtin_amdgcn_permlane32_swap(__float_as_uint(m),__float_as_uint(m),false,false);
  return max2f(__uint_as_float(rr[0]),__uint_as_float(rr[1]));
}
__device__ __forceinline__ void pv(f32x16*o,int vb,bf16x8 pa0,bf16x8 pa1,bf16x8 pa2,bf16x8 pa3){
  #pragma unroll
  for(int d0=0;d0<2;++d0){s16x4 lo[4],hi[4];
    #pragma unroll
    for(int ks=0;ks<4;++ks){
      asm volatile("ds_read_b64_tr_b16 %0,%1 offset:%c2":"=&v"(lo[ks]):"v"(vb),"i"(d0*4096+ks*1024):"memory");
      asm volatile("ds_read_b64_tr_b16 %0,%1 offset:%c2":"=&v"(hi[ks]):"v"(vb),"i"(d0*4096+ks*1024+512):"memory");}
    asm volatile("s_waitcnt lgkmcnt(0)":::"memory");SBAR();
    #define PK(k) (bf16x8){lo[k][0],lo[k][1],lo[k][2],lo[k][3],hi[k][0],hi[k][1],hi[k][2],hi[k][3]}
    o[d0]=__builtin_amdgcn_mfma_f32_32x32x16_bf16(pa0,PK(0),o[d0],0,0,0);
    o[d0]=__builtin_amdgcn_mfma_f32_32x32x16_bf16(pa1,PK(1),o[d0],0,0,0);
    o[d0]=__builtin_amdgcn_mfma_f32_32x32x16_bf16(pa2,PK(2),o[d0],0,0,0);
    o[d0]=__builtin_amdgcn_mfma_f32_32x32x16_bf16(pa3,PK(3),o[d0],0,0,0);
    #undef PK
  }
}

#ifndef ATTN_STORE16
#define ATTN_STORE16(p,v) (*(u32x4*)(p)=(v))
#endif
template<int THRL> __device__ __forceinline__ void attn_unit(int b,int h,int c,int vh,int qb,int t0,const bf16*Q,const bf16*__restrict__ K,const bf16*__restrict__ V,bf16*O,char*shm){
  int tid_=threadIdx.x; asm volatile("":"+v"(tid_)); const int tid=tid_,lane=tid&63,r32=lane&31,hi=lane>>5; const int wid=__builtin_amdgcn_readfirstlane(tid>>6);
  const long rowbase=(long)b*LP+64; const int q0=64+qb*QB;
  const bf16*Qw=Q+(rowbase+q0+wid*QBLK)*PQ+h*128+c*64;
  const bf16*Kh=K+(rowbase+(long)t0*KVBLK)*PQ+h*128+c*64,*Vh=V+(rowbase+(long)t0*KVBLK)*PQ+h*128+vh*64;
  const float s2=__builtin_amdgcn_exp2f(-(float)(h+1))*1.4426950408889634f;
  const unsigned lds0=(unsigned)(uintptr_t)shm;
  float*wsf=(float*)(shm+LDS_WS)+wid*64;
  const bf16*ksrc=Kh+(long)lane*PQ+wid*8;
  const bf16*vsrc=Vh+(long)(16*(wid&3)+(lane>>2))*PQ+(wid>>2)*32+(lane&3)*8;
  const unsigned kdst=lds0+LDS_K+wid*1024, vdst=lds0+LDS_V+wid*1024;
  #define DMA_K(t,slot) glds16(ksrc+(long)(t)*KVBLK*PQ,(unsigned)__builtin_amdgcn_readfirstlane(kdst+(slot)))
  #define DMA_V(t,slot) glds16(vsrc+(long)(t)*KVBLK*PQ,(unsigned)__builtin_amdgcn_readfirstlane(vdst+(slot)))
  const int vb0=(int)(lds0+LDS_V)+((lane>>4)&1)*32+(lane&3)*8+(4*hi+((lane&15)>>2))*64;
  const char*Kbase=shm+LDS_K; bf16x8 kf[8];
  const lds_cptr shm3=(lds_cptr)shm; const lds_cptr kp0=shm3+LDS_K+hi*1024+r32*16; const lds_cptr vp0=shm3+LDS_V+((lane>>4)&1)*32+(lane&3)*8+(4*hi+((lane&15)>>2))*64;
  const int NT=(q0+QB)/KVBLK-t0;
  DMA_K(0,0);DMA_V(0,0);DMA_K(1,SLOTB);
  bf16x8 qr[4];
  #pragma unroll
  for(int d0=0;d0<4;++d0)qr[d0]=*reinterpret_cast<const bf16x8*>(&Qw[(long)r32*PQ+d0*16+hi*8]);
  float mhat=0.f,l_reg=0.f;f32x16 o[2];o[0]=f32x16{};o[1]=f32x16{};
  #define RFL(x) __uint_as_float((unsigned)__builtin_amdgcn_readfirstlane((int)__float_as_uint(x)))
  const float s2x1=RFL(s2),s2x2=RFL(2.f*s2),s2x3=RFL(3.f*s2),s2x8=RFL(8.f*s2),s2x16=RFL(16.f*s2),s2x24=RFL(24.f*s2),s2_32=RFL(32.f*s2),s2_64=RFL(64.f*s2);
  const float hi4=hi?4.f*s2:0.f;
  #define CINIT(C0,C1,t) do{ const float tbh_=(s2_64*(float)((t)-(NT-4))-mhat)+hi4; \
    { const float g0_=tbh_,g1_=tbh_+s2x8,g2_=tbh_+s2x16,g3_=tbh_+s2x24; \
      C0[0]=g0_;C0[1]=g0_+s2x1;C0[2]=g0_+s2x2;C0[3]=g0_+s2x3; C0[4]=g1_;C0[5]=g1_+s2x1;C0[6]=g1_+s2x2;C0[7]=g1_+s2x3; \
      C0[8]=g2_;C0[9]=g2_+s2x1;C0[10]=g2_+s2x2;C0[11]=g2_+s2x3; C0[12]=g3_;C0[13]=g3_+s2x1;C0[14]=g3_+s2x2;C0[15]=g3_+s2x3; } \
    _Pragma("unroll") for(int r=0;r<16;++r)C1[r]=C0[r]+s2_32; }while(0)
  const int qrel=wid*QBLK+r32;
  #define CMASK(P0,P1,t) do{int jb_=(t)-(NT-4); if(jb_>=0)cmask(P0,P1,jb_,qrel,hi);}while(0)
  bool resc=false;
  #define START(P0,P1) do{ const float rm=rowmax(P0,P1); resc=false; \
    { const float dl=rm; mhat=fadd_s(mhat,dl); \
      _Pragma("unroll") for(int r=0;r<16;++r){P0[r]=fsub_s(P0[r],dl);P1[r]=fsub_s(P1[r],dl);} } \
    _Pragma("unroll") for(int r=0;r<16;++r)P0[r]=__builtin_amdgcn_exp2f(P0[r]); }while(0)
  #define RESC() do{ if(resc){ asm volatile("s_waitcnt lgkmcnt(0)":::"memory"); \
      _Pragma("unroll") for(int d_=0;d_<2;++d_) _Pragma("unroll") for(int r=0;r<16;++r)o[d_][r]*=wsf[crow(r,hi)]; } }while(0)
  f32x16 pA0,pA1,pB0,pB1;
  int sl_prev=0,sl_cur=0,sl_next=SLOTB;
  #define ROT() do{sl_prev=sl_cur;sl_cur=sl_next;sl_next=(sl_next==(NSLOT-1)*SLOTB)?0:sl_next+SLOTB;}while(0)
  DMA_K(2,2*SLOTB);
  WAIT_BAR(3);
  { f32x16 ci0,ci1; CINIT(ci0,ci1,0); qkt(pA0,pA1,Kbase,qr,ci0,ci1,r32,hi); } asm volatile("s_nop 15\n\ts_nop 7":"+v"(pA0),"+v"(pA1));
  if(t0==0){ const float NEGI=-INFINITY; _Pragma("unroll") for(int r=0;r<16;++r)pA0[r]=NEGI; _Pragma("unroll") for(int r=0;r<8;++r)pA1[r]=NEGI; }
  START(pA0,pA1);
  _Pragma("unroll") for(int r=0;r<16;++r)pA1[r]=__builtin_amdgcn_exp2f(pA1[r]);
  WAIT_BAR(0);
  DMA_K(3,0);DMA_V(1,SLOTB);
  ROT();
  kload8(kf,kp0+sl_cur);
  WAIT_BAR(2);
  s16x4 vlo[8],vhi[8]; u32x4 pw0,pw1,pw2,pw3;
  #define PKW(P,B) cvtpk_s(P[B],P[B+1])
  #define PAF(k) __builtin_bit_cast(bf16x8,pw##k)
  #define VFR(i) (bf16x8){vlo[i][0],vlo[i][1],vlo[i][2],vlo[i][3],vhi[i][0],vhi[i][1],vhi[i][2],vhi[i][3]}
  #define PIN(x) asm volatile("":"+v"(x))
  #define MX3(a,b,c) __builtin_fmaxf(__builtin_fmaxf((a),(b)),(c))
  #define GAPA(MF,A0,A1,A2,A3,W0,W1,PW) do{ MF; sacc+=A0; sacc+=A1; sacc+=A2; sacc+=A3; PIN(sacc); W0; W1; PIN(PW); SBAR(); }while(0)
  #define EX(v) __builtin_amdgcn_exp2f(v)
  #define GAPB(MF,X,B,INI) do{ MF; X[B]=EX(X[B]); X[B+1]=EX(X[B+1]); X[B+2]=EX(X[B+2]); X[B+3]=EX(X[B+3]); PIN(X); INI; SBAR(); }while(0)
  #define NI0(P,g) do{ P[4*(g)]=gn##g##_; P[4*(g)+1]=gn##g##_+s2x1; P[4*(g)+2]=gn##g##_+s2x2; P[4*(g)+3]=gn##g##_+s2x3; PIN(P); }while(0)
  #define NI1(P1,P0,g) do{ P1[4*(g)]=P0[4*(g)]+s2_32; P1[4*(g)+1]=P0[4*(g)+1]+s2_32; P1[4*(g)+2]=P0[4*(g)+2]+s2_32; P1[4*(g)+3]=P0[4*(g)+3]+s2_32; PIN(P1); }while(0)
  #define VRD(i) do{ vlo[i]=vtr(vp_+(((i)>>2)*4096+((i)&3)*1024)); vhi[i]=vtr(vp_+(((i)>>2)*4096+((i)&3)*1024+512)); }while(0)
  #define KRD(G,j) do{ if(G){ kload2(kf,kp0+sl_next,j); SBAR(); } }while(0)
  #define STEP(C0,C1,P0,P1,t,GK,GV,GL) do{ SBAR(); \
    const lds_cptr vp_=vp0+sl_prev; \
    VRD(0); SBAR(); float sacc=(P0[0]+P0[1]); \
    GAPA(C0=__builtin_amdgcn_mfma_f32_32x32x16_bf16(kf[0],qr[0],C0,0,0,0), P0[2],P0[3],P0[4],P0[5],     pw0[0]=PKW(P0,0), pw0[1]=PKW(P0,2), pw0); \
    VRD(4); SBAR(); GAPA(C1=__builtin_amdgcn_mfma_f32_32x32x16_bf16(kf[1],qr[0],C1,0,0,0), P0[6],P0[7],P0[8],P0[9],     pw0[2]=PKW(P0,4), pw0[3]=PKW(P0,6), pw0); \
    VRD(1); SBAR(); GAPA(C0=__builtin_amdgcn_mfma_f32_32x32x16_bf16(kf[2],qr[1],C0,0,0,0),   P0[10],P0[11],P0[12],P0[13], pw1[0]=PKW(P0,8), pw1[1]=PKW(P0,10), pw1); \
    VRD(5); SBAR(); GAPA(C1=__builtin_amdgcn_mfma_f32_32x32x16_bf16(kf[3],qr[1],C1,0,0,0),   P0[14],P0[15],P1[0],P1[1],   pw1[2]=PKW(P0,12),pw1[3]=PKW(P0,14), pw1); \
    VRD(2); SBAR(); GAPA(C0=__builtin_amdgcn_mfma_f32_32x32x16_bf16(kf[4],qr[2],C0,0,0,0),   P1[2],P1[3],P1[4],P1[5],     pw2[0]=PKW(P1,0), pw2[1]=PKW(P1,2), pw2); \
    VRD(6); SBAR(); GAPA(C1=__builtin_amdgcn_mfma_f32_32x32x16_bf16(kf[5],qr[2],C1,0,0,0),   P1[6],P1[7],P1[8],P1[9],     pw2[2]=PKW(P1,4), pw2[3]=PKW(P1,6), pw2); \
    VRD(3); SBAR(); GAPA(C0=__builtin_amdgcn_mfma_f32_32x32x16_bf16(kf[6],qr[3],C0,0,0,0),   P1[10],P1[11],P1[12],P1[13], pw3[0]=PKW(P1,8), pw3[1]=PKW(P1,10), pw3); \
    VRD(7); SBAR(); GAPA(C1=__builtin_amdgcn_mfma_f32_32x32x16_bf16(kf[7],qr[3],C1,0,0,0),   P1[14],P1[15],0.f,0.f,       pw3[2]=PKW(P1,12),pw3[3]=PKW(P1,14), pw3); \
    l_reg+=sacc; \
    if(GK){DMA_K((t)+3,sl_cur);} if(GV){DMA_V((t)+1,sl_next);} \
    CMASK(C0,C1,t); \
    { float a=MX3(C0[0],C0[1],C1[0]),b=MX3(C0[2],C0[3],C1[1]); a=MX3(a,C1[2],C1[3]); \
      _Pragma("unroll") for(int r=4;r<16;r+=4){a=MX3(a,C0[r],C0[r+1]);b=MX3(b,C0[r+2],C0[r+3]);a=MX3(a,C1[r],C1[r+1]);b=MX3(b,C1[r+2],C1[r+3]);} \
      float rm=__builtin_fmaxf(a,b); { auto rr=__builtin_amdgcn_permlane32_swap(__float_as_uint(rm),__float_as_uint(rm),false,false); rm=__builtin_fmaxf(__uint_as_float(rr[0]),__uint_as_float(rr[1])); } \
      resc=false; \
      if(__builtin_expect(__any(rm>(float)THRL),0)){ const float dl=__builtin_fmaxf(rm,0.f); mhat+=dl; \
        _Pragma("unroll") for(int r=0;r<16;++r){C0[r]-=dl;C1[r]-=dl;} \
        const float f=__builtin_amdgcn_exp2f(-dl); l_reg*=f; if(hi==0)wsf[r32]=f; resc=true; } } \
    SBAR(); \
    const float gn0_=(s2_64*(float)(((t)+1)-(NT-4))-mhat)+hi4, gn1_=gn0_+s2x8, gn2_=gn0_+s2x16, gn3_=gn0_+s2x24; \
    GAPB(o[0]=__builtin_amdgcn_mfma_f32_32x32x16_bf16(PAF(0),VFR(0),o[0],0,0,0), C0,0, NI0(P0,0)); \
    GAPB(o[1]=__builtin_amdgcn_mfma_f32_32x32x16_bf16(PAF(0),VFR(4),o[1],0,0,0), C0,4, NI0(P0,1)); \
    KRD(GL,0); GAPB(o[0]=__builtin_amdgcn_mfma_f32_32x32x16_bf16(PAF(1),VFR(1),o[0],0,0,0), C0,8, NI0(P0,2)); \
    KRD(GL,1); GAPB(o[1]=__builtin_amdgcn_mfma_f32_32x32x16_bf16(PAF(1),VFR(5),o[1],0,0,0), C0,12, NI0(P0,3)); \
    KRD(GL,2); GAPB(o[0]=__builtin_amdgcn_mfma_f32_32x32x16_bf16(PAF(2),VFR(2),o[0],0,0,0), C1,0, NI1(P1,P0,0)); \
    KRD(GL,3); GAPB(o[1]=__builtin_amdgcn_mfma_f32_32x32x16_bf16(PAF(2),VFR(6),o[1],0,0,0), C1,4, NI1(P1,P0,1)); \
    GAPB(o[0]=__builtin_amdgcn_mfma_f32_32x32x16_bf16(PAF(3),VFR(3),o[0],0,0,0), C1,8, NI1(P1,P0,2)); \
    GAPB(o[1]=__builtin_amdgcn_mfma_f32_32x32x16_bf16(PAF(3),VFR(7),o[1],0,0,0), C1,12, NI1(P1,P0,3)); \
    }while(0)
  CINIT(pB0,pB1,1);
  int t=1;
  #undef CMASK
  #define CMASK(P0,P1,t) do{}while(0)
  for(;t+5<NT;t+=2){
    STEP(pB0,pB1,pA0,pA1,t,true,true,true);     WAIT_BAR(2); RESC(); ROT();
    STEP(pA0,pA1,pB0,pB1,t+1,true,true,true);   WAIT_BAR(2); RESC(); ROT();
  }
  #undef CMASK
  #define CMASK(P0,P1,t) do{int jb_=(t)-(NT-4); if(jb_>=0)cmask(P0,P1,jb_,qrel,hi);}while(0)
  #define ENDW(tt) do{ if((tt)+3<NT){WAIT_BAR(2);} else if((tt)+2<NT){WAIT_BAR(1);} else {WAIT_BAR(0);} }while(0)
  for(;t+2<NT;t+=2){
    STEP(pB0,pB1,pA0,pA1,t,(t+3<NT),(t+1<NT),(t+1<NT));       ENDW(t);   RESC(); ROT();
    STEP(pA0,pA1,pB0,pB1,t+1,(t+4<NT),(t+2<NT),(t+2<NT));     ENDW(t+1); RESC(); ROT();
  }
  STEP(pB0,pB1,pA0,pA1,NT-2,false,true,true);   ENDW(NT-2); RESC(); ROT();
  STEP(pA0,pA1,pB0,pB1,NT-1,false,false,false); RESC();
  { float sacc=pA0[0]+pA0[1]; _Pragma("unroll") for(int r=2;r<16;++r)sacc+=pA0[r]; _Pragma("unroll") for(int r=0;r<16;++r)sacc+=pA1[r]; l_reg+=sacc;
    pw0=(u32x4){PKW(pA0,0),PKW(pA0,2),PKW(pA0,4),PKW(pA0,6)};pw1=(u32x4){PKW(pA0,8),PKW(pA0,10),PKW(pA0,12),PKW(pA0,14)};pw2=(u32x4){PKW(pA1,0),PKW(pA1,2),PKW(pA1,4),PKW(pA1,6)};pw3=(u32x4){PKW(pA1,8),PKW(pA1,10),PKW(pA1,12),PKW(pA1,14)};
    SBAR(); pv(o,vb0+sl_cur,PAF(0),PAF(1),PAF(2),PAF(3)); }
  #undef PKW
  #undef PAF
  #undef VFR
  #undef PIN
  #undef MX3
  #undef GAPA
  #undef GAPB
  #undef NI0
  #undef NI1
  #undef EX
  #undef VRD
  #undef KRD
  #undef STEP
  #undef ENDW
  {auto rr=__builtin_amdgcn_permlane32_swap(__float_as_uint(l_reg),__float_as_uint(l_reg),false,false);l_reg=__uint_as_float(rr[0])+__uint_as_float(rr[1]);}
  if(hi==0)wsf[32+r32]=l_reg;asm volatile("s_waitcnt lgkmcnt(0)":::"memory");
  float rli[16];
  #pragma unroll
  for(int r=0;r<16;++r)rli[r]=__builtin_amdgcn_rcpf(wsf[32+crow(r,hi)]);
  bf16*Ow=O+(rowbase+q0+wid*QBLK)*PO+c*1024+h*128+vh*64;
  { bf16*stg=(bf16*)(shm+LDS_OST)+wid*2048;
    #pragma unroll
    for(int r=0;r<16;++r){const int orow=crow(r,hi);
      #pragma unroll
      for(int d0=0;d0<2;++d0)stg[orow*64+d0*32+r32]=__float2bfloat16(o[d0][r]*rli[r]);}
    asm volatile("s_waitcnt lgkmcnt(0)":::"memory");
    #pragma unroll
    for(int i=0;i<4;++i){const int row=i*8+(lane>>3),ch=lane&7; const u32x4 v=*(const u32x4*)(stg+row*64+ch*8); ATTN_STORE16(Ow+(long)row*PO+ch*8,v);} }
  asm volatile("s_waitcnt lgkmcnt(0)\n\ts_barrier":::"memory");
  #undef DMA_K
  #undef DMA_V
  #undef CINIT
  #undef RFL
  #undef CMASK
  #undef START
  #undef RESC
  #undef ROT
}
constexpr int ATTN_LDS_BYTES=LDS_BYTES;
struct AttnUnit { int b,h,c,vh,qb; };
struct AttnTensors { const bf16* Q; const bf16* K; const bf16* V; bf16* O; const float* NORM; unsigned* qctr; };
template<int THRL=8> __device__ __forceinline__ void attn_phase(char*lds,const AttnTensors&T){
  typedef __attribute__((address_space(3))) unsigned lu32;
  lu32* slot=(lu32*)((__attribute__((address_space(3))) char*)lds+LDS_BYTES+32);
  unsigned nxt=0u; if(threadIdx.x==0)nxt=atomicAdd(T.qctr,1u);
  for(;;){
    if(threadIdx.x==0){ *slot=nxt; nxt=atomicAdd(T.qctr,1u); }
    asm volatile("s_waitcnt lgkmcnt(0)\n\ts_barrier":::"memory");
    const unsigned u=(unsigned)__builtin_amdgcn_readfirstlane((int)*slot);
    if(u>=4096u)break;
    const int qb=31-(int)(u&31u),cr=(int)(u>>5),h=7-(cr>>4),b=(cr>>2)&3,c=(cr>>1)&1,vh=cr&1;
    const float* nq=T.NORM+((0*8+h)*2+c)*2; const float* nk=T.NORM+((1*8+h)*2+c)*2;
    const float q2=__hip_atomic_load(nq,__ATOMIC_RELAXED,__HIP_MEMORY_SCOPE_AGENT)+__hip_atomic_load(nq+1,__ATOMIC_RELAXED,__HIP_MEMORY_SCOPE_AGENT);
    const float k2=__hip_atomic_load(nk,__ATOMIC_RELAXED,__HIP_MEMORY_SCOPE_AGENT)+__hip_atomic_load(nk+1,__ATOMIC_RELAXED,__HIP_MEMORY_SCOPE_AGENT);
    const float S=1.02f*sqrtf(q2*k2);
    const float s2=__builtin_amdgcn_exp2f(-(float)(h+1))*1.4426950408889634f;
    const float Dd=(150.f+2.f*S)/s2;
    const int q0=64+qb*QB, NTfull=(q0+QB)/KVBLK;
    int t0=0; { const float lim=(float)(q0-63)-Dd; if(lim>=0.f){ t0=(int)(lim*(1.f/64.f))+1; } }
    t0&=~1; if(t0>NTfull-5)t0=(NTfull-5)&~1; if(t0<0)t0=0;
    t0=__builtin_amdgcn_readfirstlane(t0);
    attn_unit<THRL>(b,h,c,vh,qb,t0,T.Q,T.K,T.V,T.O,lds);
  }
}
#undef SBAR
#undef WAIT_BAR
}
namespace ssd {
typedef unsigned short bf16_t;
typedef short bf16x8 __attribute__((ext_vector_type(8)));
typedef float f32x4 __attribute__((ext_vector_type(4)));
typedef unsigned u32x4 __attribute__((ext_vector_type(4)));
typedef unsigned u32x2 __attribute__((ext_vector_type(2)));
#define SLAS __attribute__((address_space(3)))
constexpr int LP = 8320, NCH = 65, LDA = 136;
constexpr int OFF_A = 0, OFF_B = 34816, OFF_X = 69632, OFF_P = 87040, OFF_F = 104448;
struct Params { const bf16_t* XBC; const float* DT; const float* conv_w; const float* conv_b; const float* dt_bias; const float* a_log; const float* d_skip; bf16_t* ST; float* CDEC; bf16_t* Y;
    bf16_t* XT; bf16_t* BT; bf16_t* BM; bf16_t* CM; float* DTA; };
typedef float f32x2_t __attribute__((ext_vector_type(2))); typedef __bf16 bf16x2_t __attribute__((ext_vector_type(2)));
__device__ __forceinline__ unsigned cvtpk(float lo, float hi) { f32x2_t v = {lo, hi}; bf16x2_t b = __builtin_convertvector(v, bf16x2_t); return __builtin_bit_cast(unsigned, b); }
__device__ __forceinline__ float bflo(unsigned w) { return __uint_as_float(w << 16); }
__device__ __forceinline__ float bfhi(unsigned w) { return __uint_as_float(w & 0xffff0000u); }

__device__ __forceinline__ void conv_item(const Params& P, int b, int c, int oct, int strip) {
    const int ch = oct * 8, l0 = strip * 8;
    float w[8][4], bias[8], x[11][8];
#pragma unroll
    for (int j = 0; j < 8; ++j) { const f32x4 t = *(const f32x4*)(P.conv_w + (size_t)(ch + j) * 4); w[j][0] = t[0]; w[j][1] = t[1]; w[j][2] = t[2]; w[j][3] = t[3]; }
    { const f32x4 t0 = *(const f32x4*)(P.conv_b + ch), t1 = *(const f32x4*)(P.conv_b + ch + 4); bias[0] = t0[0]; bias[1] = t0[1]; bias[2] = t0[2]; bias[3] = t0[3]; bias[4] = t1[0]; bias[5] = t1[1]; bias[6] = t1[2]; bias[7] = t1[3]; }
    const long prow0 = (long)b * LP + c * 128 + l0 - 3;
#pragma unroll
    for (int i = 0; i < 11; ++i) { const u32x4 raw = *(const u32x4*)(P.XBC + (prow0 + i) * 1536 + ch);
        x[i][0] = bflo(raw.x); x[i][1] = bfhi(raw.x); x[i][2] = bflo(raw.y); x[i][3] = bfhi(raw.y); x[i][4] = bflo(raw.z); x[i][5] = bfhi(raw.z); x[i][6] = bflo(raw.w); x[i][7] = bfhi(raw.w); }
#define CV(rr, j) ({ const float v_ = bias[j] + w[j][0] * x[rr][j] + w[j][1] * x[rr + 1][j] + w[j][2] * x[rr + 2][j] + w[j][3] * x[rr + 3][j]; v_ * __builtin_amdgcn_rcpf(1.f + __expf(-v_)); })
#define CV_T(dst) { _Pragma("unroll") for (int j = 0; j < 8; ++j) { u32x4 wv; wv.x = cvtpk(CV(0, j), CV(1, j)); wv.y = cvtpk(CV(2, j), CV(3, j)); wv.z = cvtpk(CV(4, j), CV(5, j)); wv.w = cvtpk(CV(6, j), CV(7, j)); *(u32x4*)((dst) + j * 128) = wv; } }
#define CV_R(dst) { _Pragma("unroll") for (int rr = 0; rr < 8; ++rr) { u32x4 wv; wv.x = cvtpk(CV(rr, 0), CV(rr, 1)); wv.y = cvtpk(CV(rr, 2), CV(rr, 3)); wv.z = cvtpk(CV(rr, 4), CV(rr, 5)); wv.w = cvtpk(CV(rr, 6), CV(rr, 7)); *(u32x4*)((dst) + rr * 128) = wv; } }
    const size_t bc = (size_t)b * NCH + c;
    if (oct < 128) {
        bf16_t* dst = P.XT + (bc * 16 + (oct >> 3)) * 8192 + (size_t)((oct & 7) * 8) * 128 + l0;
        CV_T(dst)
    } else {
        const int bcsel = (oct - 128) >> 5, g = ((oct - 128) >> 4) & 1, n0 = ((oct - 128) & 15) * 8;
        bf16_t* rm = (bcsel ? P.CM : P.BM) + (bc * 2 + g) * 16384 + (size_t)l0 * 128 + n0;
        CV_R(rm)
        if (bcsel == 0) { bf16_t* dst = P.BT + (bc * 2 + g) * 16384 + (size_t)n0 * 128 + l0; CV_T(dst) }
    }
#undef CV
#undef CV_T
#undef CV_R
}
__device__ __forceinline__ void dta_item(const Params& P, int u, int lane) {
    const int b = u / (NCH * 16), c = (u / 16) % NCH, h = u % 16;
    const long prow = (long)b * LP + c * 128 + 2 * lane;
    const float bias = P.dt_bias[h], a = -__expf(P.a_log[h]);
    float d0 = P.DT[prow * 16 + h] + bias, d1 = P.DT[(prow + 1) * 16 + h] + bias;
    d0 = d0 > 20.f ? d0 : log1pf(__expf(d0)); d1 = d1 > 20.f ? d1 : log1pf(__expf(d1));
    const int i0 = c * 128 + 2 * lane;
    if (i0 < 112) d0 = 0.f;
    if (i0 + 1 < 112) d1 = 0.f;
    const float a0 = d0 * a, a1 = d1 * a; float s = a0 + a1;
#pragma unroll
    for (int o = 1; o < 64; o <<= 1) { const float t = __shfl_up(s, o); if (lane >= o) s += t; }
    const float excl = s - (a0 + a1);
    float* D = P.DTA + (size_t)u * 256;
    *(f32x2_t*)(D + 2 * lane) = (f32x2_t){d0, d1}; *(f32x2_t*)(D + 128 + 2 * lane) = (f32x2_t){excl + a0, s};
    if (lane == 63) P.CDEC[u] = __expf(s);
}
__device__ __forceinline__ void conv_phase(const Params& P, int gw, int NGW, int lane) {
    for (int it = gw; it < 4 * NCH * 48; it += NGW) { const int bc = it / 48, oq = it % 48; conv_item(P, bc / NCH, bc % NCH, oq * 4 + (lane >> 4), lane & 15); }
    for (int u = gw; u < 4 * NCH * 16; u += NGW) dta_item(P, u, lane);
}
#define SSD_FRAG(base, row, k) (*(const SLAS bf16x8*)((base) + (row) * LDA + (k) * 32 + q * 8))
struct ARegs { u32x4 xv[2], bv[4]; f32x4 dtv[2][2], acv[2][2]; float ae; };
__device__ __forceinline__ void passA_load(ARegs& R, const Params& P, int u, int tid) {
    const int h = u & 15, g = h >> 3; const size_t bc = (size_t)(u >> 4), uh = (size_t)u;
    const bf16_t* gX = P.XT + uh * 8192; const bf16_t* gB = P.BT + (bc * 2 + g) * 16384; const float* D = P.DTA + uh * 256;
#pragma unroll
    for (int i = 0; i < 2; ++i) { const int pc = tid + i * 512; R.xv[i] = *(const u32x4*)(gX + pc * 8); const int l0 = (pc & 15) * 8;
        R.dtv[i][0] = *(const f32x4*)(D + l0); R.dtv[i][1] = *(const f32x4*)(D + l0 + 4); R.acv[i][0] = *(const f32x4*)(D + 128 + l0); R.acv[i][1] = *(const f32x4*)(D + 128 + l0 + 4); }
#pragma unroll
    for (int i = 0; i < 4; ++i) R.bv[i] = *(const u32x4*)(gB + (tid + i * 512) * 8);
    R.ae = D[255];
}
__device__ __forceinline__ void passA_phase(SLAS unsigned char* lds, const Params& P, int first, int stride, int nunits) {
    int tid_ = threadIdx.x; asm volatile("" : "+v"(tid_));
    const int tid = tid_, lane = tid & 63, wid = tid >> 6, r = lane & 15, q = lane >> 4;
    SLAS bf16_t* XT = (SLAS bf16_t*)(lds + OFF_X); SLAS bf16_t* BT = (SLAS bf16_t*)(lds + OFF_A);
    int u = first; if (u >= nunits) return;
    ARegs R; passA_load(R, P, u, tid);
    for (;;) {
#pragma unroll
        for (int i = 0; i < 2; ++i) { const int pc = tid + i * 512, p = pc >> 4, l0 = (pc & 15) * 8; float wg[8];
#pragma unroll
            for (int e = 0; e < 4; ++e) { wg[e] = R.dtv[i][0][e] * __expf(R.ae - R.acv[i][0][e]); wg[4 + e] = R.dtv[i][1][e] * __expf(R.ae - R.acv[i][1][e]); }
            u32x4 wv; wv.x = cvtpk(bflo(R.xv[i].x) * wg[0], bfhi(R.xv[i].x) * wg[1]); wv.y = cvtpk(bflo(R.xv[i].y) * wg[2], bfhi(R.xv[i].y) * wg[3]);
            wv.z = cvtpk(bflo(R.xv[i].z) * wg[4], bfhi(R.xv[i].z) * wg[5]); wv.w = cvtpk(bflo(R.xv[i].w) * wg[6], bfhi(R.xv[i].w) * wg[7]);
            *(SLAS u32x4*)(XT + p * LDA + l0) = wv; }
#pragma unroll
        for (int i = 0; i < 4; ++i) { const int pc = tid + i * 512; *(SLAS u32x4*)(BT + (pc >> 4) * LDA + (pc & 15) * 8) = R.bv[i]; }
        __syncthreads();
        const int un = u + stride;
        if (un < nunits) passA_load(R, P, un, tid);
        f32x4 acc[4];
#pragma unroll
        for (int pt = 0; pt < 4; ++pt) acc[pt] = (f32x4){0.f, 0.f, 0.f, 0.f};
#pragma unroll
        for (int k = 0; k < 4; ++k) { const bf16x8 bfr = SSD_FRAG(BT, wid * 16 + r, k);
#pragma unroll
            for (int pt = 0; pt < 4; ++pt) acc[pt] = __builtin_amdgcn_mfma_f32_16x16x32_bf16(bfr, SSD_FRAG(XT, pt * 16 + r, k), acc[pt], 0, 0, 0); }
        bf16_t* S = P.ST + (size_t)u * 8192;
#pragma unroll
        for (int pt = 0; pt < 4; ++pt) { u32x2 wv; wv.x = cvtpk(acc[pt][0], acc[pt][1]); wv.y = cvtpk(acc[pt][2], acc[pt][3]); *(u32x2*)(S + (pt * 16 + r) * 128 + wid * 16 + 4 * q) = wv; }
        __syncthreads();
        if (un >= nunits) break;
        u = un;
    }
}
struct CRegs { u32x4 xv[2], sv[2], bv[4], cv[4]; f32x4 fv; };
__device__ __forceinline__ void passC_load(CRegs& R, const Params& P, int u, int tid) {
    const int h = u & 15, g = h >> 3; const size_t bc = (size_t)(u >> 4), uh = (size_t)u;
    const bf16_t* gX = P.XT + uh * 8192; const bf16_t* gB = P.BM + (bc * 2 + g) * 16384; const bf16_t* gC = P.CM + (bc * 2 + g) * 16384; const bf16_t* gS = P.ST + uh * 8192; const float* D = P.DTA + uh * 256;
#pragma unroll
    for (int i = 0; i < 2; ++i) { R.xv[i] = *(const u32x4*)(gX + (tid + i * 512) * 8); R.sv[i] = *(const u32x4*)(gS + (tid + i * 512) * 8); }
#pragma unroll
    for (int i = 0; i < 4; ++i) { R.bv[i] = *(const u32x4*)(gB + (tid + i * 512) * 8); R.cv[i] = *(const u32x4*)(gC + (tid + i * 512) * 8); }
    R.fv = *(const f32x4*)(D + (tid & 63) * 4);
}
__device__ __forceinline__ void passC_phase(SLAS unsigned char* lds, const Params& P, int first, int stride, int nunits) {
    int tid_ = threadIdx.x; asm volatile("" : "+v"(tid_));
    const int tid = tid_, lane = tid & 63, wid = tid >> 6, r = lane & 15, q = lane >> 4;
    SLAS float* F = (SLAS float*)(lds + OFF_F);
    SLAS bf16_t* CM = (SLAS bf16_t*)(lds + OFF_A); SLAS bf16_t* BM = (SLAS bf16_t*)(lds + OFF_B); SLAS bf16_t* XT = (SLAS bf16_t*)(lds + OFF_X); SLAS bf16_t* PV = (SLAS bf16_t*)(lds + OFF_P);
    int u = first; if (u >= nunits) return;
    CRegs R; passC_load(R, P, u, tid);
    for (;;) {
        const int h = u & 15, c = (u >> 4) % NCH, b = (u >> 4) / NCH;
#pragma unroll
        for (int i = 0; i < 2; ++i) { const int pc = tid + i * 512; *(SLAS u32x4*)(XT + (pc >> 4) * LDA + (pc & 15) * 8) = R.xv[i]; *(SLAS u32x4*)(PV + (pc >> 4) * LDA + (pc & 15) * 8) = R.sv[i]; }
#pragma unroll
        for (int i = 0; i < 4; ++i) { const int pc = tid + i * 512; *(SLAS u32x4*)(BM + (pc >> 4) * LDA + (pc & 15) * 8) = R.bv[i]; *(SLAS u32x4*)(CM + (pc >> 4) * LDA + (pc & 15) * 8) = R.cv[i]; }
        if (tid < 64) *(SLAS f32x4*)(F + tid * 4) = R.fv;
        __syncthreads();
        const int un = u + stride;
        if (un < nunits) passC_load(R, P, un, tid);
        f32x4 sacc[8];
#pragma unroll
        for (int st = 0; st < 8; ++st) sacc[st] = (f32x4){0.f, 0.f, 0.f, 0.f};
#pragma unroll
        for (int k = 0; k < 4; ++k) { const bf16x8 afr = SSD_FRAG(CM, wid * 16 + r, k);
#pragma unroll
            for (int st = 0; st < 8; ++st) sacc[st] = __builtin_amdgcn_mfma_f32_16x16x32_bf16(SSD_FRAG(BM, st * 16 + r, k), afr, sacc[st], 0, 0, 0); }
        __syncthreads();
        const int l = wid * 16 + r; const float al = F[128 + l], Dh = P.d_skip[h];
#pragma unroll
        for (int st = 0; st < 8; ++st) { const int s0 = st * 16 + 4 * q; float gv[4];
#pragma unroll
            for (int j = 0; j < 4; ++j) { const int s = s0 + j; float v = 0.f; if (s <= l) v = sacc[st][j] * __expf(al - F[128 + s]) * F[s]; if (s == l) v += Dh; gv[j] = v; }
            u32x2 wv; wv.x = cvtpk(gv[0], gv[1]); wv.y = cvtpk(gv[2], gv[3]); *(SLAS u32x2*)(BM + l * LDA + s0) = wv; }
        __syncthreads();
        f32x4 yacc[4];
#pragma unroll
        for (int pt = 0; pt < 4; ++pt) yacc[pt] = (f32x4){0.f, 0.f, 0.f, 0.f};
#pragma unroll
        for (int k = 0; k < 4; ++k) { const bf16x8 afr = SSD_FRAG(CM, wid * 16 + r, k);
#pragma unroll
            for (int pt = 0; pt < 4; ++pt) yacc[pt] = __builtin_amdgcn_mfma_f32_16x16x32_bf16(SSD_FRAG(PV, pt * 16 + r, k), afr, yacc[pt], 0, 0, 0); }
        { const float el = __expf(al);
#pragma unroll
            for (int pt = 0; pt < 4; ++pt) yacc[pt] = yacc[pt] * el; }
#pragma unroll
        for (int k = 0; k < 4; ++k) { const bf16x8 afr = SSD_FRAG(BM, wid * 16 + r, k);
#pragma unroll
            for (int pt = 0; pt < 4; ++pt) yacc[pt] = __builtin_amdgcn_mfma_f32_16x16x32_bf16(SSD_FRAG(XT, pt * 16 + r, k), afr, yacc[pt], 0, 0, 0); }
        bf16_t* yrow = P.Y + ((size_t)b * LP + c * 128 + l) * 1024 + h * 64 + 4 * q;
#pragma unroll
        for (int pt = 0; pt < 4; ++pt) { u32x2 wv; wv.x = cvtpk(yacc[pt][0], yacc[pt][1]); wv.y = cvtpk(yacc[pt][2], yacc[pt][3]); *(u32x2*)(yrow + pt * 16) = wv; }
        __syncthreads();
        if (un >= nunits) break;
        u = un;
    }
}
#undef SSD_FRAG
__device__ __forceinline__ void scan_phase(const Params& P, int gtid, int nthreads) {
    for (int qd = gtid; qd < 4 * 32768; qd += nthreads) {
        const int b = qd >> 15, e = (qd & 32767) * 4, h = e >> 13;
        bf16_t* base = P.ST + (size_t)b * NCH * 131072 + e; const float* cd = P.CDEC + b * NCH * 16 + h;
        float s0 = 0.f, s1 = 0.f, s2 = 0.f, s3 = 0.f;
        for (int c0 = 0; c0 < NCH; c0 += 13) {
            u32x2 v[13]; float d[13];
#pragma unroll
            for (int i = 0; i < 13; ++i) { v[i] = *(const u32x2*)(base + (size_t)(c0 + i) * 131072); d[i] = cd[(c0 + i) * 16]; }
#pragma unroll
            for (int i = 0; i < 13; ++i) { u32x2 o; o.x = cvtpk(s0, s1); o.y = cvtpk(s2, s3); *(u32x2*)(base + (size_t)(c0 + i) * 131072) = o;
                s0 = s0 * d[i] + __uint_as_float(v[i].x << 16); s1 = s1 * d[i] + __uint_as_float(v[i].x & 0xffff0000u);
                s2 = s2 * d[i] + __uint_as_float(v[i].y << 16); s3 = s3 * d[i] + __uint_as_float(v[i].y & 0xffff0000u); }
        }
    }
}
}

namespace cg = cooperative_groups;
#define GAS __attribute__((address_space(1)))
#define LAS __attribute__((address_space(3)))
typedef unsigned short bf16;
typedef unsigned v4u __attribute__((ext_vector_type(4)));
typedef float f32x4 __attribute__((ext_vector_type(4)));
constexpr int NWAVES = 8;
constexpr int NB = 4, SEQ = 8192, LP = 8320, MP = NB * LP, MC = NB * SEQ, DMODEL = 1024, DFF = 2816;
constexpr float EPS = 1e-6f;
constexpr size_t MiB = 1u << 20, S1 = 65 * MiB;
constexpr size_t WS_WIN = 0, WS_WZG = 10 * MiB, WS_WSSD = 16 * MiB, WS_WATT = 18 * MiB, WS_WOUT = 20 * MiB, WS_WGU = 22 * MiB, WS_WDN = 33 * MiB;
constexpr size_t WS_DT = 39 * MiB, WS_DTA = 0  , WS_CDEC = 42 * MiB, WS_SSQ = 42 * MiB + 65536, WS_SSQ2 = 42 * MiB + 262144;
constexpr size_t WS_R5 = 44 * MiB, WS_R0 = WS_R5 + S1, WS_R1 = WS_R0 + S1, WS_R2 = WS_R1 + S1, WS_R3 = WS_R2 + S1, WS_R4 = WS_R3 + S1, WS_END = WS_R4 + 2 * S1;
static_assert(WS_END <= 512 * MiB, "d_ws map fits the guaranteed 512 MiB");
constexpr int LDS_BYTES = 147456;
#ifndef PHASES
#define PHASES 0xFFFF
#endif
#ifndef DUP
#define DUP 0
#endif

__device__ __forceinline__ unsigned f2bf(float f) { unsigned u = __builtin_bit_cast(unsigned, f); return (u + 0x7fffu + ((u >> 16) & 1u)) >> 16; }
__device__ __forceinline__ unsigned pk2(float lo, float hi) { return f2bf(lo) | (f2bf(hi) << 16); }
__device__ __forceinline__ float wave_sum(float v) {
#pragma unroll
    for (int o = 1; o < 64; o <<= 1) v += __shfl_xor(v, o);
    return v;
}
__device__ __forceinline__ float blo(unsigned w) { return __uint_as_float(w << 16); }
__device__ __forceinline__ float bhi(unsigned w) { return __uint_as_float(w & 0xffff0000u); }

__device__ __forceinline__ void tr_item(const float* W, int K, int Npitch, int nsrc, int nvalid, bf16* WT, int drow, const float* kscale, int kb, LAS float* scr, int lane) {
    const int k0 = 64 * kb, n4 = (lane & 7) * 4;
#pragma unroll
    for (int i = 0; i < 8; ++i) { const int kk = 8 * i + (lane >> 3); f32x4 v = (f32x4){0.f, 0.f, 0.f, 0.f};
        if (n4 < nvalid) v = __builtin_nontemporal_load((const f32x4*)(W + (size_t)(k0 + kk) * Npitch + nsrc + n4));
        if (kscale) v = v * kscale[k0 + kk];
        scr[kk * 33 + n4] = v.x; scr[kk * 33 + n4 + 1] = v.y; scr[kk * 33 + n4 + 2] = v.z; scr[kk * 33 + n4 + 3] = v.w; }
    asm volatile("s_waitcnt lgkmcnt(0)" ::: "memory");
    const int c = lane & 7;
#pragma unroll
    for (int jj = 0; jj < 4; ++jj) { const int n = (lane >> 3) + 8 * jj; const LAS float* s = scr + (8 * c) * 33 + n;
        v4u o; o.x = pk2(s[0 * 33], s[1 * 33]); o.y = pk2(s[2 * 33], s[3 * 33]); o.z = pk2(s[4 * 33], s[5 * 33]); o.w = pk2(s[6 * 33], s[7 * 33]);
        *(v4u*)(WT + (size_t)(drow + n) * K + k0 + 8 * c) = o; }
    asm volatile("s_waitcnt lgkmcnt(0)" ::: "memory");
}
template <int NR> __device__ __forceinline__ void u_rows(const float* x, const float* meta, const float* g, bf16* U, int m0, int stride, int lane) {
    f32x4 v[NR][4]; bool live[NR], inr[NR];
#pragma unroll
    for (int k = 0; k < NR; ++k) { const int prow = m0 + k * stride; inr[k] = prow < MP; const int pr = inr[k] ? prow : 0; const int b = pr / LP, i = pr - b * LP; live[k] = inr[k] && i >= 112;
        const f32x4* src = (const f32x4*)(i < 128 ? meta + (size_t)(i < 112 ? 0 : i - 112) * 1024 : x + ((size_t)b * SEQ + (i - 128)) * 1024) + lane;
#pragma unroll
        for (int j = 0; j < 4; ++j) v[k][j] = __builtin_nontemporal_load(src + 64 * j); }
    f32x4 gg[4];
#pragma unroll
    for (int j = 0; j < 4; ++j) gg[j] = ((const f32x4*)g)[lane + 64 * j];
#pragma unroll
    for (int k = 0; k < NR; ++k) { if (!inr[k]) continue;
        unsigned long long* o8 = (unsigned long long*)(U + (size_t)(m0 + k * stride) * 1024) + lane; float s = 0.f;
#pragma unroll
        for (int j = 0; j < 4; ++j) s += (v[k][j].x * v[k][j].x + v[k][j].y * v[k][j].y) + (v[k][j].z * v[k][j].z + v[k][j].w * v[k][j].w);
        const float rstd = live[k] ? rsqrtf(wave_sum(s) * (1.f / 1024.f) + EPS) : 0.f;
#pragma unroll
        for (int j = 0; j < 4; ++j) o8[64 * j] = (unsigned long long)pk2(v[k][j].x * rstd * gg[j].x, v[k][j].y * rstd * gg[j].y) | ((unsigned long long)pk2(v[k][j].z * rstd * gg[j].z, v[k][j].w * rstd * gg[j].w) << 32); }
}
template <int NR> __device__ __forceinline__ void combine_rows(const bf16* O, bf16* YATT, const float* subln_g, float lam, int r0, int stride, int lane) {
    v4u A0[NR], A1[NR], C0[NR], C1[NR];
#pragma unroll
    for (int k = 0; k < NR; ++k) { const int r = r0 + k * stride; const int rr = r < MC ? r : 0; const int b = rr >> 13, t = rr & 8191; const size_t prow = (size_t)b * LP + 128 + t;
        const v4u* p1 = (const v4u*)(O + prow * 2048 + 16 * lane); const v4u* p2 = (const v4u*)(O + prow * 2048 + 1024 + 16 * lane);
        A0[k] = p1[0]; A1[k] = p1[1]; C0[k] = p2[0]; C1[k] = p2[1]; }
    float gpv[16];
    { const f32x4* gp4 = (const f32x4*)(subln_g + 16 * (lane & 7));
#pragma unroll
      for (int i = 0; i < 4; ++i) { const f32x4 t = gp4[i]; gpv[4 * i] = t.x; gpv[4 * i + 1] = t.y; gpv[4 * i + 2] = t.z; gpv[4 * i + 3] = t.w; } }
#pragma unroll
    for (int k = 0; k < NR; ++k) { const int r = r0 + k * stride; if (r >= MC) continue;
        const v4u a0 = A0[k], a1 = A1[k], c0 = C0[k], c1 = C1[k];
        float a[16];
        a[0] = blo(a0.x) - lam * blo(c0.x); a[1] = bhi(a0.x) - lam * bhi(c0.x); a[2] = blo(a0.y) - lam * blo(c0.y); a[3] = bhi(a0.y) - lam * bhi(c0.y);
        a[4] = blo(a0.z) - lam * blo(c0.z); a[5] = bhi(a0.z) - lam * bhi(c0.z); a[6] = blo(a0.w) - lam * blo(c0.w); a[7] = bhi(a0.w) - lam * bhi(c0.w);
        a[8] = blo(a1.x) - lam * blo(c1.x); a[9] = bhi(a1.x) - lam * bhi(c1.x); a[10] = blo(a1.y) - lam * blo(c1.y); a[11] = bhi(a1.y) - lam * bhi(c1.y);
        a[12] = blo(a1.z) - lam * blo(c1.z); a[13] = bhi(a1.z) - lam * bhi(c1.z); a[14] = blo(a1.w) - lam * blo(c1.w); a[15] = bhi(a1.w) - lam * bhi(c1.w);
        float ss = 0.f;
#pragma unroll
        for (int i = 0; i < 16; ++i) ss += a[i] * a[i];
        ss += __shfl_xor(ss, 1); ss += __shfl_xor(ss, 2); ss += __shfl_xor(ss, 4);
        const float rs = rsqrtf(ss * (1.f / 128.f) + EPS) * 0.8f;
        v4u o0, o1;
        o0.x = pk2(a[0] * rs * gpv[0], a[1] * rs * gpv[1]); o0.y = pk2(a[2] * rs * gpv[2], a[3] * rs * gpv[3]); o0.z = pk2(a[4] * rs * gpv[4], a[5] * rs * gpv[5]); o0.w = pk2(a[6] * rs * gpv[6], a[7] * rs * gpv[7]);
        o1.x = pk2(a[8] * rs * gpv[8], a[9] * rs * gpv[9]); o1.y = pk2(a[10] * rs * gpv[10], a[11] * rs * gpv[11]); o1.z = pk2(a[12] * rs * gpv[12], a[13] * rs * gpv[13]); o1.w = pk2(a[14] * rs * gpv[14], a[15] * rs * gpv[15]);
        v4u* q = (v4u*)(YATT + (size_t)r * 1024 + 16 * lane); q[0] = o0; q[1] = o1; }
}

#define XB_TMO      128
#define XB_XCNT(j)  (256  + 64 * (j))
#define XB_XSUB(j)  (1280 + 64 * (j))
#define XB_XGEN(j)  (2304 + 64 * (j))
#define XB_TOP      3328
#define XB_TOPGEN   3392
#define XCD_BAR_WORDS 3456
#define XB_SPIN_CAP (1u << 18)

__device__ __forceinline__ unsigned xb_ld(unsigned* p)              { return __hip_atomic_load(p, __ATOMIC_RELAXED, __HIP_MEMORY_SCOPE_AGENT); }
__device__ __forceinline__ unsigned xb_add(unsigned* p, unsigned v) { return __hip_atomic_fetch_add(p, v, __ATOMIC_RELAXED, __HIP_MEMORY_SCOPE_AGENT); }
__device__ __forceinline__ unsigned xb_xcc_id() { return (unsigned)__builtin_amdgcn_s_getreg((3 << 11) | 20) & 0xFu; }
#define XB_SPIN(cond, bar) do { unsigned _sp = 0; while (cond) { __builtin_amdgcn_s_sleep(1); \
    if ((++_sp & 255u) == 0u) { if (xb_ld(&(bar)[XB_TMO])) break; if (_sp > XB_SPIN_CAP) { atomicAdd(&(bar)[XB_TMO], 1u); break; } } } } while (0)

struct XcdBarrier {
    unsigned* bar; unsigned x;
    volatile LAS unsigned* st;
};

__device__ __forceinline__ XcdBarrier xcd_barrier_post(unsigned* bar, volatile LAS unsigned* st) {
    XcdBarrier b; b.bar = bar; b.x = xb_xcc_id(); b.st = st;
    if (threadIdx.x == 0) (void)xb_add(&bar[XB_XCNT(b.x)], 1u);
    return b;
}
__device__ __forceinline__ void xcd_barrier_complete(unsigned* bar, unsigned x, unsigned& nloc, unsigned& nx) {
    const unsigned G = gridDim.x * gridDim.y * gridDim.z;
    unsigned sum, cnt, mine, sp = 0u;
    for (;;) {
        sum = 0u; cnt = 0u; mine = 0u;
#pragma unroll
        for (unsigned j = 0; j < 16; ++j) { const unsigned c = xb_ld(&bar[XB_XCNT(j)]); sum += c; cnt += (c > 0u) ? 1u : 0u; mine = (j == x) ? c : mine; }
        if (sum == G) break;
        __builtin_amdgcn_s_sleep(1);
        if ((++sp & 255u) == 0u) { if (xb_ld(&bar[XB_TMO])) break; if (sp > XB_SPIN_CAP) { atomicAdd(&bar[XB_TMO], 1u); break; } }
    }
    nloc = mine > 0u ? mine : 1u; nx = cnt > 0u ? cnt : 1u;
}

__device__ __forceinline__ void xcd_barrier(const XcdBarrier& b) {
    asm volatile("s_waitcnt vmcnt(0)" ::: "memory");
    __syncthreads();
    if (threadIdx.x == 0) {
        unsigned* bar = b.bar;
        __builtin_amdgcn_s_waitcnt(0);
        unsigned nloc = b.st[0], nx = b.st[1];
        if (nloc == 0u) { xcd_barrier_complete(bar, b.x, nloc, nx); b.st[0] = nloc; b.st[1] = nx; }
        const unsigned old = xb_add(&bar[XB_XSUB(b.x)], 1u);
        const unsigned gen = old / nloc;
        if (old + 1u == (gen + 1u) * nloc) {
            __builtin_amdgcn_fence(__ATOMIC_RELEASE, "agent");
            asm volatile("s_waitcnt vmcnt(0)" ::: "memory");
            const unsigned og = xb_add(&bar[XB_TOP], 1u);
            const unsigned tg = og / nx;
            if (og + 1u == (tg + 1u) * nx) xb_add(&bar[XB_TOPGEN], 1u);
            else XB_SPIN(xb_ld(&bar[XB_TOPGEN]) == tg, bar);
            __builtin_amdgcn_fence(__ATOMIC_ACQUIRE, "agent");
            xb_add(&bar[XB_XGEN(b.x)], 1u);
            asm volatile("s_waitcnt vmcnt(0)" ::: "memory");
        } else {
            XB_SPIN(xb_ld(&bar[XB_XGEN(b.x)]) == gen, bar);
            __builtin_amdgcn_fence(__ATOMIC_ACQUIRE, "agent");
            asm volatile("s_waitcnt vmcnt(0)" ::: "memory");
        }
    }
    __syncthreads();
}
constexpr size_t WS_CTL = 43 * MiB, CTL_BYTES = 65536;
constexpr int LDSCTL_OFF = 131072;

struct Args { const float* in[24]; float* out; unsigned char* ws; };
enum { I_X = 0, I_META, I_NMIXG, I_WIN, I_GBIAS, I_CONVW, I_CONVB, I_DTBIAS, I_ALOG, I_DSKIP, I_SSDG, I_LQ1, I_LK1, I_LQ2, I_LK2, I_SUBLNG, I_WSSD, I_WATT, I_WOUT, I_NFFNG, I_WGATE, I_WUP, I_WDOWN, I_NFING };

__global__ void __launch_bounds__(NWAVES * 64, 2) mega_fwd(Args args) {
    extern __shared__ __attribute__((aligned(16))) unsigned char lds[];
    cg::grid_group grid = cg::this_grid();
    { LAS unsigned* z = (LAS unsigned*)(lds + 0) ; (void)z; }
    for (int u = threadIdx.x; u < 64; u += NWAVES * 64) ((LAS unsigned*)((LAS unsigned char*)lds + LDSCTL_OFF))[u] = 0u;
    __syncthreads();
    XcdBarrier xbar = xcd_barrier_post((unsigned*)(args.ws + WS_CTL), (volatile LAS unsigned*)((LAS unsigned char*)lds + LDSCTL_OFF) + 8);
    grid.sync();
    LAS unsigned char* L = (LAS unsigned char*)lds;
    const int G = gridDim.x, bx = blockIdx.x, vcu = (G % 8 == 0) ? (bx % 8) * (G / 8) + bx / 8 : bx;
    const int NGW = G * NWAVES;
#define PHASE_PTRS() \
    const __attribute__((address_space(4))) Args* A_ = (const __attribute__((address_space(4))) Args*)__builtin_amdgcn_kernarg_segment_ptr(); asm volatile("" : "+s"(A_)); \
    unsigned char* ws = A_->ws; (void)ws; \
    int tid_o = threadIdx.x; asm volatile("" : "+v"(tid_o)); const int lane = tid_o & 63, wave = __builtin_amdgcn_readfirstlane(tid_o >> 6), gw = vcu * NWAVES + wave; (void)lane; (void)gw; \
    bf16 *Win_t = (bf16*)(ws + WS_WIN), *Wzg_t = (bf16*)(ws + WS_WZG), *Wssd_t = (bf16*)(ws + WS_WSSD), *Watt_t = (bf16*)(ws + WS_WATT), *Wout_t = (bf16*)(ws + WS_WOUT), *Wgu_t = (bf16*)(ws + WS_WGU), *Wdn_t = (bf16*)(ws + WS_WDN); \
    float *DT = (float*)(ws + WS_DT), *CDEC = (float*)(ws + WS_CDEC), *SSQ = (float*)(ws + WS_SSQ), *SSQ2 = (float*)(ws + WS_SSQ2), *SSQ3 = (float*)(ws + WS_SSQ2 + 131072); (void)SSQ3; \
    bf16 *R5 = (bf16*)(ws + WS_R5), *R0 = (bf16*)(ws + WS_R0), *R1 = (bf16*)(ws + WS_R1), *R2 = (bf16*)(ws + WS_R2), *R3 = (bf16*)(ws + WS_R3), *R4 = (bf16*)(ws + WS_R4); \
    const float* x = A_->in[I_X]; float* outp = A_->out; \
    (void)Win_t; (void)Wzg_t; (void)Wssd_t; (void)Watt_t; (void)Wout_t; (void)Wgu_t; (void)Wdn_t; (void)DT; (void)CDEC; (void)SSQ; (void)SSQ2; (void)R5; (void)R0; (void)R1; (void)R2; (void)R3; (void)R4; (void)x; (void)outp;
#define GRID_SYNC() xcd_barrier(xbar)

    if constexpr ((PHASES >> 0) & 1) for (int rep0_ = 0; rep0_ < 1 + ((DUP >> 0) & 1); ++rep0_) { PHASE_PTRS();
        LAS float* scr = (LAS float*)(L + wave * 16384);
        const float* w_in = A_->in[I_WIN];
        constexpr int NIN = 7696;
        for (int it = gw; it < 3856; it += NGW) {
            int r = it;
#define SEG(W_, K_, NP_, NS_, NBLK_, NVAL_, WT_, DROW_, KS_, IL_) { const int n_ = ((K_) / 64) * (NBLK_); if (r < n_) { const int kb = r / (NBLK_), blk = r % (NBLK_); \
                tr_item(W_, K_, NP_, (NS_) + 32 * blk, NVAL_, WT_, (IL_) ? (DROW_) + 256 * (blk >> 2) + 32 * (blk & 3) : (DROW_) + 32 * blk, KS_, kb, scr, lane); continue; } r -= n_; }
            SEG(w_in, 1024, NIN, 2576, 32, 32, Win_t, 0, nullptr, 0)
            SEG(w_in, 1024, NIN, 3600, 32, 32, Win_t, 1024, nullptr, 0)
            SEG(w_in, 1024, NIN, 4624, 32, 32, Win_t, 2048, nullptr, 0)
            SEG(w_in, 1024, NIN, 1024, 48, 32, Win_t, 3072, nullptr, 0)
            SEG(w_in, 1024, NIN, 2560, 1, 16, Win_t, 4608, nullptr, 0)
            SEG(w_in, 1024, NIN, 0, 32, 32, Wzg_t, 0, nullptr, 0)
            SEG(w_in, 1024, NIN, 5648, 64, 32, Wzg_t, 1024, nullptr, 0)
        }
        {
            const int gt = gw * 64 + lane, NT = NGW * 64;
            v4u* z = (v4u*)(Win_t + (size_t)4640 * 1024);
            for (int i = gt; i < 224 * 128; i += NT) z[i] = (v4u){0u, 0u, 0u, 0u};
            for (int i = gt; i < MC; i += NT) { SSQ[i] = 0.f; SSQ2[i] = 0.f; SSQ3[i] = 0.f; }
        }
        for (int m = gw; m < MP; m += 4 * NGW) u_rows<4>(x, A_->in[I_META], A_->in[I_NMIXG], (bf16*)outp, m, NGW, lane);
    }
    GRID_SYNC();
    if constexpr ((PHASES >> 1) & 1) { PHASE_PTRS();
        pg8::Gemm g{(const bf16*)outp, Win_t, MP, 4864, 1024, 0}; pg8::StaticOrder S; S.init(MP, 4864, G, bx);
        pg8::EpiProj1 E{R1, R2, R3, R4, DT, (float*)(ws + WS_CTL + 16384)};
        for (int rep_ = 0; rep_ < 1 + ((DUP >> 1) & 1); ++rep_) pg8::gemm_phase<pg8::EpiProj1, pg8::StaticOrder, true, true>(L, g, S, E);
    }
    GRID_SYNC();
    if constexpr ((PHASES >> 2) & 1) { PHASE_PTRS();
        const attn_body::AttnTensors AT{(const attn_body::bf16*)R1, (const attn_body::bf16*)R2, (const attn_body::bf16*)R3, (attn_body::bf16*)R5, (const float*)(ws + WS_CTL + 16384), (unsigned*)(ws + WS_CTL + 32768)};
        attn_body::attn_phase<64>((char*)lds, AT);
        {
            unsigned* wctr = (unsigned*)(ws + WS_CTL + 32768 + 256);
            LAS unsigned* wslot = (LAS unsigned*)(L + 140000);
            LAS float* scr = (LAS float*)(L + wave * 16384);
            for (;;) {
                __syncthreads();
                if (threadIdx.x == 0) *wslot = atomicAdd(wctr, 1u);
                __syncthreads();
                const int it = (int)(*wslot) * NWAVES + wave;
                if ((int)(*wslot) * NWAVES >= 5760) break;
                if (it < 5760) { int r = it; do {
            SEG(A_->in[I_WSSD], 1024, 1024, 0, 32, 32, Wssd_t, 0, A_->in[I_SSDG], 0)
            SEG(A_->in[I_WATT], 1024, 1024, 0, 32, 32, Watt_t, 0, nullptr, 0)
            SEG(A_->in[I_WOUT], 1024, 1024, 0, 32, 32, Wout_t, 0, nullptr, 0)
            SEG(A_->in[I_WGATE], 1024, DFF, 0, 88, 32, Wgu_t, 0, A_->in[I_NFFNG], 1)
            SEG(A_->in[I_WUP], 1024, DFF, 0, 88, 32, Wgu_t, 128, A_->in[I_NFFNG], 1)
            SEG(A_->in[I_WDOWN], DFF, 1024, 0, 32, 32, Wdn_t, 0, nullptr, 0)
                } while (0); }
            }
        }
#undef SEG
    }
    GRID_SYNC();
#define SSD_PARAMS() PHASE_PTRS(); const ssd::Params SP{R4, DT, A_->in[I_CONVW], A_->in[I_CONVB], A_->in[I_DTBIAS], A_->in[I_ALOG], A_->in[I_DSKIP], R3, CDEC, R4, R1, R1 + (size_t)MP * 1024, R1 + (size_t)MP * 1280, R1 + (size_t)MP * 1536, (float*)(ws + WS_DTA)}
    if constexpr ((PHASES >> 3) & 1) { SSD_PARAMS(); for (int rep_ = 0; rep_ < 1 + ((DUP >> 12) & 1); ++rep_) ssd::conv_phase(SP, gw, NGW, lane); }
    GRID_SYNC();
    if constexpr ((PHASES >> 3) & 1) { SSD_PARAMS(); for (int rep_ = 0; rep_ < 1 + ((DUP >> 3) & 1); ++rep_) ssd::passA_phase(L, SP, vcu, G, NB * 65 * 16); }
    GRID_SYNC();
    if constexpr ((PHASES >> 4) & 1) { SSD_PARAMS(); ssd::scan_phase(SP, gw * 64 + lane, NGW * 64); }
    GRID_SYNC();
    if constexpr ((PHASES >> 5) & 1) { SSD_PARAMS(); for (int rep_ = 0; rep_ < 1 + ((DUP >> 5) & 1); ++rep_) ssd::passC_phase(L, SP, vcu, G, NB * 65 * 16);
        const float s1 = wave_sum(A_->in[I_LQ1][lane] * A_->in[I_LK1][lane]), s2 = wave_sum(A_->in[I_LQ2][lane] * A_->in[I_LK2][lane]);
        const float lam = expf(s1) - expf(s2) + 0.2f;
        for (int r = gw; r < MC; r += 4 * NGW) combine_rows<4>(R5, R4 + (size_t)MP * 1024, A_->in[I_SUBLNG], lam, r, NGW, lane);
        }
    GRID_SYNC();
    if constexpr ((PHASES >> 6) & 1) { PHASE_PTRS();
        pg8::Gemm g{(const bf16*)outp, Wzg_t, MC, 3072, 1024, 1}; pg8::StaticOrder S; S.init(MC, 3072, G, bx);
        pg8::EpiZG E{R4, R1, R2, A_->in[I_GBIAS], SSQ3};
        for (int rep_ = 0; rep_ < 1 + ((DUP >> 6) & 1); ++rep_) pg8::gemm_phase<pg8::EpiZG, pg8::StaticOrder, true, true>(L, g, S, E);
    }
    GRID_SYNC();
    if constexpr ((PHASES >> 8) & 1) { PHASE_PTRS();
        pg8::Gemm g{R1, Wssd_t, MC, 1024, 1024, 0, R4 + (size_t)MP * 1024, Watt_t, 0}; pg8::StaticOrder2 S; S.init(MC, 1024, G, bx);
        pg8::EpiBranch E{R2, R4, SSQ3};
        pg8::gemm_phase<pg8::EpiBranch, pg8::StaticOrder2, true, true>(L, g, S, E);
    }
    GRID_SYNC();
    if constexpr ((PHASES >> 9) & 1) { PHASE_PTRS();
        pg8::Gemm g{R4, Wout_t, MC, 1024, 1024, 0}; pg8::StaticOrder S; S.init(MC, 1024, G, bx);
        pg8::EpiWout E{x, outp, R4 + (size_t)MP * 1024, SSQ};
        pg8::gemm_phase<pg8::EpiWout, pg8::StaticOrder, true, true>(L, g, S, E);
    }
    GRID_SYNC();
    if constexpr ((PHASES >> 10) & 1) { PHASE_PTRS();
        pg8::Gemm g{R4 + (size_t)MP * 1024, Wgu_t, MC, 2 * DFF, 1024, 0}; pg8::StaticOrder S; S.init(MC, 2 * DFF, G, bx);
        pg8::EpiGU E{R5, SSQ};
        for (int rep_ = 0; rep_ < 1 + ((DUP >> 10) & 1); ++rep_) pg8::gemm_phase<pg8::EpiGU, pg8::StaticOrder, true, true>(L, g, S, E);
    }
    GRID_SYNC();
    if constexpr ((PHASES >> 11) & 1) { PHASE_PTRS();
        pg8::Gemm g{R5, Wdn_t, MC, 1024, DFF, 0}; pg8::StaticOrder S; S.init(MC, 1024, G, bx);
        pg8::EpiDownNorm E{outp, R4 + (size_t)MP * 1024, SSQ2, (unsigned*)(ws + WS_CTL + 40960), A_->in[I_NFING]};
        pg8::gemm_phase<pg8::EpiDownNorm, pg8::StaticOrder, true, true>(L, g, S, E);
    }
}

extern "C" void kernel_launch(void* const* d_in, const int* in_sizes, int n_in, void* d_out, int out_size, void* d_ws, size_t ws_size, hipStream_t stream) {
    static int grid = 0;
    if (grid == 0) {
        if (n_in != 24 || in_sizes[0] != MC * 1024 || out_size != MC * 1024 || ws_size < WS_END) { fprintf(stderr, "kernel_launch: unexpected shapes (n_in %d, in0 %d, out %d, ws %zu)\n", n_in, n_in > 0 ? in_sizes[0] : -1, out_size, ws_size); grid = -1; return; }
        int dev = 0, cus = 0, per_cu = 0;
        hipGetDevice(&dev); hipDeviceGetAttribute(&cus, hipDeviceAttributeMultiprocessorCount, dev);
        hipFuncSetAttribute((const void*)mega_fwd, hipFuncAttributeMaxDynamicSharedMemorySize, LDS_BYTES);
        hipOccupancyMaxActiveBlocksPerMultiprocessor(&per_cu, (const void*)mega_fwd, NWAVES * 64, LDS_BYTES);
        (void)hipGetLastError();
        if (per_cu < 1) fprintf(stderr, "kernel_launch: occupancy query says %d blocks per CU\n", per_cu);
        grid = cus > 0 ? cus : 256;
        if (grid != 256) fprintf(stderr, "kernel_launch: built for a 256-CU device (the fused final norm needs the four owners of a row panel in one scheduling round); got %d\n", grid);
    }
    if (grid < 0) return;
    if (hipMemsetAsync((char*)d_ws + WS_CTL, 0, CTL_BYTES, stream) != hipSuccess) { fprintf(stderr, "kernel_launch: hipMemsetAsync failed\n"); return; }
    Args a{};
    for (int i = 0; i < 24; ++i) a.in[i] = (const float*)d_in[i];
    a.out = (float*)d_out; a.ws = (unsigned char*)d_ws;
    void* kargs[] = {&a};
    hipError_t e = hipLaunchCooperativeKernel((const void*)mega_fwd, dim3(grid), dim3(NWAVES * 64), kargs, LDS_BYTES, stream);
    if (e != hipSuccess) fprintf(stderr, "kernel_launch: cooperative launch failed: %s (grid %d)\n", hipGetErrorString(e), grid);
}
```
